# Optimizing an MI355X kernel written in HIP

```python
import jax, jax.numpy as jnp
from jax import lax
import numpy as np

D_MODEL = 2048
BATCH = 8
SEQ = 4096
DEPTH = 4

N_A = DEPTH // 2
N_B = DEPTH - N_A
MIX_W = D_MODEL
MEM_HEADS = 4
MEM_HEAD_DIM = 128
MEM_W = MEM_HEADS * MEM_HEAD_DIM
CHUNK = 128
G_HEADS = 12
G_DIM = 128
G_W = G_HEADS * G_DIM
MLA_HEADS = 12
NOPE_DIM = 128
ROPE_DIM = 64
V_DIM = 128
Q_RANK = 512
KV_RANK = 512
Q_BLOCK = 128
ROPE_THETA = 10000.0
D_FF = 5632
CONV_W = 3
EPS = 1e-6

kernel_name = "yoco_gmlp_mla_memxattn_convffn"


def rmsnorm(x, g):
    x32 = x.astype(jnp.float32)
    y = x32 * lax.rsqrt(jnp.mean(x32 * x32, axis=-1, keepdims=True) + EPS)
    return (y * g.astype(jnp.float32)).astype(x.dtype)


def rope_tables(positions, dtype):
    inv = 1.0 / (ROPE_THETA ** (jnp.arange(0, ROPE_DIM, 2, dtype=jnp.float32) / ROPE_DIM))
    ang = positions.astype(jnp.float32)[..., None] * inv
    return jnp.cos(ang).astype(dtype), jnp.sin(ang).astype(dtype)


def apply_rope(x, cos, sin):
    x1, x2 = jnp.split(x, 2, axis=-1)
    return jnp.concatenate([x1 * cos - x2 * sin, x2 * cos + x1 * sin], axis=-1)


def spatial_gating(z_u, z_v, g_v, w_sp, b_sp):
    B, S, _ = z_u.shape
    u = jax.nn.gelu(z_u, approximate=False)
    v = rmsnorm(jax.nn.gelu(z_v, approximate=False), g_v)
    vb = v.reshape(B, S // CHUNK, CHUNK, G_HEADS, G_DIM)
    w = w_sp * jnp.tril(jnp.ones((CHUNK, CHUNK), w_sp.dtype))
    sv = jnp.einsum('gts,bnsgc->bntgc', w, vb) + b_sp.T[None, None, :, :, None]
    return u * sv.reshape(B, S, G_W)


def mla_attention(q_lat, g_q_lat, w_uq, w_uk, w_uv, c_kv, k_rope, cos, sin):
    B, S, _ = q_lat.shape
    q = (rmsnorm(q_lat, g_q_lat) @ w_uq).reshape(B, S, MLA_HEADS, NOPE_DIM + ROPE_DIM)
    q_nope = q[..., :NOPE_DIM]
    q_rope = apply_rope(q[..., NOPE_DIM:], cos[:, :, None, :], sin[:, :, None, :])
    n_blk = S // Q_BLOCK
    scale = (NOPE_DIM + ROPE_DIM) ** -0.5
    k_pos = jnp.arange(S)

    def to_blocks(t):
        return jnp.moveaxis(t.reshape(B, n_blk, Q_BLOCK, *t.shape[2:]), 1, 0)

    def block(args):
        qn, qr, i = args
        qa = jnp.einsum('bqhn,rhn->bqhr', qn, w_uk)
        s = (jnp.einsum('bqhr,bkr->bhqk', qa, c_kv)
             + jnp.einsum('bqhp,bkp->bhqk', qr, k_rope)).astype(jnp.float32) * scale
        q_pos = i * Q_BLOCK + jnp.arange(Q_BLOCK)
        s = jnp.where(k_pos[None, :] <= q_pos[:, None], s, -jnp.inf)
        p = jax.nn.softmax(s, axis=-1).astype(c_kv.dtype)
        o_lat = jnp.einsum('bhqk,bkr->bqhr', p, c_kv)
        return jnp.einsum('bqhr,rhv->bqhv', o_lat, w_uv)

    o = lax.map(block, (to_blocks(q_nope), to_blocks(q_rope), jnp.arange(n_blk)))
    return jnp.moveaxis(o, 0, 1).reshape(B, S, MLA_HEADS * V_DIM)


def memory_attention(q_m, mem, g_mem, w_mem_kv):
    B, S, _ = q_m.shape
    M = mem.shape[1]
    q = q_m.reshape(B, S, MEM_HEADS, MEM_HEAD_DIM)
    kv = rmsnorm(mem, g_mem) @ w_mem_kv
    k = kv[..., :MEM_W].reshape(B, M, MEM_HEADS, MEM_HEAD_DIM)
    v = kv[..., MEM_W:].reshape(B, M, MEM_HEADS, MEM_HEAD_DIM)
    s = jnp.einsum('bshd,bmhd->bhsm', q, k).astype(jnp.float32) * (MEM_HEAD_DIM ** -0.5)
    p = jax.nn.softmax(s, axis=-1).astype(v.dtype)
    return jnp.einsum('bhsm,bmhd->bshd', p, v).reshape(B, S, MEM_W)


def conv_ffn(h, w_up, cw, cb, w_down):
    S = h.shape[1]
    a = h @ w_up
    ap = jnp.pad(a, ((0, 0), (CONV_W - 1, 0), (0, 0)))
    c = sum(ap[:, k:k + S] * cw[k] for k in range(CONV_W)) + cb
    gate, val = c[..., :D_FF], c[..., D_FF:]
    return (jax.nn.silu(gate) * val) @ w_down


def setup_inputs(seed: int = 0) -> dict:
    key = jax.random.key(seed)
    ks = jax.random.split(key, 26)

    def nrm(k, shape, scale):
        return jax.random.normal(k, shape, jnp.float32) * scale

    def gain(k, shape):
        return 1.0 + 0.05 * jax.random.normal(k, shape, jnp.float32)

    D = D_MODEL
    return {
        "x": nrm(ks[0], (BATCH, SEQ, D), 1.0),
        "mem": nrm(ks[1], (BATCH, 256, D), 1.0),
        "positions": (jnp.arange(SEQ, dtype=jnp.int32)[None, :]
                      + jax.random.randint(ks[2], (BATCH, 1), 0, 1024, dtype=jnp.int32)),
        "g_mix": gain(ks[3], (DEPTH, D)),
        "g_ffn": gain(ks[4], (DEPTH, D)),
        "g_final": gain(ks[5], (D,)),
        "w_in_a": nrm(ks[6], (N_A, D, 2 * G_W + MEM_W), D ** -0.5),
        "g_v": gain(ks[7], (N_A, G_W)),
        "w_sp": nrm(ks[8], (N_A, G_HEADS, CHUNK, CHUNK), CHUNK ** -0.5),
        "b_sp": 1.0 + 0.1 * jax.random.normal(ks[9], (N_A, G_HEADS, CHUNK), jnp.float32),
        "g_kv": gain(ks[10], (D,)),
        "w_kv_a": nrm(ks[11], (D, KV_RANK + ROPE_DIM), D ** -0.5),
        "g_kv_lat": gain(ks[12], (KV_RANK,)),
        "w_in_b": nrm(ks[13], (N_B, D, Q_RANK + MEM_W), D ** -0.5),
        "g_q_lat": gain(ks[14], (N_B, Q_RANK)),
        "w_uq": nrm(ks[15], (N_B, Q_RANK, MLA_HEADS * (NOPE_DIM + ROPE_DIM)), Q_RANK ** -0.5),
        "w_uk": nrm(ks[16], (N_B, KV_RANK, MLA_HEADS, NOPE_DIM), KV_RANK ** -0.5),
        "w_uv": nrm(ks[17], (N_B, KV_RANK, MLA_HEADS, V_DIM), KV_RANK ** -0.5),
        "g_mem": gain(ks[18], (DEPTH, D)),
        "w_mem_kv": nrm(ks[19], (DEPTH, D, 2 * MEM_W), D ** -0.5),
        "w_out": nrm(ks[20], (DEPTH, MIX_W, D), MIX_W ** -0.5),
        "w_ffn_up": nrm(ks[21], (DEPTH, D, 2 * D_FF), D ** -0.5),
        "conv_w": nrm(ks[22], (DEPTH, CONV_W, 2 * D_FF), CONV_W ** -0.5),
        "conv_b": nrm(ks[23], (DEPTH, 2 * D_FF), 0.01),
        "w_ffn_down": nrm(ks[24], (DEPTH, D_FF, D), D_FF ** -0.5),
    }


def reference(x, mem, positions, g_mix, g_ffn, g_final, w_in_a, g_v, w_sp, b_sp,
              g_kv, w_kv_a, g_kv_lat, w_in_b, g_q_lat, w_uq, w_uk, w_uv,
              g_mem, w_mem_kv, w_out, w_ffn_up, conv_w, conv_b, w_ffn_down):
    cos, sin = rope_tables(positions, x.dtype)
    c_kv = None
    k_rope = None
    for l in range(DEPTH):
        if l == N_A:
            kv = rmsnorm(x, g_kv) @ w_kv_a
            c_kv = rmsnorm(kv[..., :KV_RANK], g_kv_lat)
            k_rope = apply_rope(kv[..., KV_RANK:], cos, sin)
        h = rmsnorm(x, g_mix[l])
        if l < N_A:
            z = h @ w_in_a[l]
            main = spatial_gating(z[..., :G_W], z[..., G_W:2 * G_W], g_v[l], w_sp[l], b_sp[l])
            q_m = z[..., 2 * G_W:]
        else:
            j = l - N_A
            z = h @ w_in_b[j]
            main = mla_attention(z[..., :Q_RANK], g_q_lat[j], w_uq[j], w_uk[j], w_uv[j],
                                 c_kv, k_rope, cos, sin)
            q_m = z[..., Q_RANK:]
        mo = memory_attention(q_m, mem, g_mem[l], w_mem_kv[l])
        x = x + jnp.concatenate([main, mo], axis=-1) @ w_out[l]
        x = x + conv_ffn(rmsnorm(x, g_ffn[l]), w_ffn_up[l], conv_w[l], conv_b[l], w_ffn_down[l])
    return rmsnorm(x, g_final)
```

```cpp
#include <hip/hip_runtime.h>
#include <hip/hip_cooperative_groups.h>
#include <cstdio>
#include <cstring>
namespace cg = cooperative_groups;

#define LAS __attribute__((address_space(3)))
typedef unsigned short bf16_t;
typedef short bf16x8 __attribute__((ext_vector_type(8)));
typedef short s16x4 __attribute__((ext_vector_type(4)));
typedef float f32x4 __attribute__((ext_vector_type(4)));
typedef float f32x2 __attribute__((ext_vector_type(2)));
typedef float f32x16 __attribute__((ext_vector_type(16)));
typedef unsigned u32x4 __attribute__((ext_vector_type(4)));
typedef unsigned u32x2 __attribute__((ext_vector_type(2)));

constexpr int DM = 2048, NB = 8, SEQ = 4096, MTOK = NB * SEQ, NMEM = 256, MMEM = NB * NMEM;
constexpr int GW = 1536, ZA_W = 3584, ZB_W = 1024, QW = 2304, KVW = 768, DFF = 5632, DFF2 = 11264;
constexpr float EPS = 1e-6f;
constexpr float LOG2E = 1.4426950408889634f;
constexpr float SC_MEM = 0.08838834764831845f * LOG2E;
constexpr float SC_MLA = 0.07216878364870323f * LOG2E;

constexpr size_t MiB = 1u << 20;
constexpr size_t WS_RS = 1 * MiB;
constexpr size_t WS_CS = 2 * MiB;
constexpr size_t WS_MEMB = 10 * MiB;
constexpr size_t WS_MEMK = 18 * MiB;
constexpr size_t WS_MEMVT = 26 * MiB;
constexpr size_t WS_W = 34 * MiB;
constexpr size_t WS_XB = 396 * MiB;
constexpr size_t WS_KVB = 524 * MiB;
constexpr size_t WS_KN = 572 * MiB;
constexpr size_t WS_VT = 668 * MiB;
constexpr size_t WS_HALO = 764 * MiB;
constexpr size_t WS_R = 852 * MiB;
constexpr size_t WS_CAT = WS_R + 224 * MiB;
constexpr size_t WS_Q = WS_R + 64 * MiB;
constexpr size_t WS_END = 1204 * MiB;

typedef __bf16 bf16x2_t __attribute__((ext_vector_type(2)));
__device__ __forceinline__ unsigned cvt_pk_bf16(float lo, float hi) { const f32x2 v = {lo, hi}; const bf16x2_t b = __builtin_convertvector(v, bf16x2_t); return __builtin_bit_cast(unsigned, b); }
__device__ __forceinline__ float wave_sum(float v) {
#pragma unroll
  for (int o = 1; o < 64; o <<= 1) v += __shfl_xor(v, o);
  return v;
}
__device__ __forceinline__ f32x2 gelu_pk(f32x2 v) {
  const f32x2 av = __builtin_elementwise_abs(v), d = av * 0.2316418882f + 1.0f;
  f32x2 t; t.x = __builtin_amdgcn_rcpf(d.x); t.y = __builtin_amdgcn_rcpf(d.y);
  f32x2 q = t * 0.5307027145f + (-0.7265760135f); q = q * t + 0.7107068705f; q = q * t + (-0.142248368f); q = q * t + 0.127414796f; q = q * t;
  const f32x2 s = (v * v) * (-0.72134752044f);
  f32x2 e; e.x = __builtin_amdgcn_exp2f(s.x); e.y = __builtin_amdgcn_exp2f(s.y);
  const f32x2 m = v * (q * e), r = v - m;
  f32x2 o; o.x = v.x < 0.f ? m.x : r.x; o.y = v.y < 0.f ? m.y : r.y; return o;
}
__device__ __forceinline__ f32x4 gelu4(f32x4 v) { f32x2 a = gelu_pk((f32x2){v[0], v[1]}), b = gelu_pk((f32x2){v[2], v[3]}); return (f32x4){a.x, a.y, b.x, b.y}; }
__device__ __forceinline__ float silu1(float x) { return x * __builtin_amdgcn_rcpf(1.0f + __builtin_amdgcn_exp2f(-x * LOG2E)); }
__device__ __forceinline__ float ror1(float v) { return __builtin_bit_cast(float, __builtin_amdgcn_update_dpp(0, __builtin_bit_cast(int, v), 0x121, 0xf, 0xf, false)); }
__device__ __forceinline__ float ror2(float v) { return __builtin_bit_cast(float, __builtin_amdgcn_update_dpp(0, __builtin_bit_cast(int, v), 0x122, 0xf, 0xf, false)); }
__device__ __forceinline__ f32x4 ror1v(f32x4 v) { return (f32x4){ror1(v[0]), ror1(v[1]), ror1(v[2]), ror1(v[3])}; }
__device__ __forceinline__ f32x4 ror2v(f32x4 v) { return (f32x4){ror2(v[0]), ror2(v[1]), ror2(v[2]), ror2(v[3])}; }

namespace pg8 {
constexpr int BM = 256, BK = 64, HALF = 128, HTB = HALF * BK * 2, STAGE_BYTES = 8 * HTB, NXCD = 8, WGM = 8;
__device__ __forceinline__ int lds_byte(int r, int c) { const int st = (r >> 4) * 2 + (c >> 5), rr = r & 15, cc = c & 31, ob = rr * 64 + cc * 2; return st * 1024 + (ob ^ (((ob >> 9) & 1) << 5)); }
__device__ __forceinline__ void stage_rc(int b, int& R, int& C) { const int st = b / 1024, sb = b % 1024, swz = sb ^ (((sb >> 9) & 1) << 5); R = (st >> 1) * 16 + swz / 64; C = (st & 1) * 32 + (swz % 64) / 2; }
__device__ __forceinline__ int perm32(int rho) { const int n = rho >> 4, i = rho & 15; return 8 * (i >> 2) + 4 * n + (i & 3); }
struct Unit { int pm, pn; };
struct Gemm { const bf16_t* A; const bf16_t* Bt; int M, N, K, lda, ldb; };
struct StaticOrder {
  int nM, nN, nwg, G, c;
  __device__ void init(int M, int N, int G_, int c_) { nM = M / BM; nN = N / BM; nwg = nM * nN; G = G_; c = c_; }
  __device__ bool next(int i, Unit& u) const {
    const long L = (long)i * G + c; if (L >= nwg) return false;
    int wgid = (int)L; { const int q = nwg / NXCD, r = nwg % NXCD, xcd = wgid % NXCD, off = wgid / NXCD; wgid = (xcd < r ? xcd * (q + 1) : r * (q + 1) + (xcd - r) * q) + off; }
    const int nig = WGM * nN, gid = wgid / nig, fm = gid * WGM, gsz = (nM - fm) < WGM ? (nM - fm) : WGM;
    u.pm = fm + ((wgid % nig) % gsz); u.pn = (wgid % nig) / gsz; return true;
  }
};

template <class Epi>
__device__ __forceinline__ void gemm_phase(LAS unsigned char* lds, const Gemm g, const StaticOrder& S, const Epi& E) {
  int tid_o = threadIdx.x; asm volatile("" : "+v"(tid_o));
  const int tid = tid_o, wid = __builtin_amdgcn_readfirstlane(tid >> 6), lane = tid & 63, wr = wid >> 2, wc = wid & 3, fr = lane & 15, fq = lane >> 4;
  const int K = g.K, nt = K / BK;
  unsigned voffA[2], voffB[2];
#pragma unroll
  for (int i = 0; i < 2; ++i) { int R, C; stage_rc(tid * 16 + i * 8192, R, C); const int Rb = Epi::PERM ? ((R & ~31) + perm32(R & 31)) : R;
    voffA[i] = (unsigned)(R * g.lda + C) * 2u; voffB[i] = (unsigned)(Rb * g.ldb + C) * 2u; }
  const size_t kstep = (size_t)(BK * 2);
  const size_t hstepA = (size_t)HALF * g.lda * 2, hstepB = (size_t)HALF * g.ldb * 2;
  const size_t tstepA = 2 * hstepA, tstepB = 2 * hstepB;
  const unsigned ldsw = (unsigned)wid * 1024u;
  const int aoff = lds_byte(wr * 64 + fr, fq * 8), boff = lds_byte(wc * 32 + fr, fq * 8);
#define PG8_SA(b, h) (((b) * 2 + (h)) * HTB)
#define PG8_SB(b, h) ((4 + (b) * 2 + (h)) * HTB)
#define PG8_STAGE(bufoff, gbase, voff) do { _Pragma("unroll") for (int _i = 0; _i < 2; ++_i) \
    __builtin_amdgcn_global_load_lds((const unsigned*)((const char*)(gbase) + (voff)[_i]), (LAS unsigned*)(lds + (bufoff) + ldsw + _i * 8192), 16, 0, 0); } while (0)
#define PG8_LDA(dst, b, h) do { _Pragma("unroll") for (int m = 0; m < 4; ++m) _Pragma("unroll") for (int k = 0; k < 2; ++k) dst[m][k] = *(const LAS bf16x8*)(lds + PG8_SA(b, h) + aoff + m * 2048 + k * 1024); } while (0)
#define PG8_LDB(dst, b, h) do { _Pragma("unroll") for (int n = 0; n < 2; ++n) _Pragma("unroll") for (int k = 0; k < 2; ++k) dst[n][k] = *(const LAS bf16x8*)(lds + PG8_SB(b, h) + boff + n * 2048 + k * 1024); } while (0)
#define PG8_MMA(ai, bj, At, Bt) do { __builtin_amdgcn_s_setprio(1); _Pragma("unroll") for (int m = 0; m < 4; ++m) _Pragma("unroll") for (int n = 0; n < 2; ++n) _Pragma("unroll") for (int k = 0; k < 2; ++k) \
    acc[ai][bj][m][n] = __builtin_amdgcn_mfma_f32_16x16x32_bf16(Bt[n][k], At[m][k], acc[ai][bj][m][n], 0, 0, 0); __builtin_amdgcn_s_setprio(0); } while (0)
#define PG8_WAIT_V(n) asm volatile("s_waitcnt vmcnt(" #n ")" ::: "memory")
#define PG8_WAIT_L(n) asm volatile("s_waitcnt lgkmcnt(" #n ")" ::: "memory")
#define PG8_BAR __builtin_amdgcn_s_barrier()
#define PG8_SCHED __builtin_amdgcn_sched_barrier(0)
  Unit cur, nxt; int ui = 0;
  if (!S.next(0, cur)) return;
  f32x4 acc[2][2][4][2];
#pragma unroll
  for (int a = 0; a < 2; ++a)
#pragma unroll
    for (int b = 0; b < 2; ++b)
#pragma unroll
      for (int m = 0; m < 4; ++m)
#pragma unroll
        for (int n = 0; n < 2; ++n) acc[a][b][m][n] = (f32x4){0.f, 0.f, 0.f, 0.f};
  bf16x8 At[4][2], B0[2][2], B1[2][2];
  const char* cA = (const char*)g.A + (size_t)cur.pm * tstepA; const char* cB = (const char*)g.Bt + (size_t)cur.pn * tstepB;
  PG8_STAGE(PG8_SB(0, 0), cB, voffB); PG8_STAGE(PG8_SA(0, 0), cA, voffA); PG8_STAGE(PG8_SB(0, 1), cB + hstepB, voffB); PG8_STAGE(PG8_SA(0, 1), cA + hstepA, voffA);
  if (wr == 1) PG8_BAR;
  PG8_WAIT_V(4); PG8_BAR;
  PG8_STAGE(PG8_SB(1, 0), cB + kstep, voffB); PG8_STAGE(PG8_SA(1, 0), cA + kstep, voffA); PG8_STAGE(PG8_SB(1, 1), cB + hstepB + kstep, voffB);
  PG8_WAIT_V(6); PG8_BAR;
  for (;;) {
    const bool has_next = S.next(ui + 1, nxt);
    const char* nA = has_next ? (const char*)g.A + (size_t)nxt.pm * tstepA : cA; const char* nB = has_next ? (const char*)g.Bt + (size_t)nxt.pn * tstepB : cB;
    for (int t = 0; t < nt; t += 2) {
      const bool last = (t == nt - 2);
      const char* a1 = cA + (size_t)(t + 1) * kstep;
      const char* a2 = last ? nA : cA + (size_t)(t + 2) * kstep; const char* b2 = last ? nB : cB + (size_t)(t + 2) * kstep;
      const char* a3 = a2 + kstep; const char* b3 = b2 + kstep;
      PG8_LDB(B0, 0, 0); PG8_SCHED; PG8_LDA(At, 0, 0); PG8_STAGE(PG8_SA(1, 1), a1 + hstepA, voffA);
      PG8_WAIT_L(8); PG8_BAR; PG8_WAIT_L(0); PG8_MMA(0, 0, At, B0); PG8_BAR; PG8_SCHED;
      PG8_LDB(B1, 0, 1); PG8_STAGE(PG8_SB(0, 0), b2, voffB);
      PG8_BAR; PG8_WAIT_L(0); PG8_MMA(0, 1, At, B1); PG8_BAR;
      PG8_LDA(At, 0, 1); PG8_STAGE(PG8_SA(0, 0), a2, voffA);
      PG8_BAR; PG8_WAIT_L(0); PG8_MMA(1, 0, At, B0); PG8_BAR; PG8_SCHED;
      PG8_STAGE(PG8_SB(0, 1), b2 + hstepB, voffB);
      PG8_WAIT_V(6); PG8_BAR; PG8_MMA(1, 1, At, B1); PG8_BAR;
      PG8_LDB(B0, 1, 0); PG8_SCHED; PG8_LDA(At, 1, 0); PG8_STAGE(PG8_SA(0, 1), a2 + hstepA, voffA);
      PG8_WAIT_L(8); PG8_BAR; PG8_WAIT_L(0); PG8_MMA(0, 0, At, B0); PG8_BAR; PG8_SCHED;
      PG8_LDB(B1, 1, 1); PG8_STAGE(PG8_SB(1, 0), b3, voffB);
      PG8_BAR; PG8_WAIT_L(0); PG8_MMA(0, 1, At, B1); PG8_BAR;
      PG8_LDA(At, 1, 1); PG8_STAGE(PG8_SA(1, 0), a3, voffA);
      PG8_BAR; PG8_WAIT_L(0); PG8_MMA(1, 0, At, B0); PG8_BAR; PG8_SCHED;
      PG8_STAGE(PG8_SB(1, 1), b3 + hstepB, voffB);
      PG8_WAIT_V(6); PG8_BAR; PG8_MMA(1, 1, At, B1); PG8_BAR;
    }
    E(acc, cur, wr, wc, fr, fq);
    if (!has_next) break;
#pragma unroll
    for (int a = 0; a < 2; ++a)
#pragma unroll
      for (int b = 0; b < 2; ++b)
#pragma unroll
        for (int m = 0; m < 4; ++m)
#pragma unroll
          for (int n = 0; n < 2; ++n) acc[a][b][m][n] = (f32x4){0.f, 0.f, 0.f, 0.f};
    cur = nxt; cA = nA; cB = nB; ++ui;
  }
  PG8_WAIT_V(0);
  if (wr == 0) PG8_BAR;
  PG8_BAR;
#undef PG8_SA
#undef PG8_SB
#undef PG8_STAGE
#undef PG8_LDA
#undef PG8_LDB
#undef PG8_MMA
#undef PG8_WAIT_V
#undef PG8_WAIT_L
#undef PG8_BAR
#undef PG8_SCHED
}
}
using pg8::Unit; using pg8::HALF;
typedef f32x4 Acc[2][2][4][2];

struct EpiG {
  static constexpr bool PERM = true;
  bf16_t* O; int ldc;
  const float* rss; float rinvD;
  const float* css; float cinvD;
  int gelu_hi;
  int ss_lo, ss_hi; float* ssacc;
  int rope_mode;
  const f32x2* cs;
  int sc_lo; float sc_val;
  __device__ __forceinline__ void operator()(Acc& acc, const Unit& u, int wr, int wc, int fr, int fq) const {
    const int ct = u.pn * 256;
    const bool do_gelu = ct < gelu_hi, do_ss = (ct >= ss_lo && ct < ss_hi), do_sc = ct >= sc_lo;
#pragma unroll
    for (int ai = 0; ai < 2; ++ai)
#pragma unroll
      for (int m = 0; m < 4; ++m) {
        const int row = u.pm * 256 + ai * HALF + wr * 64 + m * 16 + fr;
        const float rs = rss ? __builtin_amdgcn_rsqf(rss[row] * rinvD + EPS) : 1.0f;
        float ss = 0.f;
#pragma unroll
        for (int bj = 0; bj < 2; ++bj) {
          const int c0 = ct + bj * HALF + wc * 32 + 8 * fq;
          f32x4 v0 = acc[ai][bj][m][0] * rs, v1 = acc[ai][bj][m][1] * rs;
          if (css) {
            const f32x4 q0 = *(const f32x4*)(css + c0), q1 = *(const f32x4*)(css + c0 + 4);
#pragma unroll
            for (int j = 0; j < 4; ++j) { v0[j] *= __builtin_amdgcn_rsqf(q0[j] * cinvD + EPS); v1[j] *= __builtin_amdgcn_rsqf(q1[j] * cinvD + EPS); }
          }
          if (do_gelu) { v0 = gelu4(v0); v1 = gelu4(v1); }
          if (do_ss) ss += (v0[0] * v0[0] + v0[1] * v0[1]) + (v0[2] * v0[2] + v0[3] * v0[3]) + (v1[0] * v1[0] + v1[1] * v1[1]) + (v1[2] * v1[2] + v1[3] * v1[3]);
          int roff = -1;
          if (rope_mode == 1) { const int d = c0 % 192; if (d >= 128) roff = d - 128; }
          else if (rope_mode == 2) { if (c0 >= 512 && c0 < 576) roff = c0 - 512; }
          if (roff >= 0) {
            const f32x2* t = cs + (size_t)row * 32 + (roff >> 1);
            const f32x2 t0 = t[0], t1 = t[1], t2 = t[2], t3 = t[3];
            f32x4 w0, w1;
            w0[0] = v0[0] * t0.x - v0[1] * t0.y; w0[1] = v0[1] * t0.x + v0[0] * t0.y;
            w0[2] = v0[2] * t1.x - v0[3] * t1.y; w0[3] = v0[3] * t1.x + v0[2] * t1.y;
            w1[0] = v1[0] * t2.x - v1[1] * t2.y; w1[1] = v1[1] * t2.x + v1[0] * t2.y;
            w1[2] = v1[2] * t3.x - v1[3] * t3.y; w1[3] = v1[3] * t3.x + v1[2] * t3.y;
            v0 = w0; v1 = w1;
          }
          if (do_sc) { v0 = v0 * sc_val; v1 = v1 * sc_val; }
          u32x4 w; w.x = cvt_pk_bf16(v0[0], v0[1]); w.y = cvt_pk_bf16(v0[2], v0[3]); w.z = cvt_pk_bf16(v1[0], v1[1]); w.w = cvt_pk_bf16(v1[2], v1[3]);
          *(u32x4*)(O + (size_t)row * ldc + c0) = w;
        }
        if (do_ss) { ss += __shfl_xor(ss, 16); ss += __shfl_xor(ss, 32); if (fq == 0) atomicAdd(ssacc + row, ss); }
      }
  }
};

struct EpiRes {
  static constexpr bool PERM = false;
  const float* xold; float* xnew; bf16_t* xb; float* ssacc;
  __device__ __forceinline__ void operator()(Acc& acc, const Unit& u, int wr, int wc, int fr, int fq) const {
    const int col0 = u.pn * 256 + wc * 32 + 4 * fq;
#pragma unroll
    for (int ai = 0; ai < 2; ++ai)
#pragma unroll
      for (int m = 0; m < 4; ++m) {
        const int row = u.pm * 256 + ai * HALF + wr * 64 + m * 16 + fr;
        float ss = 0.f;
#pragma unroll
        for (int bj = 0; bj < 2; ++bj)
#pragma unroll
          for (int n = 0; n < 2; ++n) {
            const size_t off = (size_t)row * DM + col0 + bj * HALF + n * 16;
            const f32x4 v = *(const f32x4*)(xold + off) + acc[ai][bj][m][n];
            *(f32x4*)(xnew + off) = v;
            u32x2 w; w.x = cvt_pk_bf16(v[0], v[1]); w.y = cvt_pk_bf16(v[2], v[3]);
            *(u32x2*)(xb + off) = w;
            ss += (v[0] * v[0] + v[1] * v[1]) + (v[2] * v[2] + v[3] * v[3]);
          }
        ss += __shfl_xor(ss, 16); ss += __shfl_xor(ss, 32);
        if (fq == 0) atomicAdd(ssacc + row, ss);
      }
  }
};

struct EpiUp {
  static constexpr bool PERM = true;
  bf16_t* g; float* halo; const float* rss; const float* cw; const float* cb;
  __device__ __forceinline__ void operator()(Acc& acc, const Unit& u, int wr, int wc, int fr, int fq) const {
    const int rowb = u.pm * 256 + wr * 64;
    const int c0 = u.pn * 128 + wc * 32 + 8 * fq;
#pragma unroll
    for (int ai = 0; ai < 2; ++ai)
#pragma unroll
      for (int m = 0; m < 4; ++m) {
        const float r = __builtin_amdgcn_rsqf(rss[rowb + ai * HALF + m * 16 + fr] * (1.0f / DM) + EPS);
#pragma unroll
        for (int bj = 0; bj < 2; ++bj)
#pragma unroll
          for (int n = 0; n < 2; ++n) acc[ai][bj][m][n] = acc[ai][bj][m][n] * r;
      }
#pragma unroll
    for (int n = 0; n < 2; ++n) {
      const int cc = c0 + 4 * n;
      const f32x4 wg0 = *(const f32x4*)(cw + cc), wg1 = *(const f32x4*)(cw + DFF2 + cc), wg2 = *(const f32x4*)(cw + 2 * DFF2 + cc), bg = *(const f32x4*)(cb + cc);
      const f32x4 wv0 = *(const f32x4*)(cw + DFF + cc), wv1 = *(const f32x4*)(cw + DFF2 + DFF + cc), wv2 = *(const f32x4*)(cw + 2 * DFF2 + DFF + cc), bv = *(const f32x4*)(cb + DFF + cc);
#pragma unroll
      for (int ai = 0; ai < 2; ++ai) {
        f32x4 g1p = (f32x4){0.f, 0.f, 0.f, 0.f}, g2p = g1p, v1p = g1p, v2p = g1p;
#pragma unroll
        for (int m = 0; m < 4; ++m) {
          const f32x4 G = acc[ai][0][m][n], V = acc[ai][1][m][n];
          const f32x4 g1 = ror1v(G), g2 = ror2v(G), v1 = ror1v(V), v2 = ror2v(V);
          const f32x4 pg1 = fr >= 1 ? g1 : g1p, pg2 = fr >= 2 ? g2 : g2p, pv1 = fr >= 1 ? v1 : v1p, pv2 = fr >= 2 ? v2 : v2p;
          const f32x4 cgt = wg2 * G + wg1 * pg1 + wg0 * pg2 + bg;
          const f32x4 cvl = wv2 * V + wv1 * pv1 + wv0 * pv2 + bv;
          g1p = g1; g2p = g2; v1p = v1; v2p = v2;
          const int row = rowb + ai * HALF + m * 16 + fr;
          if (m > 0 || fr >= 2) {
            u32x2 w; w.x = cvt_pk_bf16(silu1(cgt[0]) * cvl[0], silu1(cgt[1]) * cvl[1]); w.y = cvt_pk_bf16(silu1(cgt[2]) * cvl[2], silu1(cgt[3]) * cvl[3]);
            *(u32x2*)(g + (size_t)row * DFF + cc) = w;
          }
          int slot = -1;
          if (m == 0 && fr < 2) slot = fr;
          if (m == 3 && fr >= 14) slot = fr - 12;
          if (slot >= 0) {
            float* hp = halo + ((size_t)(row >> 6) * 4 + slot) * DFF2 + cc;
            *(f32x4*)hp = G; *(f32x4*)(hp + DFF) = V;
          }
        }
      }
    }
  }
};

constexpr int ATT_KBUF = 64 * 400, ATT_VROWB = 136, ATT_VBUF = 128 * ATT_VROWB, ATT_BUF = ATT_KBUF + ATT_VBUF;
template <int DQK, bool CAUSAL>
__device__ __forceinline__ void attn_unit(LAS unsigned char* lds, const bf16_t* Q, int ldq, const bf16_t* K1, int ldk1, const bf16_t* K2, int ldk2,
                                          const bf16_t* VT, int ldv, int ntiles, int q0, bf16_t* O, int ldo) {
  constexpr int KROWB = (DQK + 8) * 2, NKS = DQK / 16, CPR = DQK / 8, NKCH = 64 * CPR / 512;
  int tid_o = threadIdx.x; asm volatile("" : "+v"(tid_o));
  const int tid = tid_o, wid = __builtin_amdgcn_readfirstlane(tid >> 6), lane = tid & 63, r32 = lane & 31, hi = lane >> 5;
  bf16x8 qf[NKS];
  { const bf16_t* qp = Q + (size_t)(wid * 32 + r32) * ldq + hi * 8;
#pragma unroll
    for (int ks = 0; ks < NKS; ++ks) qf[ks] = *(const bf16x8*)(qp + ks * 16); }
  u32x4 kreg[NKCH], vreg[2];
#define ATT_GLOAD(t_) do { const int k0_ = (t_) * 64; \
    _Pragma("unroll") for (int i = 0; i < NKCH; ++i) { const int ch = tid + i * 512, kr = ch / CPR, kc = ch - kr * CPR; \
      const bf16_t* src = (DQK == 128 || kc < 16) ? K1 + (size_t)(k0_ + kr) * ldk1 + kc * 8 : K2 + (size_t)(k0_ + kr) * ldk2 + (kc - 16) * 8; \
      kreg[i] = *(const u32x4*)src; } \
    _Pragma("unroll") for (int i = 0; i < 2; ++i) { const int ch = tid + i * 512, d = ch >> 3, cc = ch & 7; vreg[i] = *(const u32x4*)(VT + (size_t)d * ldv + k0_ + cc * 8); } } while (0)
#define ATT_LWRITE(buf_) do { LAS unsigned char* kb_ = lds + (buf_) * ATT_BUF; \
    _Pragma("unroll") for (int i = 0; i < NKCH; ++i) { const int ch = tid + i * 512, kr = ch / CPR, kc = ch - kr * CPR; *(LAS u32x4*)(kb_ + kr * KROWB + kc * 16) = kreg[i]; } \
    _Pragma("unroll") for (int i = 0; i < 2; ++i) { const int ch = tid + i * 512, d = ch >> 3, cc = ch & 7; LAS unsigned char* p = kb_ + ATT_KBUF + d * ATT_VROWB + cc * 16; \
      *(LAS u32x2*)p = (u32x2){vreg[i].x, vreg[i].y}; *(LAS u32x2*)(p + 8) = (u32x2){vreg[i].z, vreg[i].w}; } } while (0)
  f32x16 o[4];
#pragma unroll
  for (int d = 0; d < 4; ++d)
#pragma unroll
    for (int i = 0; i < 16; ++i) o[d][i] = 0.f;
  float mrow = -INFINITY, lsum = 0.f;
  const int qabs = q0 + wid * 32 + r32, qlo = q0 + wid * 32;
  ATT_GLOAD(0); ATT_LWRITE(0); __syncthreads();
  for (int t = 0; t < ntiles; ++t) {
    const int buf = t & 1;
    if (t + 1 < ntiles) ATT_GLOAD(t + 1);
    const int k0 = t * 64;
    if (!CAUSAL || k0 <= qlo + 31) {
      const LAS unsigned char* kb = lds + buf * ATT_BUF;
      f32x16 s0, s1;
#pragma unroll
      for (int i = 0; i < 16; ++i) { s0[i] = 0.f; s1[i] = 0.f; }
#pragma unroll
      for (int ks = 0; ks < NKS; ++ks) {
        const bf16x8 ka = *(const LAS bf16x8*)(kb + r32 * KROWB + ks * 32 + hi * 16);
        const bf16x8 kc = *(const LAS bf16x8*)(kb + (32 + r32) * KROWB + ks * 32 + hi * 16);
        s0 = __builtin_amdgcn_mfma_f32_32x32x16_bf16(ka, qf[ks], s0, 0, 0, 0);
        s1 = __builtin_amdgcn_mfma_f32_32x32x16_bf16(kc, qf[ks], s1, 0, 0, 0);
      }
      if (CAUSAL && k0 + 63 > qlo) {
#pragma unroll
        for (int i = 0; i < 16; ++i) { const int kv = k0 + (i & 3) + 8 * (i >> 2) + 4 * hi;
          if (kv > qabs) s0[i] = -INFINITY; if (kv + 32 > qabs) s1[i] = -INFINITY; }
      }
      float mx = s0[0];
#pragma unroll
      for (int i = 1; i < 16; ++i) mx = fmaxf(mx, s0[i]);
#pragma unroll
      for (int i = 0; i < 16; ++i) mx = fmaxf(mx, s1[i]);
      mx = fmaxf(mx, __shfl_xor(mx, 32));
      const float mnew = fmaxf(mrow, mx);
      const float alpha = __builtin_amdgcn_exp2f(mrow - mnew);
      mrow = mnew;
      float ps = 0.f;
#pragma unroll
      for (int i = 0; i < 16; ++i) { s0[i] = __builtin_amdgcn_exp2f(s0[i] - mnew); s1[i] = __builtin_amdgcn_exp2f(s1[i] - mnew); ps += s0[i] + s1[i]; }
      lsum = lsum * alpha + ps;
#pragma unroll
      for (int d = 0; d < 4; ++d)
#pragma unroll
        for (int i = 0; i < 16; ++i) o[d][i] *= alpha;
      bf16x8 pa[4];
#pragma unroll
      for (int s = 0; s < 4; ++s) {
        u32x4 w;
        if (s < 2) { w.x = cvt_pk_bf16(s0[8 * s + 0], s0[8 * s + 1]); w.y = cvt_pk_bf16(s0[8 * s + 2], s0[8 * s + 3]); w.z = cvt_pk_bf16(s0[8 * s + 4], s0[8 * s + 5]); w.w = cvt_pk_bf16(s0[8 * s + 6], s0[8 * s + 7]); }
        else { const int b = 8 * (s - 2); w.x = cvt_pk_bf16(s1[b + 0], s1[b + 1]); w.y = cvt_pk_bf16(s1[b + 2], s1[b + 3]); w.z = cvt_pk_bf16(s1[b + 4], s1[b + 5]); w.w = cvt_pk_bf16(s1[b + 6], s1[b + 7]); }
        pa[s] = __builtin_bit_cast(bf16x8, w);
      }
      const LAS unsigned char* vb = kb + ATT_KBUF;
#pragma unroll
      for (int d = 0; d < 4; ++d)
#pragma unroll
        for (int s = 0; s < 4; ++s) {
          const LAS unsigned char* p = vb + (32 * d + r32) * ATT_VROWB + (16 * s + 4 * hi) * 2;
          const u32x2 lo = *(const LAS u32x2*)p, hh = *(const LAS u32x2*)(p + 16);
          const bf16x8 vf = __builtin_bit_cast(bf16x8, (u32x4){lo.x, lo.y, hh.x, hh.y});
          o[d] = __builtin_amdgcn_mfma_f32_32x32x16_bf16(vf, pa[s], o[d], 0, 0, 0);
        }
    }
    if (t + 1 < ntiles) ATT_LWRITE(buf ^ 1);
    __syncthreads();
  }
#undef ATT_GLOAD
#undef ATT_LWRITE
  const float inv = 1.0f / (lsum + __shfl_xor(lsum, 32));
  bf16_t* op = O + (size_t)(wid * 32 + r32) * ldo + 4 * hi;
#pragma unroll
  for (int d = 0; d < 4; ++d)
#pragma unroll
    for (int ig = 0; ig < 4; ++ig) {
      u32x2 w; w.x = cvt_pk_bf16(o[d][4 * ig] * inv, o[d][4 * ig + 1] * inv); w.y = cvt_pk_bf16(o[d][4 * ig + 2] * inv, o[d][4 * ig + 3] * inv);
      *(u32x2*)(op + 32 * d + 8 * ig) = w;
    }
}

constexpr int NWD = 27;
struct WDesc { const float* src; const float* scale; bf16_t* dst; int K, Ns, Nd, kind, item0, pad; };
struct Args { const float* in[25]; float* out; unsigned char* ws; WDesc wd[NWD]; int nitems; int pad; };

__device__ __forceinline__ int srccol(int kind, int n) {
  if (kind == 0) return n;
  if (kind == 1) { if (n < 512) return n; if (n < 576) { const int r = n - 512; return 512 + ((r & 1) ? 32 : 0) + (r >> 1); } return -1; }
  if (kind == 2) { const int h = n / 192, d = n - h * 192; if (d < 128) return n; const int r = d - 128; return h * 192 + 128 + ((r & 1) ? 32 : 0) + (r >> 1); }
  { const int t = n >> 8, w = n & 255; return (w >> 7) * DFF + 128 * t + (w & 127); }
}

constexpr int LDS_BYTES = 132 * 1024;
#ifndef ONLY
#define ONLY 0
#endif
#define EN(k) (ONLY == 0 || ONLY == (k))
typedef __attribute__((address_space(4))) const Args CArgs;
#define DERIVE_PTRS(ap) \
  unsigned char* ws = (ap)->ws; \
  float* rsA = (float*)(ws + WS_RS); float* rsB = rsA + MTOK; float* rsV = rsB + MTOK; float* rsQ = rsV + MTOK; float* rsKV = rsQ + MTOK; float* rsM = rsKV + MTOK; \
  f32x2* cs = (f32x2*)(ws + WS_CS); \
  bf16_t* memb = (bf16_t*)(ws + WS_MEMB); bf16_t* memk = (bf16_t*)(ws + WS_MEMK); bf16_t* memvt = (bf16_t*)(ws + WS_MEMVT); \
  bf16_t* xb = (bf16_t*)(ws + WS_XB); bf16_t* kvb = (bf16_t*)(ws + WS_KVB); bf16_t* kn = (bf16_t*)(ws + WS_KN); bf16_t* vT = (bf16_t*)(ws + WS_VT); \
  float* halo = (float*)(ws + WS_HALO); \
  bf16_t* gbuf = (bf16_t*)(ws + WS_R); bf16_t* zbuf = (bf16_t*)(ws + WS_R); bf16_t* cat = (bf16_t*)(ws + WS_CAT); bf16_t* qbuf = (bf16_t*)(ws + WS_Q); \
  const float* x_in = (ap)->in[0]; float* xo = (ap)->out; \
  (void)rsA; (void)rsB; (void)rsV; (void)rsQ; (void)rsKV; (void)rsM; (void)cs; (void)memb; (void)memk; (void)memvt; (void)xb; (void)kvb; (void)kn; (void)vT; (void)halo; (void)gbuf; (void)zbuf; (void)cat; (void)qbuf; (void)x_in; (void)xo;
__global__ void __launch_bounds__(512, 2) yoco_fwd(Args a) {
  extern __shared__ __attribute__((aligned(16))) unsigned char lds_raw[];
  LAS unsigned char* lds = (LAS unsigned char*)lds_raw;
  cg::grid_group grid = cg::this_grid();
#define DERIVE_IDS \
  int tid_o = threadIdx.x; asm volatile("" : "+v"(tid_o)); \
  const int tid = tid_o, lane = tid & 63, wave = __builtin_amdgcn_readfirstlane(tid >> 6); \
  const int G = gridDim.x, bx = blockIdx.x; \
  const int vcu = (G % 8 == 0) ? (bx % 8) * (G / 8) + bx / 8 : bx; \
  const int gw = vcu * 8 + wave, NGW = G * 8; \
  const size_t gtid = (size_t)bx * 512 + tid, NGT = (size_t)G * 512; \
  (void)lane; (void)wave; (void)vcu; (void)gw; (void)NGW; (void)gtid; (void)NGT;
  {
    const Args* ap = &a; DERIVE_PTRS(ap)
    DERIVE_IDS
    LAS float* scr = (LAS float*)(lds + wave * 8448);
    for (int it = gw; it < a.nitems; it += NGW) {
      int di = 0;
#pragma unroll 1
      for (int j = 1; j < NWD; ++j) if (it >= a.wd[j].item0) di = j;
      const float* src = a.wd[di].src; const float* scale = a.wd[di].scale; bf16_t* dst = a.wd[di].dst;
      const int K = a.wd[di].K, Ns = a.wd[di].Ns, Nd = a.wd[di].Nd, kind = a.wd[di].kind, item = it - a.wd[di].item0;
      const int nblk = Nd / 32, kb = item / nblk, nb = item - kb * nblk, k0 = 64 * kb, n0 = 32 * nb;
      const int sc = srccol(kind, n0 + (lane & 31));
#pragma unroll 8
      for (int i = 0; i < 32; ++i) { const int kk = 2 * i + (lane >> 5); float v = 0.f; if (sc >= 0) v = src[(size_t)(k0 + kk) * Ns + sc]; if (scale) v *= scale[k0 + kk]; scr[kk * 33 + (lane & 31)] = v; }
      asm volatile("s_waitcnt lgkmcnt(0)" ::: "memory");
      const int c = lane & 7;
#pragma unroll
      for (int j = 0; j < 4; ++j) { const int n = (lane >> 3) + 8 * j; const LAS float* s = scr + (8 * c) * 33 + n;
        u32x4 o; o.x = cvt_pk_bf16(s[0 * 33], s[1 * 33]); o.y = cvt_pk_bf16(s[2 * 33], s[3 * 33]); o.z = cvt_pk_bf16(s[4 * 33], s[5 * 33]); o.w = cvt_pk_bf16(s[6 * 33], s[7 * 33]);
        *(u32x4*)(dst + (size_t)(n0 + n) * K + k0 + 8 * c) = o; }
      asm volatile("s_waitcnt lgkmcnt(0)" ::: "memory");
    }
    for (int r = gw; r < MTOK + MMEM; r += NGW) {
      const bool ism = r >= MTOK; const int rr = ism ? r - MTOK : r;
      const f32x4* xr = (const f32x4*)((ism ? a.in[1] : x_in) + (size_t)rr * DM) + lane;
      u32x2* o8 = (u32x2*)((ism ? memb : xb) + (size_t)rr * DM) + lane;
      float s = 0.f;
#pragma unroll
      for (int j = 0; j < 8; ++j) { const f32x4 v = xr[64 * j]; s += (v[0] * v[0] + v[1] * v[1]) + (v[2] * v[2] + v[3] * v[3]); u32x2 w; w.x = cvt_pk_bf16(v[0], v[1]); w.y = cvt_pk_bf16(v[2], v[3]); o8[64 * j] = w; }
      s = wave_sum(s);
      if (lane == 0) (ism ? rsM : rsA)[rr] = s;
    }
    const int* pos = (const int*)a.in[2];
    for (size_t i = gtid; i < (size_t)MTOK * 32; i += NGT) {
      const int row = (int)(i >> 5), j = (int)(i & 31);
      const float inv = 1.0f / powf(10000.0f, (float)(2 * j) / 64.0f);
      const float ang = (float)pos[row] * inv;
      const double rev = (double)ang * 0.15915494309189535;
      const float fr = (float)(rev - floor(rev));
      cs[i] = (f32x2){__builtin_amdgcn_cosf(fr), __builtin_amdgcn_sinf(fr)};
    }
    for (size_t i = gtid; i < (size_t)MTOK * 4; i += NGT) rsB[i] = 0.f;
  }
  grid.sync();

  pg8::StaticOrder S;
#pragma unroll 1
  for (int l = -1; l < 4; ++l) {
    const bool isA = l < 2; const int j = l - 2;
#pragma unroll 1
    for (int s = 0; s < 10; ++s) {
      CArgs* ap = (CArgs*)__builtin_amdgcn_kernarg_segment_ptr(); asm volatile("" : "+s"(ap));
      DERIVE_PTRS(ap)
      DERIVE_IDS
      int type = 0; bool sync = false;
      pg8::Gemm g{nullptr, nullptr, 0, 0, 0, 0, 0}; int corder = bx;
      EpiG eg{nullptr, 0, nullptr, 0.f, nullptr, 0.f, 0, 0, 0, nullptr, 0, nullptr, 1 << 30, 1.f};
      EpiRes er{nullptr, nullptr, xb, nullptr};
      if (l < 0) {
        if (s < 8) {
          const int ml = s >> 1; const bf16_t* wt = ap->wd[9 + ml].dst;
          type = 1; corder = (bx + 16 * s) % G; sync = (s == 7);
          if (!(s & 1)) { g = pg8::Gemm{memb, wt, MMEM, 512, DM, DM, DM}; eg.O = memk + (size_t)ml * MMEM * 512; eg.ldc = 512; eg.rss = rsM; eg.rinvD = 1.0f / DM; }
          else { g = pg8::Gemm{wt + (size_t)512 * DM, memb, 512, MMEM, DM, DM, DM}; eg.O = memvt + (size_t)ml * 512 * MMEM; eg.ldc = MMEM; eg.css = rsM; eg.cinvD = 1.0f / DM; }
        }
      } else {
        switch (s) {
          case 0: if (l == 2) { type = 1; sync = true;
              g = pg8::Gemm{xb, ap->wd[4].dst, MTOK, KVW, DM, DM, DM};
              eg.O = kvb; eg.ldc = KVW; eg.rss = rsA; eg.rinvD = 1.0f / DM; eg.ss_lo = 0; eg.ss_hi = 512; eg.ssacc = rsKV; eg.rope_mode = 2; eg.cs = cs; } break;
          case 1: type = 1; eg.O = zbuf; eg.rss = rsA; eg.rinvD = 1.0f / DM; eg.sc_val = SC_MEM;
            if (isA) { sync = true; g = pg8::Gemm{xb, ap->wd[l].dst, MTOK, ZA_W, DM, DM, DM}; eg.ldc = ZA_W; eg.gelu_hi = 2 * GW; eg.ss_lo = GW; eg.ss_hi = 2 * GW; eg.ssacc = rsV; eg.sc_lo = 2 * GW; }
            else { g = pg8::Gemm{xb, ap->wd[2 + j].dst, MTOK, ZB_W, DM, DM, DM}; eg.ldc = ZB_W; eg.ss_lo = 0; eg.ss_hi = 512; eg.ssacc = rsQ; eg.sc_lo = 512; }
            break;
          case 2: if (!isA) { type = 1; g = pg8::Gemm{kvb, ap->wd[5 + j].dst, MTOK, GW, 512, KVW, 512}; eg.O = kn; eg.ldc = GW; eg.rss = rsKV; eg.rinvD = 1.0f / 512; } break;
          case 3: if (!isA) { type = 1; sync = true; g = pg8::Gemm{ap->wd[7 + j].dst, kvb, GW, MTOK, 512, 512, KVW}; eg.O = vT; eg.ldc = MTOK; eg.css = rsKV; eg.cinvD = 1.0f / 512; } break;
          case 4: if (!isA) { type = 1; sync = true; g = pg8::Gemm{zbuf, ap->wd[13 + j].dst, MTOK, QW, 512, ZB_W, 512};
              eg.O = qbuf; eg.ldc = QW; eg.rss = rsQ; eg.rinvD = 1.0f / 512; eg.rope_mode = 1; eg.cs = cs; eg.sc_lo = 0; eg.sc_val = SC_MLA; } break;
          case 5: type = 4; sync = true; break;
          case 6: type = 2; sync = true; g = pg8::Gemm{cat, ap->wd[15 + l].dst, MTOK, DM, DM, DM, DM}; er.xold = (l == 0) ? x_in : xo; er.xnew = xo; er.ssacc = rsB; break;
          case 7: type = 3; sync = true; g = pg8::Gemm{xb, ap->wd[19 + l].dst, MTOK, DFF2, DM, DM, DM}; break;
          case 8: type = 5; sync = true; break;
          case 9: type = 2; sync = true; g = pg8::Gemm{gbuf, ap->wd[23 + l].dst, MTOK, DM, DFF, DFF, DFF}; er.xold = xo; er.xnew = xo; er.ssacc = rsA; break;
        }
      }
      if (type == 1 && EN(1)) { S.init(g.M, g.N, G, corder); pg8::gemm_phase<EpiG>(lds, g, S, eg); }
      else if (type == 2 && EN(2)) {
        S.init(g.M, g.N, G, corder); pg8::gemm_phase<EpiRes>(lds, g, S, er);
        if (s == 6) for (size_t i = gtid; i < (size_t)MTOK; i += NGT) { rsA[i] = 0.f; rsV[i] = 0.f; rsQ[i] = 0.f; }
      }
      else if (type == 3 && EN(3)) {
        S.init(g.M, g.N, G, corder);
        EpiUp E{gbuf, halo, rsB, ap->in[22] + (size_t)l * 3 * DFF2, ap->in[23] + (size_t)l * DFF2};
        pg8::gemm_phase<EpiUp>(lds, g, S, E);
      }
      else if (type == 4 && (EN(4) || EN(6) || EN(7))) {
        if (isA && EN(4)) {
          const float* wsp = ap->in[8] + (size_t)l * 12 * 128 * 128; const float* bsp = ap->in[9] + (size_t)l * 12 * 128; const float* gv = ap->in[7] + (size_t)l * GW;
          LAS unsigned char* Wl = lds; LAS unsigned char* Vt = lds + 128 * 272;
          const int r32 = lane & 31, hi = lane >> 5, tb = wave & 3, chh = wave >> 2;
          for (int uidx = vcu; uidx < NB * 32 * 12; uidx += G) {
            const int gi = uidx % 12, bn = uidx / 12, tok0 = bn * 128;
#pragma unroll
            for (int i = 0; i < 8; ++i) { const int idx = tid + i * 512, t = idx >> 5, s4 = (idx & 31) * 4;
              f32x4 w = *(const f32x4*)(wsp + ((size_t)gi * 128 + t) * 128 + s4);
              const f32x4 q = *(const f32x4*)(rsV + tok0 + s4);
#pragma unroll
              for (int e = 0; e < 4; ++e) w[e] = (s4 + e <= t) ? w[e] * __builtin_amdgcn_rsqf(q[e] * (1.0f / GW) + EPS) : 0.f;
              *(LAS u32x2*)(Wl + t * 272 + s4 * 2) = (u32x2){cvt_pk_bf16(w[0], w[1]), cvt_pk_bf16(w[2], w[3])}; }
#pragma unroll
            for (int i = 0; i < 4; ++i) { const int idx = tid + i * 512, sr = idx >> 4, c8 = (idx & 15) * 8;
              const u32x4 v = *(const u32x4*)(zbuf + (size_t)(tok0 + sr) * ZA_W + GW + gi * 128 + c8);
              const unsigned vv[4] = {v.x, v.y, v.z, v.w};
#pragma unroll
              for (int e = 0; e < 4; ++e) { *(LAS unsigned short*)(Vt + (c8 + 2 * e) * 272 + sr * 2) = (unsigned short)(vv[e] & 0xffffu); *(LAS unsigned short*)(Vt + (c8 + 2 * e + 1) * 272 + sr * 2) = (unsigned short)(vv[e] >> 16); } }
            __syncthreads();
            f32x16 acc2[2];
#pragma unroll
            for (int cb = 0; cb < 2; ++cb)
#pragma unroll
              for (int i = 0; i < 16; ++i) acc2[cb][i] = 0.f;
            const int nks = 2 * (tb + 1);
            for (int ks = 0; ks < nks; ++ks) {
              const bf16x8 wf = *(const LAS bf16x8*)(Wl + (32 * tb + r32) * 272 + ks * 32 + hi * 16);
#pragma unroll
              for (int cb = 0; cb < 2; ++cb) {
                const bf16x8 vf = *(const LAS bf16x8*)(Vt + (64 * chh + 32 * cb + r32) * 272 + ks * 32 + hi * 16);
                acc2[cb] = __builtin_amdgcn_mfma_f32_32x32x16_bf16(vf, wf, acc2[cb], 0, 0, 0);
              }
            }
            const int t = 32 * tb + r32; const float bt = bsp[gi * 128 + t];
            const size_t rowoff = (size_t)(tok0 + t);
#pragma unroll
            for (int cb = 0; cb < 2; ++cb)
#pragma unroll
              for (int ig = 0; ig < 4; ++ig) {
                const int c = gi * 128 + 64 * chh + 32 * cb + 8 * ig + 4 * hi;
                const f32x4 gg = *(const f32x4*)(gv + c);
                const u32x2 uu = *(const u32x2*)(zbuf + rowoff * ZA_W + c);
                const float u0 = __uint_as_float(uu.x << 16), u1 = __uint_as_float(uu.x & 0xffff0000u), u2 = __uint_as_float(uu.y << 16), u3 = __uint_as_float(uu.y & 0xffff0000u);
                const float o0 = u0 * (acc2[cb][4 * ig] * gg[0] + bt), o1 = u1 * (acc2[cb][4 * ig + 1] * gg[1] + bt), o2 = u2 * (acc2[cb][4 * ig + 2] * gg[2] + bt), o3 = u3 * (acc2[cb][4 * ig + 3] * gg[3] + bt);
                *(u32x2*)(cat + rowoff * DM + c) = (u32x2){cvt_pk_bf16(o0, o1), cvt_pk_bf16(o2, o3)};
              }
            __syncthreads();
          }
        } else if (!isA && EN(6)) {
          for (int p = 6 * vcu; p < 1536; p += 6 * G)
#pragma unroll 1
            for (int uu = p; uu < p + 6 && uu < 1536; ++uu) {
              const int pp = uu >> 1, half = uu & 1, bh = pp >> 3, i8 = pp & 7, b = bh / 12, h = bh - b * 12;
              const int qblk = half ? i8 : 15 - i8; const size_t row0 = (size_t)b * SEQ + qblk * 256;
              attn_unit<192, true>(lds, qbuf + row0 * QW + h * 192, QW, kn + (size_t)b * SEQ * GW + h * 128, GW, kvb + (size_t)b * SEQ * KVW + 512, KVW,
                                   vT + (size_t)(h * 128) * MTOK + (size_t)b * SEQ, MTOK, (qblk + 1) * 4, qblk * 256, cat + row0 * DM + h * 128, DM);
            }
        }
        if (EN(7)) {
          const bf16_t* qm = zbuf + (isA ? 2 * GW : 512); const int ldq = isA ? ZA_W : ZB_W;
#pragma unroll 1
          for (int uidx = vcu; uidx < NB * 4 * 16; uidx += G) {
            const int qblk = uidx & 15, bh = uidx >> 4, b = bh >> 2, h = bh & 3; const size_t row0 = (size_t)b * SEQ + qblk * 256;
            attn_unit<128, false>(lds, qm + row0 * ldq + h * 128, ldq, memk + (size_t)l * MMEM * 512 + (size_t)b * NMEM * 512 + h * 128, 512, nullptr, 0,
                                  memvt + (size_t)l * 512 * MMEM + (size_t)(h * 128) * MMEM + b * NMEM, MMEM, 4, 0, cat + row0 * DM + GW + h * 128, DM);
          }
        }
        for (size_t i = gtid; i < (size_t)MTOK; i += NGT) rsB[i] = 0.f;
      }
      else if (type == 5 && EN(5)) {
        const float* cw = ap->in[22] + (size_t)l * 3 * DFF2; const float* cb = ap->in[23] + (size_t)l * DFF2;
        for (size_t idx = gtid; idx < (size_t)1024 * (DFF / 4); idx += NGT) {
          const int rowi = (int)(idx / (DFF / 4)), c4 = (int)(idx % (DFF / 4)) * 4, blk = rowi >> 1, rr = rowi & 1;
          const bool hp = (blk & 63) != 0;
          const float* H0 = halo + (size_t)blk * 4 * DFF2; const float* Hp = H0 - (size_t)4 * DFF2;
          f32x4 cv[2];
#pragma unroll
          for (int part = 0; part < 2; ++part) {
            const int off = part * DFF + c4; const f32x4 z4 = (f32x4){0.f, 0.f, 0.f, 0.f};
            const f32x4 a0 = *(const f32x4*)(H0 + (size_t)rr * DFF2 + off);
            const f32x4 p3 = hp ? *(const f32x4*)(Hp + (size_t)3 * DFF2 + off) : z4;
            const f32x4 a1 = rr ? *(const f32x4*)(H0 + off) : p3;
            const f32x4 a2 = rr ? p3 : (hp ? *(const f32x4*)(Hp + (size_t)2 * DFF2 + off) : z4);
            cv[part] = *(const f32x4*)(cw + 2 * DFF2 + off) * a0 + *(const f32x4*)(cw + DFF2 + off) * a1 + *(const f32x4*)(cw + off) * a2 + *(const f32x4*)(cb + off);
          }
          u32x2 w; w.x = cvt_pk_bf16(silu1(cv[0][0]) * cv[1][0], silu1(cv[0][1]) * cv[1][1]); w.y = cvt_pk_bf16(silu1(cv[0][2]) * cv[1][2], silu1(cv[0][3]) * cv[1][3]);
          *(u32x2*)(gbuf + (size_t)(blk * 64 + rr) * DFF + c4) = w;
        }
      }
      if (sync) grid.sync();
    }
  }
  {
    const Args* ap = &a; DERIVE_PTRS(ap)
    DERIVE_IDS
    const float* gf = a.in[5];
    for (size_t i = gtid; i < (size_t)MTOK * (DM / 4); i += NGT) {
      const int row = (int)(i / (DM / 4)), c4 = (int)(i % (DM / 4)) * 4;
      const float r = __builtin_amdgcn_rsqf(rsA[row] * (1.0f / DM) + EPS);
      f32x4* p = (f32x4*)(xo + (size_t)row * DM + c4);
      *p = *p * r * *(const f32x4*)(gf + c4);
    }
  }
}

extern "C" void kernel_launch(void* const* d_in, const int* in_sizes, int n_in, void* d_out, int out_size, void* d_ws, size_t ws_size, hipStream_t stream) {
  static int grid_blocks = 0;
  if (!grid_blocks) {
    int dev = 0, cus = 0, per_cu = 0;
    (void)hipGetDevice(&dev);
    (void)hipDeviceGetAttribute(&cus, hipDeviceAttributeMultiprocessorCount, dev);
    (void)hipFuncSetAttribute((const void*)yoco_fwd, hipFuncAttributeMaxDynamicSharedMemorySize, LDS_BYTES);
    (void)hipOccupancyMaxActiveBlocksPerMultiprocessor(&per_cu, (const void*)yoco_fwd, 512, LDS_BYTES);
    if (per_cu < 1) per_cu = 1;
    grid_blocks = cus * per_cu;
    if (ws_size < WS_END) fprintf(stderr, "kernel_launch: workspace too small: %zu < %zu\n", ws_size, (size_t)WS_END);
  }
  Args a; memset(&a, 0, sizeof(a));
  for (int i = 0; i < 25; ++i) a.in[i] = (const float*)d_in[i];
  a.out = (float*)d_out; a.ws = (unsigned char*)d_ws;
  const float* const* in = a.in;
  bf16_t* wp = (bf16_t*)((unsigned char*)d_ws + WS_W);
  int nd = 0, items = 0;
  auto add = [&](const float* src, const float* scale, int K, int Ns, int Nd, int kind) {
    WDesc& d = a.wd[nd++]; d.src = src; d.scale = scale; d.dst = wp; d.K = K; d.Ns = Ns; d.Nd = Nd; d.kind = kind; d.item0 = items; d.pad = 0;
    items += (K / 64) * (Nd / 32); wp += (size_t)K * Nd;
  };
  for (int l = 0; l < 2; ++l) add(in[6] + (size_t)l * DM * ZA_W, in[3] + (size_t)l * DM, DM, ZA_W, ZA_W, 0);
  for (int j = 0; j < 2; ++j) add(in[13] + (size_t)j * DM * ZB_W, in[3] + (size_t)(2 + j) * DM, DM, ZB_W, ZB_W, 0);
  add(in[11], in[10], DM, 576, KVW, 1);
  for (int j = 0; j < 2; ++j) add(in[16] + (size_t)j * 512 * GW, in[12], 512, GW, GW, 0);
  for (int j = 0; j < 2; ++j) add(in[17] + (size_t)j * 512 * GW, in[12], 512, GW, GW, 0);
  for (int l = 0; l < 4; ++l) add(in[19] + (size_t)l * DM * 1024, in[18] + (size_t)l * DM, DM, 1024, 1024, 0);
  for (int j = 0; j < 2; ++j) add(in[15] + (size_t)j * 512 * QW, in[14] + (size_t)j * 512, 512, QW, QW, 2);
  for (int l = 0; l < 4; ++l) add(in[20] + (size_t)l * DM * DM, nullptr, DM, DM, DM, 0);
  for (int l = 0; l < 4; ++l) add(in[21] + (size_t)l * DM * DFF2, in[4] + (size_t)l * DM, DM, DFF2, DFF2, 3);
  for (int l = 0; l < 4; ++l) add(in[24] + (size_t)l * DFF * DM, nullptr, DFF, DM, DM, 0);
  a.nitems = items;
  void* args[] = {&a};
  hipError_t e = hipLaunchCooperativeKernel((const void*)yoco_fwd, dim3(grid_blocks), dim3(512), args, LDS_BYTES, stream);
  if (e != hipSuccess) fprintf(stderr, "cooperative launch failed: %s (grid %d)\n", hipGetErrorString(e), grid_blocks);
}
```

```cpp
#include <hip/hip_runtime.h>
#include <hip/hip_cooperative_groups.h>
#include <cstdio>
#include <cstring>
namespace cg = cooperative_groups;

#define LAS __attribute__((address_space(3)))
typedef unsigned short bf16_t;
typedef short bf16x8 __attribute__((ext_vector_type(8)));
typedef short s16x4 __attribute__((ext_vector_type(4)));
typedef float f32x4 __attribute__((ext_vector_type(4)));
typedef float f32x2 __attribute__((ext_vector_type(2)));
typedef float f32x16 __attribute__((ext_vector_type(16)));
typedef unsigned u32x4 __attribute__((ext_vector_type(4)));
typedef unsigned u32x2 __attribute__((ext_vector_type(2)));

constexpr int DM = 2048, NB = 8, SEQ = 4096, MTOK = NB * SEQ, NMEM = 256, MMEM = NB * NMEM;
constexpr int GW = 1536, ZA_W = 3584, ZB_W = 1024, QW = 2304, KVW = 768, DFF = 5632, DFF2 = 11264;
constexpr float EPS = 1e-6f;
constexpr float LOG2E = 1.4426950408889634f;
constexpr float SC_MEM = 0.08838834764831845f * LOG2E;
constexpr float SC_MLA = 0.07216878364870323f * LOG2E;

constexpr size_t MiB = 1u << 20;
constexpr size_t WS_RS = 1 * MiB;
constexpr size_t WS_CS = 2 * MiB;
constexpr size_t WS_MEMB = 10 * MiB;
constexpr size_t WS_MEMK = 18 * MiB;
constexpr size_t WS_MEMVT = 26 * MiB;
constexpr size_t WS_W = 34 * MiB;
constexpr size_t WS_XB = 396 * MiB;
constexpr size_t WS_KVB = 524 * MiB;
constexpr size_t WS_KN = 572 * MiB;
constexpr size_t WS_VT = 668 * MiB;
constexpr size_t WS_HALO = 764 * MiB;
constexpr size_t WS_R = 852 * MiB;
constexpr size_t WS_CAT = WS_R + 224 * MiB;
constexpr size_t WS_Q = WS_R + 64 * MiB;
constexpr size_t WS_END = 1204 * MiB;

typedef __bf16 bf16x2_t __attribute__((ext_vector_type(2)));
__device__ __forceinline__ unsigned cvt_pk_bf16(float lo, float hi) { const f32x2 v = {lo, hi}; const bf16x2_t b = __builtin_convertvector(v, bf16x2_t); return __builtin_bit_cast(unsigned, b); }
__device__ __forceinline__ float wave_sum(float v) {
#pragma unroll
  for (int o = 1; o < 64; o <<= 1) v += __shfl_xor(v, o);
  return v;
}
__device__ __forceinline__ f32x2 gelu_pk(f32x2 v) {
  const f32x2 av = __builtin_elementwise_abs(v), d = av * 0.2316418882f + 1.0f;
  f32x2 t; t.x = __builtin_amdgcn_rcpf(d.x); t.y = __builtin_amdgcn_rcpf(d.y);
  f32x2 q = t * 0.5307027145f + (-0.7265760135f); q = q * t + 0.7107068705f; q = q * t + (-0.142248368f); q = q * t + 0.127414796f; q = q * t;
  const f32x2 s = (v * v) * (-0.72134752044f);
  f32x2 e; e.x = __builtin_amdgcn_exp2f(s.x); e.y = __builtin_amdgcn_exp2f(s.y);
  const f32x2 m = v * (q * e), r = v - m;
  f32x2 o; o.x = v.x < 0.f ? m.x : r.x; o.y = v.y < 0.f ? m.y : r.y; return o;
}
__device__ __forceinline__ f32x4 gelu4(f32x4 v) { f32x2 a = gelu_pk((f32x2){v[0], v[1]}), b = gelu_pk((f32x2){v[2], v[3]}); return (f32x4){a.x, a.y, b.x, b.y}; }
__device__ __forceinline__ float silu1(float x) { return x * __builtin_amdgcn_rcpf(1.0f + __builtin_amdgcn_exp2f(-x * LOG2E)); }
__device__ __forceinline__ float ror1(float v) { return __builtin_bit_cast(float, __builtin_amdgcn_update_dpp(0, __builtin_bit_cast(int, v), 0x121, 0xf, 0xf, false)); }
__device__ __forceinline__ float ror2(float v) { return __builtin_bit_cast(float, __builtin_amdgcn_update_dpp(0, __builtin_bit_cast(int, v), 0x122, 0xf, 0xf, false)); }
__device__ __forceinline__ f32x4 ror1v(f32x4 v) { return (f32x4){ror1(v[0]), ror1(v[1]), ror1(v[2]), ror1(v[3])}; }
__device__ __forceinline__ f32x4 ror2v(f32x4 v) { return (f32x4){ror2(v[0]), ror2(v[1]), ror2(v[2]), ror2(v[3])}; }

namespace pg8 {
constexpr int BM = 256, BK = 64, HALF = 128, HTB = HALF * BK * 2, STAGE_BYTES = 8 * HTB, NXCD = 8, WGM = 8;
__device__ __forceinline__ int lds_byte(int r, int c) { const int st = (r >> 4) * 2 + (c >> 5), rr = r & 15, cc = c & 31, ob = rr * 64 + cc * 2; return st * 1024 + (ob ^ (((ob >> 9) & 1) << 5)); }
__device__ __forceinline__ void stage_rc(int b, int& R, int& C) { const int st = b / 1024, sb = b % 1024, swz = sb ^ (((sb >> 9) & 1) << 5); R = (st >> 1) * 16 + swz / 64; C = (st & 1) * 32 + (swz % 64) / 2; }
__device__ __forceinline__ int perm32(int rho) { const int n = rho >> 4, i = rho & 15; return 8 * (i >> 2) + 4 * n + (i & 3); }
struct Unit { int pm, pn; };
struct Gemm { const bf16_t* A; const bf16_t* Bt; int M, N, K, lda, ldb; };
struct StaticOrder {
  int nM, nN, nwg, G, c;
  __device__ void init(int M, int N, int G_, int c_) { nM = M / BM; nN = N / BM; nwg = nM * nN; G = G_; c = c_; }
  __device__ bool next(int i, Unit& u) const {
    const long L = (long)i * G + c; if (L >= nwg) return false;
    int wgid = (int)L; { const int q = nwg / NXCD, r = nwg % NXCD, xcd = wgid % NXCD, off = wgid / NXCD; wgid = (xcd < r ? xcd * (q + 1) : r * (q + 1) + (xcd - r) * q) + off; }
    const int nig = WGM * nN, gid = wgid / nig, fm = gid * WGM, gsz = (nM - fm) < WGM ? (nM - fm) : WGM;
    u.pm = fm + ((wgid % nig) % gsz); u.pn = (wgid % nig) / gsz; return true;
  }
};

template <class Epi>
__device__ __forceinline__ void gemm_phase(LAS unsigned char* lds, const Gemm g, const StaticOrder& S, const Epi& E) {
  int tid_o = threadIdx.x; asm volatile("" : "+v"(tid_o));
  const int tid = tid_o, wid = __builtin_amdgcn_readfirstlane(tid >> 6), lane = tid & 63, wr = wid >> 2, wc = wid & 3, fr = lane & 15, fq = lane >> 4;
  const int K = g.K, nt = K / BK;
  unsigned voffA[2], voffB[2];
#pragma unroll
  for (int i = 0; i < 2; ++i) { int R, C; stage_rc(tid * 16 + i * 8192, R, C); const int Rb = Epi::PERM ? ((R & ~31) + perm32(R & 31)) : R;
    voffA[i] = (unsigned)(R * g.lda + C) * 2u; voffB[i] = (unsigned)(Rb * g.ldb + C) * 2u; }
  const size_t kstep = (size_t)(BK * 2);
  const size_t hstepA = (size_t)HALF * g.lda * 2, hstepB = (size_t)HALF * g.ldb * 2;
  const size_t tstepA = 2 * hstepA, tstepB = 2 * hstepB;
  const unsigned ldsw = (unsigned)wid * 1024u;
  const int aoff = lds_byte(wr * 64 + fr, fq * 8), boff = lds_byte(wc * 32 + fr, fq * 8);
#define PG8_SA(b, h) (((b) * 2 + (h)) * HTB)
#define PG8_SB(b, h) ((4 + (b) * 2 + (h)) * HTB)
#define PG8_STAGE(bufoff, gbase, voff) do { _Pragma("unroll") for (int _i = 0; _i < 2; ++_i) \
    __builtin_amdgcn_global_load_lds((const unsigned*)((const char*)(gbase) + (voff)[_i]), (LAS unsigned*)(lds + (bufoff) + ldsw + _i * 8192), 16, 0, 0); } while (0)
#define PG8_LDA(dst, b, h) do { _Pragma("unroll") for (int m = 0; m < 4; ++m) _Pragma("unroll") for (int k = 0; k < 2; ++k) dst[m][k] = *(const LAS bf16x8*)(lds + PG8_SA(b, h) + aoff + m * 2048 + k * 1024); } while (0)
#define PG8_LDB(dst, b, h) do { _Pragma("unroll") for (int n = 0; n < 2; ++n) _Pragma("unroll") for (int k = 0; k < 2; ++k) dst[n][k] = *(const LAS bf16x8*)(lds + PG8_SB(b, h) + boff + n * 2048 + k * 1024); } while (0)
#define PG8_MMA(ai, bj, At, Bt) do { __builtin_amdgcn_s_setprio(1); _Pragma("unroll") for (int m = 0; m < 4; ++m) _Pragma("unroll") for (int n = 0; n < 2; ++n) _Pragma("unroll") for (int k = 0; k < 2; ++k) \
    acc[ai][bj][m][n] = __builtin_amdgcn_mfma_f32_16x16x32_bf16(Bt[n][k], At[m][k], acc[ai][bj][m][n], 0, 0, 0); __builtin_amdgcn_s_setprio(0); } while (0)
#define PG8_WAIT_V(n) asm volatile("s_waitcnt vmcnt(" #n ")" ::: "memory")
#define PG8_WAIT_L(n) asm volatile("s_waitcnt lgkmcnt(" #n ")" ::: "memory")
#define PG8_BAR __builtin_amdgcn_s_barrier()
#define PG8_SCHED __builtin_amdgcn_sched_barrier(0)
  Unit cur, nxt; int ui = 0;
  if (!S.next(0, cur)) return;
  f32x4 acc[2][2][4][2];
#pragma unroll
  for (int a = 0; a < 2; ++a)
#pragma unroll
    for (int b = 0; b < 2; ++b)
#pragma unroll
      for (int m = 0; m < 4; ++m)
#pragma unroll
        for (int n = 0; n < 2; ++n) acc[a][b][m][n] = (f32x4){0.f, 0.f, 0.f, 0.f};
  bf16x8 At[4][2], B0[2][2], B1[2][2];
  const char* cA = (const char*)g.A + (size_t)cur.pm * tstepA; const char* cB = (const char*)g.Bt + (size_t)cur.pn * tstepB;
  PG8_STAGE(PG8_SB(0, 0), cB, voffB); PG8_STAGE(PG8_SA(0, 0), cA, voffA); PG8_STAGE(PG8_SB(0, 1), cB + hstepB, voffB); PG8_STAGE(PG8_SA(0, 1), cA + hstepA, voffA);
  if (wr == 1) PG8_BAR;
  PG8_WAIT_V(4); PG8_BAR;
  PG8_STAGE(PG8_SB(1, 0), cB + kstep, voffB); PG8_STAGE(PG8_SA(1, 0), cA + kstep, voffA); PG8_STAGE(PG8_SB(1, 1), cB + hstepB + kstep, voffB);
  PG8_WAIT_V(6); PG8_BAR;
  for (;;) {
    const bool has_next = S.next(ui + 1, nxt);
    const char* nA = has_next ? (const char*)g.A + (size_t)nxt.pm * tstepA : cA; const char* nB = has_next ? (const char*)g.Bt + (size_t)nxt.pn * tstepB : cB;
    for (int t = 0; t < nt; t += 2) {
      const bool last = (t == nt - 2);
      const char* a1 = cA + (size_t)(t + 1) * kstep;
      const char* a2 = last ? nA : cA + (size_t)(t + 2) * kstep; const char* b2 = last ? nB : cB + (size_t)(t + 2) * kstep;
      const char* a3 = a2 + kstep; const char* b3 = b2 + kstep;
      PG8_LDB(B0, 0, 0); PG8_SCHED; PG8_LDA(At, 0, 0); PG8_STAGE(PG8_SA(1, 1), a1 + hstepA, voffA);
      PG8_WAIT_L(8); PG8_BAR; PG8_WAIT_L(0); PG8_MMA(0, 0, At, B0); PG8_BAR; PG8_SCHED;
      PG8_LDB(B1, 0, 1); PG8_STAGE(PG8_SB(0, 0), b2, voffB);
      PG8_BAR; PG8_WAIT_L(0); PG8_MMA(0, 1, At, B1); PG8_BAR;
      PG8_LDA(At, 0, 1); PG8_STAGE(PG8_SA(0, 0), a2, voffA);
      PG8_BAR; PG8_WAIT_L(0); PG8_MMA(1, 0, At, B0); PG8_BAR; PG8_SCHED;
      PG8_STAGE(PG8_SB(0, 1), b2 + hstepB, voffB);
      PG8_WAIT_V(6); PG8_BAR; PG8_MMA(1, 1, At, B1); PG8_BAR;
      PG8_LDB(B0, 1, 0); PG8_SCHED; PG8_LDA(At, 1, 0); PG8_STAGE(PG8_SA(0, 1), a2 + hstepA, voffA);
      PG8_WAIT_L(8); PG8_BAR; PG8_WAIT_L(0); PG8_MMA(0, 0, At, B0); PG8_BAR; PG8_SCHED;
      PG8_LDB(B1, 1, 1); PG8_STAGE(PG8_SB(1, 0), b3, voffB);
      PG8_BAR; PG8_WAIT_L(0); PG8_MMA(0, 1, At, B1); PG8_BAR;
      PG8_LDA(At, 1, 1); PG8_STAGE(PG8_SA(1, 0), a3, voffA);
      PG8_BAR; PG8_WAIT_L(0); PG8_MMA(1, 0, At, B0); PG8_BAR; PG8_SCHED;
      PG8_STAGE(PG8_SB(1, 1), b3 + hstepB, voffB);
      PG8_WAIT_V(6); PG8_BAR; PG8_MMA(1, 1, At, B1); PG8_BAR;
    }
    E(acc, cur, wr, wc, fr, fq);
    if (!has_next) break;
#pragma unroll
    for (int a = 0; a < 2; ++a)
#pragma unroll
      for (int b = 0; b < 2; ++b)
#pragma unroll
        for (int m = 0; m < 4; ++m)
#pragma unroll
          for (int n = 0; n < 2; ++n) acc[a][b][m][n] = (f32x4){0.f, 0.f, 0.f, 0.f};
    cur = nxt; cA = nA; cB = nB; ++ui;
  }
  PG8_WAIT_V(0);
  if (wr == 0) PG8_BAR;
  PG8_BAR;
#undef PG8_SA
#undef PG8_SB
#undef PG8_STAGE
#undef PG8_LDA
#undef PG8_LDB
#undef PG8_MMA
#undef PG8_WAIT_V
#undef PG8_WAIT_L
#undef PG8_BAR
#undef PG8_SCHED
}
}
using pg8::Unit; using pg8::HALF;
typedef f32x4 Acc[2][2][4][2];

struct EpiG {
  static constexpr bool PERM = true;
  bf16_t* O; int ldc;
  const float* rss; float rinvD;
  const float* css; float cinvD;
  int gelu_hi;
  int ss_lo, ss_hi; float* ssacc;
  int rope_mode;
  const f32x2* cs;
  int sc_lo; float sc_val;
  __device__ __forceinline__ void operator()(Acc& acc, const Unit& u, int wr, int wc, int fr, int fq) const {
    const int ct = u.pn * 256;
    const bool do_gelu = ct < gelu_hi, do_ss = (ct >= ss_lo && ct < ss_hi), do_sc = ct >= sc_lo;
#pragma unroll
    for (int ai = 0; ai < 2; ++ai)
#pragma unroll
      for (int m = 0; m < 4; ++m) {
        const int row = u.pm * 256 + ai * HALF + wr * 64 + m * 16 + fr;
        const float rs = rss ? __builtin_amdgcn_rsqf(rss[row] * rinvD + EPS) : 1.0f;
        float ss = 0.f;
#pragma unroll
        for (int bj = 0; bj < 2; ++bj) {
          const int c0 = ct + bj * HALF + wc * 32 + 8 * fq;
          f32x4 v0 = acc[ai][bj][m][0] * rs, v1 = acc[ai][bj][m][1] * rs;
          if (css) {
            const f32x4 q0 = *(const f32x4*)(css + c0), q1 = *(const f32x4*)(css + c0 + 4);
#pragma unroll
            for (int j = 0; j < 4; ++j) { v0[j] *= __builtin_amdgcn_rsqf(q0[j] * cinvD + EPS); v1[j] *= __builtin_amdgcn_rsqf(q1[j] * cinvD + EPS); }
          }
          if (do_gelu) { v0 = gelu4(v0); v1 = gelu4(v1); }
          if (do_ss) ss += (v0[0] * v0[0] + v0[1] * v0[1]) + (v0[2] * v0[2] + v0[3] * v0[3]) + (v1[0] * v1[0] + v1[1] * v1[1]) + (v1[2] * v1[2] + v1[3] * v1[3]);
          int roff = -1;
          if (rope_mode == 1) { const int d = c0 % 192; if (d >= 128) roff = d - 128; }
          else if (rope_mode == 2) { if (c0 >= 512 && c0 < 576) roff = c0 - 512; }
          if (roff >= 0) {
            const f32x2* t = cs + (size_t)row * 32 + (roff >> 1);
            const f32x2 t0 = t[0], t1 = t[1], t2 = t[2], t3 = t[3];
            f32x4 w0, w1;
            w0[0] = v0[0] * t0.x - v0[1] * t0.y; w0[1] = v0[1] * t0.x + v0[0] * t0.y;
            w0[2] = v0[2] * t1.x - v0[3] * t1.y; w0[3] = v0[3] * t1.x + v0[2] * t1.y;
            w1[0] = v1[0] * t2.x - v1[1] * t2.y; w1[1] = v1[1] * t2.x + v1[0] * t2.y;
            w1[2] = v1[2] * t3.x - v1[3] * t3.y; w1[3] = v1[3] * t3.x + v1[2] * t3.y;
            v0 = w0; v1 = w1;
          }
          if (do_sc) { v0 = v0 * sc_val; v1 = v1 * sc_val; }
          u32x4 w; w.x = cvt_pk_bf16(v0[0], v0[1]); w.y = cvt_pk_bf16(v0[2], v0[3]); w.z = cvt_pk_bf16(v1[0], v1[1]); w.w = cvt_pk_bf16(v1[2], v1[3]);
          *(u32x4*)(O + (size_t)row * ldc + c0) = w;
        }
        if (do_ss) { ss += __shfl_xor(ss, 16); ss += __shfl_xor(ss, 32); if (fq == 0) atomicAdd(ssacc + row, ss); }
      }
  }
};

struct EpiRes {
  static constexpr bool PERM = false;
  const float* xold; float* xnew; bf16_t* xb; float* ssacc;
  __device__ __forceinline__ void operator()(Acc& acc, const Unit& u, int wr, int wc, int fr, int fq) const {
    const int col0 = u.pn * 256 + wc * 32 + 4 * fq;
#pragma unroll
    for (int ai = 0; ai < 2; ++ai)
#pragma unroll
      for (int m = 0; m < 4; ++m) {
        const int row = u.pm * 256 + ai * HALF + wr * 64 + m * 16 + fr;
        float ss = 0.f;
#pragma unroll
        for (int bj = 0; bj < 2; ++bj)
#pragma unroll
          for (int n = 0; n < 2; ++n) {
            const size_t off = (size_t)row * DM + col0 + bj * HALF + n * 16;
            const f32x4 v = *(const f32x4*)(xold + off) + acc[ai][bj][m][n];
            *(f32x4*)(xnew + off) = v;
            u32x2 w; w.x = cvt_pk_bf16(v[0], v[1]); w.y = cvt_pk_bf16(v[2], v[3]);
            *(u32x2*)(xb + off) = w;
            ss += (v[0] * v[0] + v[1] * v[1]) + (v[2] * v[2] + v[3] * v[3]);
          }
        ss += __shfl_xor(ss, 16); ss += __shfl_xor(ss, 32);
        if (fq == 0) atomicAdd(ssacc + row, ss);
      }
  }
};

struct EpiUp {
  static constexpr bool PERM = true;
  bf16_t* g; float* halo; const float* rss; const float* cw; const float* cb;
  __device__ __forceinline__ void operator()(Acc& acc, const Unit& u, int wr, int wc, int fr, int fq) const {
    const int rowb = u.pm * 256 + wr * 64;
    const int c0 = u.pn * 128 + wc * 32 + 8 * fq;
#pragma unroll
    for (int ai = 0; ai < 2; ++ai)
#pragma unroll
      for (int m = 0; m < 4; ++m) {
        const float r = __builtin_amdgcn_rsqf(rss[rowb + ai * HALF + m * 16 + fr] * (1.0f / DM) + EPS);
#pragma unroll
        for (int bj = 0; bj < 2; ++bj)
#pragma unroll
          for (int n = 0; n < 2; ++n) acc[ai][bj][m][n] = acc[ai][bj][m][n] * r;
      }
#pragma unroll
    for (int n = 0; n < 2; ++n) {
      const int cc = c0 + 4 * n;
      const f32x4 wg0 = *(const f32x4*)(cw + cc), wg1 = *(const f32x4*)(cw + DFF2 + cc), wg2 = *(const f32x4*)(cw + 2 * DFF2 + cc), bg = *(const f32x4*)(cb + cc);
      const f32x4 wv0 = *(const f32x4*)(cw + DFF + cc), wv1 = *(const f32x4*)(cw + DFF2 + DFF + cc), wv2 = *(const f32x4*)(cw + 2 * DFF2 + DFF + cc), bv = *(const f32x4*)(cb + DFF + cc);
#pragma unroll
      for (int ai = 0; ai < 2; ++ai) {
        f32x4 g1p = (f32x4){0.f, 0.f, 0.f, 0.f}, g2p = g1p, v1p = g1p, v2p = g1p;
#pragma unroll
        for (int m = 0; m < 4; ++m) {
          const f32x4 G = acc[ai][0][m][n], V = acc[ai][1][m][n];
          const f32x4 g1 = ror1v(G), g2 = ror2v(G), v1 = ror1v(V), v2 = ror2v(V);
          const f32x4 pg1 = fr >= 1 ? g1 : g1p, pg2 = fr >= 2 ? g2 : g2p, pv1 = fr >= 1 ? v1 : v1p, pv2 = fr >= 2 ? v2 : v2p;
          const f32x4 cgt = wg2 * G + wg1 * pg1 + wg0 * pg2 + bg;
          const f32x4 cvl = wv2 * V + wv1 * pv1 + wv0 * pv2 + bv;
          g1p = g1; g2p = g2; v1p = v1; v2p = v2;
          const int row = rowb + ai * HALF + m * 16 + fr;
          if (m > 0 || fr >= 2) {
            u32x2 w; w.x = cvt_pk_bf16(silu1(cgt[0]) * cvl[0], silu1(cgt[1]) * cvl[1]); w.y = cvt_pk_bf16(silu1(cgt[2]) * cvl[2], silu1(cgt[3]) * cvl[3]);
            *(u32x2*)(g + (size_t)row * DFF + cc) = w;
          }
          int slot = -1;
          if (m == 0 && fr < 2) slot = fr;
          if (m == 3 && fr >= 14) slot = fr - 12;
          if (slot >= 0) {
            float* hp = halo + ((size_t)(row >> 6) * 4 + slot) * DFF2 + cc;
            *(f32x4*)hp = G; *(f32x4*)(hp + DFF) = V;
          }
        }
      }
    }
  }
};

constexpr int ATT_KBUF = 64 * 400, ATT_VROWB = 136, ATT_VBUF = 128 * ATT_VROWB, ATT_BUF = ATT_KBUF + ATT_VBUF;
template <int DQK, bool CAUSAL>
__device__ __forceinline__ void attn_unit(LAS unsigned char* lds, const bf16_t* Q, int ldq, const bf16_t* K1, int ldk1, const bf16_t* K2, int ldk2,
                                          const bf16_t* VT, int ldv, int ntiles, int q0, bf16_t* O, int ldo) {
  constexpr int KROWB = (DQK + 8) * 2, NKS = DQK / 16, CPR = DQK / 8, NKCH = 64 * CPR / 512;
  int tid_o = threadIdx.x; asm volatile("" : "+v"(tid_o));
  const int tid = tid_o, wid = __builtin_amdgcn_readfirstlane(tid >> 6), lane = tid & 63, r32 = lane & 31, hi = lane >> 5;
  bf16x8 qf[NKS];
  { const bf16_t* qp = Q + (size_t)(wid * 32 + r32) * ldq + hi * 8;
#pragma unroll
    for (int ks = 0; ks < NKS; ++ks) qf[ks] = *(const bf16x8*)(qp + ks * 16); }
  u32x4 kreg[NKCH], vreg[2];
#define ATT_GLOAD(t_) do { const int k0_ = (t_) * 64; \
    _Pragma("unroll") for (int i = 0; i < NKCH; ++i) { const int ch = tid + i * 512, kr = ch / CPR, kc = ch - kr * CPR; \
      const bf16_t* src = (DQK == 128 || kc < 16) ? K1 + (size_t)(k0_ + kr) * ldk1 + kc * 8 : K2 + (size_t)(k0_ + kr) * ldk2 + (kc - 16) * 8; \
      kreg[i] = *(const u32x4*)src; } \
    _Pragma("unroll") for (int i = 0; i < 2; ++i) { const int ch = tid + i * 512, d = ch >> 3, cc = ch & 7; vreg[i] = *(const u32x4*)(VT + (size_t)d * ldv + k0_ + cc * 8); } } while (0)
#define ATT_LWRITE(buf_) do { LAS unsigned char* kb_ = lds + (buf_) * ATT_BUF; \
    _Pragma("unroll") for (int i = 0; i < NKCH; ++i) { const int ch = tid + i * 512, kr = ch / CPR, kc = ch - kr * CPR; *(LAS u32x4*)(kb_ + kr * KROWB + kc * 16) = kreg[i]; } \
    _Pragma("unroll") for (int i = 0; i < 2; ++i) { const int ch = tid + i * 512, d = ch >> 3, cc = ch & 7; LAS unsigned char* p = kb_ + ATT_KBUF + d * ATT_VROWB + cc * 16; \
      *(LAS u32x2*)p = (u32x2){vreg[i].x, vreg[i].y}; *(LAS u32x2*)(p + 8) = (u32x2){vreg[i].z, vreg[i].w}; } } while (0)
  f32x16 o[4];
#pragma unroll
  for (int d = 0; d < 4; ++d)
#pragma unroll
    for (int i = 0; i < 16; ++i) o[d][i] = 0.f;
  float mrow = -INFINITY, lsum = 0.f;
  const int qabs = q0 + wid * 32 + r32, qlo = q0 + wid * 32;
  ATT_GLOAD(0); ATT_LWRITE(0); __syncthreads();
  for (int t = 0; t < ntiles; ++t) {
    const int buf = t & 1;
    if (t + 1 < ntiles) ATT_GLOAD(t + 1);
    const int k0 = t * 64;
    if (!CAUSAL || k0 <= qlo + 31) {
      const LAS unsigned char* kb = lds + buf * ATT_BUF;
      f32x16 s0, s1;
#pragma unroll
      for (int i = 0; i < 16; ++i) { s0[i] = 0.f; s1[i] = 0.f; }
#pragma unroll
      for (int ks = 0; ks < NKS; ++ks) {
        const bf16x8 ka = *(const LAS bf16x8*)(kb + r32 * KROWB + ks * 32 + hi * 16);
        const bf16x8 kc = *(const LAS bf16x8*)(kb + (32 + r32) * KROWB + ks * 32 + hi * 16);
        s0 = __builtin_amdgcn_mfma_f32_32x32x16_bf16(ka, qf[ks], s0, 0, 0, 0);
        s1 = __builtin_amdgcn_mfma_f32_32x32x16_bf16(kc, qf[ks], s1, 0, 0, 0);
      }
      if (CAUSAL && k0 + 63 > qlo) {
#pragma unroll
        for (int i = 0; i < 16; ++i) { const int kv = k0 + (i & 3) + 8 * (i >> 2) + 4 * hi;
          if (kv > qabs) s0[i] = -INFINITY; if (kv + 32 > qabs) s1[i] = -INFINITY; }
      }
      float mx = s0[0];
#pragma unroll
      for (int i = 1; i < 16; ++i) mx = fmaxf(mx, s0[i]);
#pragma unroll
      for (int i = 0; i < 16; ++i) mx = fmaxf(mx, s1[i]);
      mx = fmaxf(mx, __shfl_xor(mx, 32));
      const float mnew = fmaxf(mrow, mx);
      const float alpha = __builtin_amdgcn_exp2f(mrow - mnew);
      mrow = mnew;
      float ps = 0.f;
#pragma unroll
      for (int i = 0; i < 16; ++i) { s0[i] = __builtin_amdgcn_exp2f(s0[i] - mnew); s1[i] = __builtin_amdgcn_exp2f(s1[i] - mnew); ps += s0[i] + s1[i]; }
      lsum = lsum * alpha + ps;
#pragma unroll
      for (int d = 0; d < 4; ++d)
#pragma unroll
        for (int i = 0; i < 16; ++i) o[d][i] *= alpha;
      bf16x8 pa[4];
#pragma unroll
      for (int s = 0; s < 4; ++s) {
        u32x4 w;
        if (s < 2) { w.x = cvt_pk_bf16(s0[8 * s + 0], s0[8 * s + 1]); w.y = cvt_pk_bf16(s0[8 * s + 2], s0[8 * s + 3]); w.z = cvt_pk_bf16(s0[8 * s + 4], s0[8 * s + 5]); w.w = cvt_pk_bf16(s0[8 * s + 6], s0[8 * s + 7]); }
        else { const int b = 8 * (s - 2); w.x = cvt_pk_bf16(s1[b + 0], s1[b + 1]); w.y = cvt_pk_bf16(s1[b + 2], s1[b + 3]); w.z = cvt_pk_bf16(s1[b + 4], s1[b + 5]); w.w = cvt_pk_bf16(s1[b + 6], s1[b + 7]); }
        pa[s] = __builtin_bit_cast(bf16x8, w);
      }
      const LAS unsigned char* vb = kb + ATT_KBUF;
#pragma unroll
      for (int d = 0; d < 4; ++d)
#pragma unroll
        for (int s = 0; s < 4; ++s) {
          const LAS unsigned char* p = vb + (32 * d + r32) * ATT_VROWB + (16 * s + 4 * hi) * 2;
          const u32x2 lo = *(const LAS u32x2*)p, hh = *(const LAS u32x2*)(p + 16);
          const bf16x8 vf = __builtin_bit_cast(bf16x8, (u32x4){lo.x, lo.y, hh.x, hh.y});
          o[d] = __builtin_amdgcn_mfma_f32_32x32x16_bf16(vf, pa[s], o[d], 0, 0, 0);
        }
    }
    if (t + 1 < ntiles) ATT_LWRITE(buf ^ 1);
    __syncthreads();
  }
#undef ATT_GLOAD
#undef ATT_LWRITE
  const float inv = 1.0f / (lsum + __shfl_xor(lsum, 32));
  bf16_t* op = O + (size_t)(wid * 32 + r32) * ldo + 4 * hi;
#pragma unroll
  for (int d = 0; d < 4; ++d)
#pragma unroll
    for (int ig = 0; ig < 4; ++ig) {
      u32x2 w; w.x = cvt_pk_bf16(o[d][4 * ig] * inv, o[d][4 * ig + 1] * inv); w.y = cvt_pk_bf16(o[d][4 * ig + 2] * inv, o[d][4 * ig + 3] * inv);
      *(u32x2*)(op + 32 * d + 8 * ig) = w;
    }
}


#define XB_TMO      128
#define XB_XCNT(j)  (256  + 64 * (j))
#define XB_XSUB(j)  (1280 + 64 * (j))
#define XB_XGEN(j)  (2304 + 64 * (j))
#define XB_TOP      3328
#define XB_TOPGEN   3392
#define XCD_BAR_WORDS 3456
#define XB_SPIN_CAP (1u << 18)
__device__ __forceinline__ unsigned xb_ld(unsigned* p)              { return __hip_atomic_load(p, __ATOMIC_RELAXED, __HIP_MEMORY_SCOPE_AGENT); }
__device__ __forceinline__ unsigned xb_add(unsigned* p, unsigned v) { return __hip_atomic_fetch_add(p, v, __ATOMIC_RELAXED, __HIP_MEMORY_SCOPE_AGENT); }
__device__ __forceinline__ unsigned xb_xcc_id() { return (unsigned)__builtin_amdgcn_s_getreg((3 << 11) | 20) & 0xFu; }
#define XB_SPIN(cond, bar) do { unsigned _sp = 0; while (cond) { __builtin_amdgcn_s_sleep(1); \
    if ((++_sp & 255u) == 0u) { if (xb_ld(&(bar)[XB_TMO])) break; if (_sp > XB_SPIN_CAP) { atomicAdd(&(bar)[XB_TMO], 1u); break; } } } } while (0)
struct XcdBarrier { unsigned* bar; unsigned x; volatile LAS unsigned* st; };
__device__ __forceinline__ XcdBarrier xcd_barrier_post(unsigned* bar, volatile LAS unsigned* st) {
  XcdBarrier b; b.bar = bar; b.x = xb_xcc_id(); b.st = st;
  if (threadIdx.x == 0) (void)xb_add(&bar[XB_XCNT(b.x)], 1u);
  return b;
}
__device__ __forceinline__ void xcd_barrier_complete(unsigned* bar, unsigned x, unsigned& nloc, unsigned& nx) {
  const unsigned G = gridDim.x * gridDim.y * gridDim.z;
  unsigned sum, cnt, mine, sp = 0u;
  for (;;) {
    sum = 0u; cnt = 0u; mine = 0u;
#pragma unroll
    for (unsigned j = 0; j < 16; ++j) { const unsigned c = xb_ld(&bar[XB_XCNT(j)]); sum += c; cnt += (c > 0u) ? 1u : 0u; mine = (j == x) ? c : mine; }
    if (sum == G) break;
    __builtin_amdgcn_s_sleep(1);
    if ((++sp & 255u) == 0u) { if (xb_ld(&bar[XB_TMO])) break; if (sp > XB_SPIN_CAP) { atomicAdd(&bar[XB_TMO], 1u); break; } }
  }
  nloc = mine > 0u ? mine : 1u; nx = cnt > 0u ? cnt : 1u;
}
__device__ __forceinline__ void xcd_barrier(const XcdBarrier& b) {
  asm volatile("s_waitcnt vmcnt(0)" ::: "memory");
  __syncthreads();
  if (threadIdx.x == 0) {
    unsigned* bar = b.bar;
    __builtin_amdgcn_s_waitcnt(0);
    unsigned nloc = b.st[0], nx = b.st[1];
    if (nloc == 0u) { xcd_barrier_complete(bar, b.x, nloc, nx); b.st[0] = nloc; b.st[1] = nx; }
    const unsigned old = xb_add(&bar[XB_XSUB(b.x)], 1u);
    const unsigned gen = old / nloc;
    if (old + 1u == (gen + 1u) * nloc) {
      __builtin_amdgcn_fence(__ATOMIC_RELEASE, "agent");
      asm volatile("s_waitcnt vmcnt(0)" ::: "memory");
      const unsigned og = xb_add(&bar[XB_TOP], 1u);
      const unsigned tg = og / nx;
      if (og + 1u == (tg + 1u) * nx) xb_add(&bar[XB_TOPGEN], 1u);
      else XB_SPIN(xb_ld(&bar[XB_TOPGEN]) == tg, bar);
      __builtin_amdgcn_fence(__ATOMIC_ACQUIRE, "agent");
      xb_add(&bar[XB_XGEN(b.x)], 1u);
      asm volatile("s_waitcnt vmcnt(0)" ::: "memory");
    } else {
      XB_SPIN(xb_ld(&bar[XB_XGEN(b.x)]) == gen, bar);
      __builtin_amdgcn_fence(__ATOMIC_ACQUIRE, "agent");
      asm volatile("s_waitcnt vmcnt(0)" ::: "memory");
    }
  }
  __syncthreads();
}

constexpr int NWD = 27;
struct WDesc { const float* src; const float* scale; bf16_t* dst; int K, Ns, Nd, kind, item0, pad; };
struct Args { const float* in[25]; float* out; unsigned char* ws; WDesc wd[NWD]; int nitems; int pad; };

__device__ __forceinline__ int srccol(int kind, int n) {
  if (kind == 0) return n;
  if (kind == 1) { if (n < 512) return n; if (n < 576) { const int r = n - 512; return 512 + ((r & 1) ? 32 : 0) + (r >> 1); } return -1; }
  if (kind == 2) { const int h = n / 192, d = n - h * 192; if (d < 128) return n; const int r = d - 128; return h * 192 + 128 + ((r & 1) ? 32 : 0) + (r >> 1); }
  { const int t = n >> 8, w = n & 255; return (w >> 7) * DFF + 128 * t + (w & 127); }
}

constexpr int LDS_BYTES = 132 * 1024;
#ifndef ONLY
#define ONLY 0
#endif
#define EN(k) (ONLY == 0 || ONLY == (k))
typedef __attribute__((address_space(4))) const Args CArgs;
#define DERIVE_PTRS(ap) \
  unsigned char* ws = (ap)->ws; \
  float* rsA = (float*)(ws + WS_RS); float* rsB = rsA + MTOK; float* rsV = rsB + MTOK; float* rsQ = rsV + MTOK; float* rsKV = rsQ + MTOK; float* rsM = rsKV + MTOK; \
  f32x2* cs = (f32x2*)(ws + WS_CS); \
  bf16_t* memb = (bf16_t*)(ws + WS_MEMB); bf16_t* memk = (bf16_t*)(ws + WS_MEMK); bf16_t* memvt = (bf16_t*)(ws + WS_MEMVT); \
  bf16_t* xb = (bf16_t*)(ws + WS_XB); bf16_t* kvb = (bf16_t*)(ws + WS_KVB); bf16_t* kn = (bf16_t*)(ws + WS_KN); bf16_t* vT = (bf16_t*)(ws + WS_VT); \
  float* halo = (float*)(ws + WS_HALO); \
  bf16_t* gbuf = (bf16_t*)(ws + WS_R); bf16_t* zbuf = (bf16_t*)(ws + WS_R); bf16_t* cat = (bf16_t*)(ws + WS_CAT); bf16_t* qbuf = (bf16_t*)(ws + WS_Q); \
  const float* x_in = (ap)->in[0]; float* xo = (ap)->out; \
  (void)rsA; (void)rsB; (void)rsV; (void)rsQ; (void)rsKV; (void)rsM; (void)cs; (void)memb; (void)memk; (void)memvt; (void)xb; (void)kvb; (void)kn; (void)vT; (void)halo; (void)gbuf; (void)zbuf; (void)cat; (void)qbuf; (void)x_in; (void)xo;
__global__ void __launch_bounds__(512, 2) yoco_fwd(Args a) {
  extern __shared__ __attribute__((aligned(16))) unsigned char lds_raw[];
  LAS unsigned char* lds = (LAS unsigned char*)lds_raw;
  cg::grid_group grid = cg::this_grid();
  volatile LAS unsigned* xst = (volatile LAS unsigned*)(lds + 131072 + 64);
  if (threadIdx.x < 4) xst[threadIdx.x] = 0u;
  __syncthreads();
#define DERIVE_IDS \
  int tid_o = threadIdx.x; asm volatile("" : "+v"(tid_o)); \
  const int tid = tid_o, lane = tid & 63, wave = __builtin_amdgcn_readfirstlane(tid >> 6); \
  const int G = gridDim.x, bx = blockIdx.x; \
  const int vcu = (G % 8 == 0) ? (bx % 8) * (G / 8) + bx / 8 : bx; \
  const int gw = vcu * 8 + wave, NGW = G * 8; \
  const size_t gtid = (size_t)bx * 512 + tid, NGT = (size_t)G * 512; \
  (void)lane; (void)wave; (void)vcu; (void)gw; (void)NGW; (void)gtid; (void)NGT;
  {
    const Args* ap = &a; DERIVE_PTRS(ap)
    DERIVE_IDS
    LAS float* scr = (LAS float*)(lds + wave * 8448);
    for (int it = gw; it < a.nitems; it += NGW) {
      int di = 0;
#pragma unroll 1
      for (int j = 1; j < NWD; ++j) if (it >= a.wd[j].item0) di = j;
      const float* src = a.wd[di].src; const float* scale = a.wd[di].scale; bf16_t* dst = a.wd[di].dst;
      const int K = a.wd[di].K, Ns = a.wd[di].Ns, Nd = a.wd[di].Nd, kind = a.wd[di].kind, item = it - a.wd[di].item0;
      const int nblk = Nd / 32, kb = item / nblk, nb = item - kb * nblk, k0 = 64 * kb, n0 = 32 * nb;
      const int sc = srccol(kind, n0 + (lane & 31));
      float wv[32];
      { const float* sp = src + (size_t)(k0 + (lane >> 5)) * Ns + (sc >= 0 ? sc : 0);
#pragma unroll
        for (int i = 0; i < 32; ++i) wv[i] = sp[(size_t)(2 * i) * Ns]; }
      if (scale) {
#pragma unroll
        for (int i = 0; i < 32; ++i) wv[i] *= scale[k0 + 2 * i + (lane >> 5)];
      }
#pragma unroll
      for (int i = 0; i < 32; ++i) scr[(2 * i + (lane >> 5)) * 33 + (lane & 31)] = (sc >= 0) ? wv[i] : 0.f;
      asm volatile("s_waitcnt lgkmcnt(0)" ::: "memory");
      const int c = lane & 7;
#pragma unroll
      for (int j = 0; j < 4; ++j) { const int n = (lane >> 3) + 8 * j; const LAS float* s = scr + (8 * c) * 33 + n;
        u32x4 o; o.x = cvt_pk_bf16(s[0 * 33], s[1 * 33]); o.y = cvt_pk_bf16(s[2 * 33], s[3 * 33]); o.z = cvt_pk_bf16(s[4 * 33], s[5 * 33]); o.w = cvt_pk_bf16(s[6 * 33], s[7 * 33]);
        *(u32x4*)(dst + (size_t)(n0 + n) * K + k0 + 8 * c) = o; }
      asm volatile("s_waitcnt lgkmcnt(0)" ::: "memory");
    }
    for (int r = gw; r < MTOK + MMEM; r += NGW) {
      const bool ism = r >= MTOK; const int rr = ism ? r - MTOK : r;
      const f32x4* xr = (const f32x4*)((ism ? a.in[1] : x_in) + (size_t)rr * DM) + lane;
      u32x2* o8 = (u32x2*)((ism ? memb : xb) + (size_t)rr * DM) + lane;
      float s = 0.f;
#pragma unroll
      for (int j = 0; j < 8; ++j) { const f32x4 v = xr[64 * j]; s += (v[0] * v[0] + v[1] * v[1]) + (v[2] * v[2] + v[3] * v[3]); u32x2 w; w.x = cvt_pk_bf16(v[0], v[1]); w.y = cvt_pk_bf16(v[2], v[3]); o8[64 * j] = w; }
      s = wave_sum(s);
      if (lane == 0) (ism ? rsM : rsA)[rr] = s;
    }
    const int* pos = (const int*)a.in[2];
    for (size_t i = gtid; i < (size_t)MTOK * 32; i += NGT) {
      const int row = (int)(i >> 5), j = (int)(i & 31);
      const float inv = 1.0f / powf(10000.0f, (float)(2 * j) / 64.0f);
      const float ang = (float)pos[row] * inv;
      const double rev = (double)ang * 0.15915494309189535;
      const float fr = (float)(rev - floor(rev));
      cs[i] = (f32x2){__builtin_amdgcn_cosf(fr), __builtin_amdgcn_sinf(fr)};
    }
    for (size_t i = gtid; i < (size_t)MTOK * 4; i += NGT) rsB[i] = 0.f;
    if (bx == 0) for (int i = tid; i < XCD_BAR_WORDS; i += 512) ((unsigned*)ws)[i] = 0u;
  }
  grid.sync();
  const XcdBarrier xbar = xcd_barrier_post((unsigned*)a.ws, xst);

  pg8::StaticOrder S;
#pragma unroll 1
  for (int l = -1; l < 4; ++l) {
    const bool isA = l < 2; const int j = l - 2;
#pragma unroll 1
    for (int s = 0; s < 10; ++s) {
      CArgs* ap = (CArgs*)__builtin_amdgcn_kernarg_segment_ptr(); asm volatile("" : "+s"(ap));
      DERIVE_PTRS(ap)
      DERIVE_IDS
      int type = 0; bool sync = false;
      pg8::Gemm g{nullptr, nullptr, 0, 0, 0, 0, 0}; int corder = bx;
      EpiG eg{nullptr, 0, nullptr, 0.f, nullptr, 0.f, 0, 0, 0, nullptr, 0, nullptr, 1 << 30, 1.f};
      EpiRes er{nullptr, nullptr, xb, nullptr};
      if (l < 0) {
        if (s < 8) {
          const int ml = s >> 1; const bf16_t* wt = ap->wd[9 + ml].dst;
          type = 1; corder = (bx + 16 * s) % G; sync = (s == 7);
          if (!(s & 1)) { g = pg8::Gemm{memb, wt, MMEM, 512, DM, DM, DM}; eg.O = memk + (size_t)ml * MMEM * 512; eg.ldc = 512; eg.rss = rsM; eg.rinvD = 1.0f / DM; }
          else { g = pg8::Gemm{wt + (size_t)512 * DM, memb, 512, MMEM, DM, DM, DM}; eg.O = memvt + (size_t)ml * 512 * MMEM; eg.ldc = MMEM; eg.css = rsM; eg.cinvD = 1.0f / DM; }
        }
      } else {
        switch (s) {
          case 0: if (l == 2) { type = 1; sync = true;
              g = pg8::Gemm{xb, ap->wd[4].dst, MTOK, KVW, DM, DM, DM};
              eg.O = kvb; eg.ldc = KVW; eg.rss = rsA; eg.rinvD = 1.0f / DM; eg.ss_lo = 0; eg.ss_hi = 512; eg.ssacc = rsKV; eg.rope_mode = 2; eg.cs = cs; } break;
          case 1: type = 1; eg.O = zbuf; eg.rss = rsA; eg.rinvD = 1.0f / DM; eg.sc_val = SC_MEM;
            if (isA) { sync = true; g = pg8::Gemm{xb, ap->wd[l].dst, MTOK, ZA_W, DM, DM, DM}; eg.ldc = ZA_W; eg.gelu_hi = 2 * GW; eg.ss_lo = GW; eg.ss_hi = 2 * GW; eg.ssacc = rsV; eg.sc_lo = 2 * GW; }
            else { g = pg8::Gemm{xb, ap->wd[2 + j].dst, MTOK, ZB_W, DM, DM, DM}; eg.ldc = ZB_W; eg.ss_lo = 0; eg.ss_hi = 512; eg.ssacc = rsQ; eg.sc_lo = 512; }
            break;
          case 2: if (!isA) { type = 1; g = pg8::Gemm{kvb, ap->wd[5 + j].dst, MTOK, GW, 512, KVW, 512}; eg.O = kn; eg.ldc = GW; eg.rss = rsKV; eg.rinvD = 1.0f / 512; } break;
          case 3: if (!isA) { type = 1; sync = true; g = pg8::Gemm{ap->wd[7 + j].dst, kvb, GW, MTOK, 512, 512, KVW}; eg.O = vT; eg.ldc = MTOK; eg.css = rsKV; eg.cinvD = 1.0f / 512; } break;
          case 4: if (!isA) { type = 1; sync = true; g = pg8::Gemm{zbuf, ap->wd[13 + j].dst, MTOK, QW, 512, ZB_W, 512};
              eg.O = qbuf; eg.ldc = QW; eg.rss = rsQ; eg.rinvD = 1.0f / 512; eg.rope_mode = 1; eg.cs = cs; eg.sc_lo = 0; eg.sc_val = SC_MLA; } break;
          case 5: type = 4; sync = true; break;
          case 6: type = 2; sync = true; g = pg8::Gemm{cat, ap->wd[15 + l].dst, MTOK, DM, DM, DM, DM}; er.xold = (l == 0) ? x_in : xo; er.xnew = xo; er.ssacc = rsB; break;
          case 7: type = 3; sync = true; g = pg8::Gemm{xb, ap->wd[19 + l].dst, MTOK, DFF2, DM, DM, DM}; break;
          case 8: type = 5; sync = true; break;
          case 9: type = 2; sync = true; g = pg8::Gemm{gbuf, ap->wd[23 + l].dst, MTOK, DM, DFF, DFF, DFF}; er.xold = xo; er.xnew = xo; er.ssacc = rsA; break;
        }
      }
      if (type == 1 && EN(1)) { S.init(g.M, g.N, G, corder); pg8::gemm_phase<EpiG>(lds, g, S, eg); }
      else if (type == 2 && EN(2)) {
        S.init(g.M, g.N, G, corder); pg8::gemm_phase<EpiRes>(lds, g, S, er);
        if (s == 6) for (size_t i = gtid; i < (size_t)MTOK; i += NGT) { rsA[i] = 0.f; rsV[i] = 0.f; rsQ[i] = 0.f; }
      }
      else if (type == 3 && EN(3)) {
        S.init(g.M, g.N, G, corder);
        EpiUp E{gbuf, halo, rsB, ap->in[22] + (size_t)l * 3 * DFF2, ap->in[23] + (size_t)l * DFF2};
        pg8::gemm_phase<EpiUp>(lds, g, S, E);
      }
      else if (type == 4 && (EN(4) || EN(6) || EN(7))) {
        if (isA && EN(4)) {
          const float* wsp = ap->in[8] + (size_t)l * 12 * 128 * 128; const float* bsp = ap->in[9] + (size_t)l * 12 * 128; const float* gv = ap->in[7] + (size_t)l * GW;
          LAS unsigned char* Wl = lds; LAS unsigned char* Vt = lds + 128 * 272;
          const int r32 = lane & 31, hi = lane >> 5, tb = wave & 3, chh = wave >> 2;
          for (int uidx = vcu; uidx < NB * 32 * 12; uidx += G) {
            const int gi = uidx % 12, bn = uidx / 12, tok0 = bn * 128;
#pragma unroll
            for (int i = 0; i < 8; ++i) { const int idx = tid + i * 512, t = idx >> 5, s4 = (idx & 31) * 4;
              f32x4 w = *(const f32x4*)(wsp + ((size_t)gi * 128 + t) * 128 + s4);
              const f32x4 q = *(const f32x4*)(rsV + tok0 + s4);
#pragma unroll
              for (int e = 0; e < 4; ++e) w[e] = (s4 + e <= t) ? w[e] * __builtin_amdgcn_rsqf(q[e] * (1.0f / GW) + EPS) : 0.f;
              *(LAS u32x2*)(Wl + t * 272 + s4 * 2) = (u32x2){cvt_pk_bf16(w[0], w[1]), cvt_pk_bf16(w[2], w[3])}; }
#pragma unroll
            for (int i = 0; i < 4; ++i) { const int idx = tid + i * 512, sr = idx >> 4, c8 = (idx & 15) * 8;
              const u32x4 v = *(const u32x4*)(zbuf + (size_t)(tok0 + sr) * ZA_W + GW + gi * 128 + c8);
              const unsigned vv[4] = {v.x, v.y, v.z, v.w};
#pragma unroll
              for (int e = 0; e < 4; ++e) { *(LAS unsigned short*)(Vt + (c8 + 2 * e) * 272 + sr * 2) = (unsigned short)(vv[e] & 0xffffu); *(LAS unsigned short*)(Vt + (c8 + 2 * e + 1) * 272 + sr * 2) = (unsigned short)(vv[e] >> 16); } }
            __syncthreads();
            f32x16 acc2[2];
#pragma unroll
            for (int cb = 0; cb < 2; ++cb)
#pragma unroll
              for (int i = 0; i < 16; ++i) acc2[cb][i] = 0.f;
            const int nks = 2 * (tb + 1);
            for (int ks = 0; ks < nks; ++ks) {
              const bf16x8 wf = *(const LAS bf16x8*)(Wl + (32 * tb + r32) * 272 + ks * 32 + hi * 16);
#pragma unroll
              for (int cb = 0; cb < 2; ++cb) {
                const bf16x8 vf = *(const LAS bf16x8*)(Vt + (64 * chh + 32 * cb + r32) * 272 + ks * 32 + hi * 16);
                acc2[cb] = __builtin_amdgcn_mfma_f32_32x32x16_bf16(vf, wf, acc2[cb], 0, 0, 0);
              }
            }
            const int t = 32 * tb + r32; const float bt = bsp[gi * 128 + t];
            const size_t rowoff = (size_t)(tok0 + t);
#pragma unroll
            for (int cb = 0; cb < 2; ++cb)
#pragma unroll
              for (int ig = 0; ig < 4; ++ig) {
                const int c = gi * 128 + 64 * chh + 32 * cb + 8 * ig + 4 * hi;
                const f32x4 gg = *(const f32x4*)(gv + c);
                const u32x2 uu = *(const u32x2*)(zbuf + rowoff * ZA_W + c);
                const float u0 = __uint_as_float(uu.x << 16), u1 = __uint_as_float(uu.x & 0xffff0000u), u2 = __uint_as_float(uu.y << 16), u3 = __uint_as_float(uu.y & 0xffff0000u);
                const float o0 = u0 * (acc2[cb][4 * ig] * gg[0] + bt), o1 = u1 * (acc2[cb][4 * ig + 1] * gg[1] + bt), o2 = u2 * (acc2[cb][4 * ig + 2] * gg[2] + bt), o3 = u3 * (acc2[cb][4 * ig + 3] * gg[3] + bt);
                *(u32x2*)(cat + rowoff * DM + c) = (u32x2){cvt_pk_bf16(o0, o1), cvt_pk_bf16(o2, o3)};
              }
            __syncthreads();
          }
        } else if (!isA && EN(6)) {
          for (int p = 6 * vcu; p < 1536; p += 6 * G)
#pragma unroll 1
            for (int uu = p; uu < p + 6 && uu < 1536; ++uu) {
              const int pp = uu >> 1, half = uu & 1, bh = pp >> 3, i8 = pp & 7, b = bh / 12, h = bh - b * 12;
              const int qblk = half ? i8 : 15 - i8; const size_t row0 = (size_t)b * SEQ + qblk * 256;
              attn_unit<192, true>(lds, qbuf + row0 * QW + h * 192, QW, kn + (size_t)b * SEQ * GW + h * 128, GW, kvb + (size_t)b * SEQ * KVW + 512, KVW,
                                   vT + (size_t)(h * 128) * MTOK + (size_t)b * SEQ, MTOK, (qblk + 1) * 4, qblk * 256, cat + row0 * DM + h * 128, DM);
            }
        }
        if (EN(7)) {
          const bf16_t* qm = zbuf + (isA ? 2 * GW : 512); const int ldq = isA ? ZA_W : ZB_W;
#pragma unroll 1
          for (int uidx = vcu; uidx < NB * 4 * 16; uidx += G) {
            const int qblk = uidx & 15, bh = uidx >> 4, b = bh >> 2, h = bh & 3; const size_t row0 = (size_t)b * SEQ + qblk * 256;
            attn_unit<128, false>(lds, qm + row0 * ldq + h * 128, ldq, memk + (size_t)l * MMEM * 512 + (size_t)b * NMEM * 512 + h * 128, 512, nullptr, 0,
                                  memvt + (size_t)l * 512 * MMEM + (size_t)(h * 128) * MMEM + b * NMEM, MMEM, 4, 0, cat + row0 * DM + GW + h * 128, DM);
          }
        }
        for (size_t i = gtid; i < (size_t)MTOK; i += NGT) rsB[i] = 0.f;
      }
      else if (type == 5 && EN(5)) {
        const float* cw = ap->in[22] + (size_t)l * 3 * DFF2; const float* cb = ap->in[23] + (size_t)l * DFF2;
        for (size_t idx = gtid; idx < (size_t)1024 * (DFF / 4); idx += NGT) {
          const int rowi = (int)(idx / (DFF / 4)), c4 = (int)(idx % (DFF / 4)) * 4, blk = rowi >> 1, rr = rowi & 1;
          const bool hp = (blk & 63) != 0;
          const float* H0 = halo + (size_t)blk * 4 * DFF2; const float* Hp = H0 - (size_t)4 * DFF2;
          f32x4 cv[2];
#pragma unroll
          for (int part = 0; part < 2; ++part) {
            const int off = part * DFF + c4; const f32x4 z4 = (f32x4){0.f, 0.f, 0.f, 0.f};
            const f32x4 a0 = *(const f32x4*)(H0 + (size_t)rr * DFF2 + off);
            const f32x4 p3 = hp ? *(const f32x4*)(Hp + (size_t)3 * DFF2 + off) : z4;
            const f32x4 a1 = rr ? *(const f32x4*)(H0 + off) : p3;
            const f32x4 a2 = rr ? p3 : (hp ? *(const f32x4*)(Hp + (size_t)2 * DFF2 + off) : z4);
            cv[part] = *(const f32x4*)(cw + 2 * DFF2 + off) * a0 + *(const f32x4*)(cw + DFF2 + off) * a1 + *(const f32x4*)(cw + off) * a2 + *(const f32x4*)(cb + off);
          }
          u32x2 w; w.x = cvt_pk_bf16(silu1(cv[0][0]) * cv[1][0], silu1(cv[0][1]) * cv[1][1]); w.y = cvt_pk_bf16(silu1(cv[0][2]) * cv[1][2], silu1(cv[0][3]) * cv[1][3]);
          *(u32x2*)(gbuf + (size_t)(blk * 64 + rr) * DFF + c4) = w;
        }
      }
      if (sync) xcd_barrier(xbar);
    }
  }
  {
    const Args* ap = &a; DERIVE_PTRS(ap)
    DERIVE_IDS
    const float* gf = a.in[5];
    for (size_t i = gtid; i < (size_t)MTOK * (DM / 4); i += NGT) {
      const int row = (int)(i / (DM / 4)), c4 = (int)(i % (DM / 4)) * 4;
      const float r = __builtin_amdgcn_rsqf(rsA[row] * (1.0f / DM) + EPS);
      f32x4* p = (f32x4*)(xo + (size_t)row * DM + c4);
      *p = *p * r * *(const f32x4*)(gf + c4);
    }
  }
}

extern "C" void kernel_launch(void* const* d_in, const int* in_sizes, int n_in, void* d_out, int out_size, void* d_ws, size_t ws_size, hipStream_t stream) {
  static int grid_blocks = 0;
  if (!grid_blocks) {
    int dev = 0, cus = 0, per_cu = 0;
    (void)hipGetDevice(&dev);
    (void)hipDeviceGetAttribute(&cus, hipDeviceAttributeMultiprocessorCount, dev);
    (void)hipFuncSetAttribute((const void*)yoco_fwd, hipFuncAttributeMaxDynamicSharedMemorySize, LDS_BYTES);
    (void)hipOccupancyMaxActiveBlocksPerMultiprocessor(&per_cu, (const void*)yoco_fwd, 512, LDS_BYTES);
    if (per_cu < 1) per_cu = 1;
    grid_blocks = cus * per_cu;
    if (ws_size < WS_END) fprintf(stderr, "kernel_launch: workspace too small: %zu < %zu\n", ws_size, (size_t)WS_END);
  }
  Args a; memset(&a, 0, sizeof(a));
  for (int i = 0; i < 25; ++i) a.in[i] = (const float*)d_in[i];
  a.out = (float*)d_out; a.ws = (unsigned char*)d_ws;
  const float* const* in = a.in;
  bf16_t* wp = (bf16_t*)((unsigned char*)d_ws + WS_W);
  int nd = 0, items = 0;
  auto add = [&](const float* src, const float* scale, int K, int Ns, int Nd, int kind) {
    WDesc& d = a.wd[nd++]; d.src = src; d.scale = scale; d.dst = wp; d.K = K; d.Ns = Ns; d.Nd = Nd; d.kind = kind; d.item0 = items; d.pad = 0;
    items += (K / 64) * (Nd / 32); wp += (size_t)K * Nd;
  };
  for (int l = 0; l < 2; ++l) add(in[6] + (size_t)l * DM * ZA_W, in[3] + (size_t)l * DM, DM, ZA_W, ZA_W, 0);
  for (int j = 0; j < 2; ++j) add(in[13] + (size_t)j * DM * ZB_W, in[3] + (size_t)(2 + j) * DM, DM, ZB_W, ZB_W, 0);
  add(in[11], in[10], DM, 576, KVW, 1);
  for (int j = 0; j < 2; ++j) add(in[16] + (size_t)j * 512 * GW, in[12], 512, GW, GW, 0);
  for (int j = 0; j < 2; ++j) add(in[17] + (size_t)j * 512 * GW, in[12], 512, GW, GW, 0);
  for (int l = 0; l < 4; ++l) add(in[19] + (size_t)l * DM * 1024, in[18] + (size_t)l * DM, DM, 1024, 1024, 0);
  for (int j = 0; j < 2; ++j) add(in[15] + (size_t)j * 512 * QW, in[14] + (size_t)j * 512, 512, QW, QW, 2);
  for (int l = 0; l < 4; ++l) add(in[20] + (size_t)l * DM * DM, nullptr, DM, DM, DM, 0);
  for (int l = 0; l < 4; ++l) add(in[21] + (size_t)l * DM * DFF2, in[4] + (size_t)l * DM, DM, DFF2, DFF2, 3);
  for (int l = 0; l < 4; ++l) add(in[24] + (size_t)l * DFF * DM, nullptr, DFF, DM, DM, 0);
  a.nitems = items;
  void* args[] = {&a};
  hipError_t e = hipLaunchCooperativeKernel((const void*)yoco_fwd, dim3(grid_blocks), dim3(512), args, LDS_BYTES, stream);
  if (e != hipSuccess) fprintf(stderr, "cooperative launch failed: %s (grid %d)\n", hipGetErrorString(e), grid_blocks);
}
```

```cpp
#include <hip/hip_runtime.h>
#include <hip/hip_cooperative_groups.h>
#include <cstdio>
#include <cstring>
namespace cg = cooperative_groups;

#define LAS __attribute__((address_space(3)))
typedef unsigned short bf16_t;
typedef short bf16x8 __attribute__((ext_vector_type(8)));
typedef short s16x4 __attribute__((ext_vector_type(4)));
typedef float f32x4 __attribute__((ext_vector_type(4)));
typedef float f32x2 __attribute__((ext_vector_type(2)));
typedef float f32x16 __attribute__((ext_vector_type(16)));
typedef unsigned u32x4 __attribute__((ext_vector_type(4)));
typedef unsigned u32x2 __attribute__((ext_vector_type(2)));

constexpr int DM = 2048, NB = 8, SEQ = 4096, MTOK = NB * SEQ, NMEM = 256, MMEM = NB * NMEM;
constexpr int GW = 1536, ZA_W = 3584, ZB_W = 1024, QW = 2304, KVW = 768, DFF = 5632, DFF2 = 11264;
constexpr float EPS = 1e-6f;
constexpr float LOG2E = 1.4426950408889634f;
constexpr float SC_MEM = 0.08838834764831845f * LOG2E;
constexpr float SC_MLA = 0.07216878364870323f * LOG2E;

constexpr size_t MiB = 1u << 20;
constexpr size_t WS_RS = 1 * MiB;
constexpr size_t WS_CS = 2 * MiB;
constexpr size_t WS_MEMB = 10 * MiB;
constexpr size_t WS_MEMK = 18 * MiB;
constexpr size_t WS_MEMVT = 26 * MiB;
constexpr size_t WS_W = 34 * MiB;
constexpr size_t WS_XB = 396 * MiB;
constexpr size_t WS_KVB = 524 * MiB;
constexpr size_t WS_KN = 572 * MiB;
constexpr size_t WS_VT = 668 * MiB;
constexpr size_t WS_HALO = 764 * MiB;
constexpr size_t WS_R = 852 * MiB;
constexpr size_t WS_CAT = WS_R + 224 * MiB;
constexpr size_t WS_Q = WS_R + 64 * MiB;
constexpr size_t WS_END = 1204 * MiB;

typedef __bf16 bf16x2_t __attribute__((ext_vector_type(2)));
__device__ __forceinline__ unsigned cvt_pk_bf16(float lo, float hi) { const f32x2 v = {lo, hi}; const bf16x2_t b = __builtin_convertvector(v, bf16x2_t); return __builtin_bit_cast(unsigned, b); }
__device__ __forceinline__ float wave_sum(float v) {
#pragma unroll
  for (int o = 1; o < 64; o <<= 1) v += __shfl_xor(v, o);
  return v;
}
__device__ __forceinline__ f32x2 gelu_pk(f32x2 v) {
  const f32x2 av = __builtin_elementwise_abs(v), d = av * 0.2316418882f + 1.0f;
  f32x2 t; t.x = __builtin_amdgcn_rcpf(d.x); t.y = __builtin_amdgcn_rcpf(d.y);
  f32x2 q = t * 0.5307027145f + (-0.7265760135f); q = q * t + 0.7107068705f; q = q * t + (-0.142248368f); q = q * t + 0.127414796f; q = q * t;
  const f32x2 s = (v * v) * (-0.72134752044f);
  f32x2 e; e.x = __builtin_amdgcn_exp2f(s.x); e.y = __builtin_amdgcn_exp2f(s.y);
  const f32x2 m = v * (q * e), r = v - m;
  f32x2 o; o.x = v.x < 0.f ? m.x : r.x; o.y = v.y < 0.f ? m.y : r.y; return o;
}
__device__ __forceinline__ f32x4 gelu4(f32x4 v) { f32x2 a = gelu_pk((f32x2){v[0], v[1]}), b = gelu_pk((f32x2){v[2], v[3]}); return (f32x4){a.x, a.y, b.x, b.y}; }
__device__ __forceinline__ float silu1(float x) { return x * __builtin_amdgcn_rcpf(1.0f + __builtin_amdgcn_exp2f(-x * LOG2E)); }
__device__ __forceinline__ float ror1(float v) { return __builtin_bit_cast(float, __builtin_amdgcn_update_dpp(0, __builtin_bit_cast(int, v), 0x121, 0xf, 0xf, false)); }
__device__ __forceinline__ float ror2(float v) { return __builtin_bit_cast(float, __builtin_amdgcn_update_dpp(0, __builtin_bit_cast(int, v), 0x122, 0xf, 0xf, false)); }
__device__ __forceinline__ f32x4 ror1v(f32x4 v) { return (f32x4){ror1(v[0]), ror1(v[1]), ror1(v[2]), ror1(v[3])}; }
__device__ __forceinline__ f32x4 ror2v(f32x4 v) { return (f32x4){ror2(v[0]), ror2(v[1]), ror2(v[2]), ror2(v[3])}; }

namespace pg8 {
constexpr int BM = 256, BK = 64, HALF = 128, HTB = HALF * BK * 2, STAGE_BYTES = 8 * HTB, NXCD = 8, WGM = 8;
__device__ __forceinline__ int lds_byte(int r, int c) { const int st = (r >> 4) * 2 + (c >> 5), rr = r & 15, cc = c & 31, ob = rr * 64 + cc * 2; return st * 1024 + (ob ^ (((ob >> 9) & 1) << 5)); }
__device__ __forceinline__ void stage_rc(int b, int& R, int& C) { const int st = b / 1024, sb = b % 1024, swz = sb ^ (((sb >> 9) & 1) << 5); R = (st >> 1) * 16 + swz / 64; C = (st & 1) * 32 + (swz % 64) / 2; }
__device__ __forceinline__ int perm32(int rho) { const int n = rho >> 4, i = rho & 15; return 8 * (i >> 2) + 4 * n + (i & 3); }
struct Unit { int pm, pn; };
struct Gemm { const bf16_t* A; const bf16_t* Bt; int M, N, K, lda, ldb; };
struct StaticOrder {
  int nM, nN, nwg, G, c;
  __device__ void init(int M, int N, int G_, int c_) { nM = M / BM; nN = N / BM; nwg = nM * nN; G = G_; c = c_; }
  __device__ bool next(int i, Unit& u) const {
    const long L = (long)i * G + c; if (L >= nwg) return false;
    int wgid = (int)L; { const int q = nwg / NXCD, r = nwg % NXCD, xcd = wgid % NXCD, off = wgid / NXCD; wgid = (xcd < r ? xcd * (q + 1) : r * (q + 1) + (xcd - r) * q) + off; }
    const int nig = WGM * nN, gid = wgid / nig, fm = gid * WGM, gsz = (nM - fm) < WGM ? (nM - fm) : WGM;
    u.pm = fm + ((wgid % nig) % gsz); u.pn = (wgid % nig) / gsz; return true;
  }
};

template <class Epi>
__device__ __forceinline__ void gemm_phase(LAS unsigned char* lds, const Gemm g, const StaticOrder& S, const Epi& E) {
  int tid_o = threadIdx.x; asm volatile("" : "+v"(tid_o));
  const int tid = tid_o, wid = __builtin_amdgcn_readfirstlane(tid >> 6), lane = tid & 63, wr = wid >> 2, wc = wid & 3, fr = lane & 15, fq = lane >> 4;
  const int K = g.K, nt = K / BK;
  unsigned voffA[2], voffB[2];
#pragma unroll
  for (int i = 0; i < 2; ++i) { int R, C; stage_rc(tid * 16 + i * 8192, R, C); const int Rb = Epi::PERM ? ((R & ~31) + perm32(R & 31)) : R;
    voffA[i] = (unsigned)(R * g.lda + C) * 2u; voffB[i] = (unsigned)(Rb * g.ldb + C) * 2u; }
  const size_t kstep = (size_t)(BK * 2);
  const size_t hstepA = (size_t)HALF * g.lda * 2, hstepB = (size_t)HALF * g.ldb * 2;
  const size_t tstepA = 2 * hstepA, tstepB = 2 * hstepB;
  const unsigned ldsw = (unsigned)wid * 1024u;
  const int aoff = lds_byte(wr * 64 + fr, fq * 8), boff = lds_byte(wc * 32 + fr, fq * 8);
#define PG8_SA(b, h) (((b) * 2 + (h)) * HTB)
#define PG8_SB(b, h) ((4 + (b) * 2 + (h)) * HTB)
#define PG8_STAGE(bufoff, gbase, voff) do { _Pragma("unroll") for (int _i = 0; _i < 2; ++_i) \
    __builtin_amdgcn_global_load_lds((const unsigned*)((const char*)(gbase) + (voff)[_i]), (LAS unsigned*)(lds + (bufoff) + ldsw + _i * 8192), 16, 0, 0); } while (0)
#define PG8_LDA(dst, b, h) do { _Pragma("unroll") for (int m = 0; m < 4; ++m) _Pragma("unroll") for (int k = 0; k < 2; ++k) dst[m][k] = *(const LAS bf16x8*)(lds + PG8_SA(b, h) + aoff + m * 2048 + k * 1024); } while (0)
#define PG8_LDB(dst, b, h) do { _Pragma("unroll") for (int n = 0; n < 2; ++n) _Pragma("unroll") for (int k = 0; k < 2; ++k) dst[n][k] = *(const LAS bf16x8*)(lds + PG8_SB(b, h) + boff + n * 2048 + k * 1024); } while (0)
#define PG8_MMA(ai, bj, At, Bt) do { __builtin_amdgcn_s_setprio(1); _Pragma("unroll") for (int m = 0; m < 4; ++m) _Pragma("unroll") for (int n = 0; n < 2; ++n) _Pragma("unroll") for (int k = 0; k < 2; ++k) \
    acc[ai][bj][m][n] = __builtin_amdgcn_mfma_f32_16x16x32_bf16(Bt[n][k], At[m][k], acc[ai][bj][m][n], 0, 0, 0); __builtin_amdgcn_s_setprio(0); } while (0)
#define PG8_WAIT_V(n) asm volatile("s_waitcnt vmcnt(" #n ")" ::: "memory")
#define PG8_WAIT_L(n) asm volatile("s_waitcnt lgkmcnt(" #n ")" ::: "memory")
#define PG8_BAR __builtin_amdgcn_s_barrier()
#define PG8_SCHED __builtin_amdgcn_sched_barrier(0)
  Unit cur, nxt; int ui = 0;
  if (!S.next(0, cur)) return;
  f32x4 acc[2][2][4][2];
  if constexpr (Epi::INIT) E.init(acc, cur, wr, wc, fr, fq);
  else {
#pragma unroll
  for (int a = 0; a < 2; ++a)
#pragma unroll
    for (int b = 0; b < 2; ++b)
#pragma unroll
      for (int m = 0; m < 4; ++m)
#pragma unroll
        for (int n = 0; n < 2; ++n) acc[a][b][m][n] = (f32x4){0.f, 0.f, 0.f, 0.f};
  }
  bf16x8 At[4][2], B0[2][2], B1[2][2];
  const char* cA = (const char*)g.A + (size_t)cur.pm * tstepA; const char* cB = (const char*)g.Bt + (size_t)cur.pn * tstepB;
  PG8_STAGE(PG8_SB(0, 0), cB, voffB); PG8_STAGE(PG8_SA(0, 0), cA, voffA); PG8_STAGE(PG8_SB(0, 1), cB + hstepB, voffB); PG8_STAGE(PG8_SA(0, 1), cA + hstepA, voffA);
  if (wr == 1) PG8_BAR;
  PG8_WAIT_V(4); PG8_BAR;
  PG8_STAGE(PG8_SB(1, 0), cB + kstep, voffB); PG8_STAGE(PG8_SA(1, 0), cA + kstep, voffA); PG8_STAGE(PG8_SB(1, 1), cB + hstepB + kstep, voffB);
  PG8_WAIT_V(6); PG8_BAR;
  for (;;) {
    const bool has_next = S.next(ui + 1, nxt);
    const char* nA = has_next ? (const char*)g.A + (size_t)nxt.pm * tstepA : cA; const char* nB = has_next ? (const char*)g.Bt + (size_t)nxt.pn * tstepB : cB;
    for (int t = 0; t < nt; t += 2) {
      const bool last = (t == nt - 2);
      const char* a1 = cA + (size_t)(t + 1) * kstep;
      const char* a2 = last ? nA : cA + (size_t)(t + 2) * kstep; const char* b2 = last ? nB : cB + (size_t)(t + 2) * kstep;
      const char* a3 = a2 + kstep; const char* b3 = b2 + kstep;
      PG8_LDB(B0, 0, 0); PG8_SCHED; PG8_LDA(At, 0, 0); PG8_STAGE(PG8_SA(1, 1), a1 + hstepA, voffA);
      PG8_WAIT_L(8); PG8_BAR; PG8_WAIT_L(0); PG8_MMA(0, 0, At, B0); PG8_BAR; PG8_SCHED;
      PG8_LDB(B1, 0, 1); PG8_STAGE(PG8_SB(0, 0), b2, voffB);
      PG8_BAR; PG8_WAIT_L(0); PG8_MMA(0, 1, At, B1); PG8_BAR;
      PG8_LDA(At, 0, 1); PG8_STAGE(PG8_SA(0, 0), a2, voffA);
      PG8_BAR; PG8_WAIT_L(0); PG8_MMA(1, 0, At, B0); PG8_BAR; PG8_SCHED;
      PG8_STAGE(PG8_SB(0, 1), b2 + hstepB, voffB);
      PG8_WAIT_V(6); PG8_BAR; PG8_MMA(1, 1, At, B1); PG8_BAR;
      PG8_LDB(B0, 1, 0); PG8_SCHED; PG8_LDA(At, 1, 0); PG8_STAGE(PG8_SA(0, 1), a2 + hstepA, voffA);
      PG8_WAIT_L(8); PG8_BAR; PG8_WAIT_L(0); PG8_MMA(0, 0, At, B0); PG8_BAR; PG8_SCHED;
      PG8_LDB(B1, 1, 1); PG8_STAGE(PG8_SB(1, 0), b3, voffB);
      PG8_BAR; PG8_WAIT_L(0); PG8_MMA(0, 1, At, B1); PG8_BAR;
      PG8_LDA(At, 1, 1); PG8_STAGE(PG8_SA(1, 0), a3, voffA);
      PG8_BAR; PG8_WAIT_L(0); PG8_MMA(1, 0, At, B0); PG8_BAR; PG8_SCHED;
      PG8_STAGE(PG8_SB(1, 1), b3 + hstepB, voffB);
      PG8_WAIT_V(6); PG8_BAR; PG8_MMA(1, 1, At, B1); PG8_BAR;
    }
    E(acc, cur, wr, wc, fr, fq);
    if (!has_next) break;
    if constexpr (Epi::INIT) E.init(acc, nxt, wr, wc, fr, fq);
    else {
#pragma unroll
    for (int a = 0; a < 2; ++a)
#pragma unroll
      for (int b = 0; b < 2; ++b)
#pragma unroll
        for (int m = 0; m < 4; ++m)
#pragma unroll
          for (int n = 0; n < 2; ++n) acc[a][b][m][n] = (f32x4){0.f, 0.f, 0.f, 0.f};
    }
    cur = nxt; cA = nA; cB = nB; ++ui;
  }
  PG8_WAIT_V(0);
  if (wr == 0) PG8_BAR;
  PG8_BAR;
#undef PG8_SA
#undef PG8_SB
#undef PG8_STAGE
#undef PG8_LDA
#undef PG8_LDB
#undef PG8_MMA
#undef PG8_WAIT_V
#undef PG8_WAIT_L
#undef PG8_BAR
#undef PG8_SCHED
}
}
using pg8::Unit; using pg8::HALF;
typedef f32x4 Acc[2][2][4][2];

struct EpiG {
  static constexpr bool PERM = true, INIT = false;
  bf16_t* O; int ldc;
  const float* rss; float rinvD;
  const float* css; float cinvD;
  int gelu_hi;
  int ss_lo, ss_hi; float* ssacc;
  int rope_mode;
  const f32x2* cs;
  int sc_lo; float sc_val;
  __device__ __forceinline__ void operator()(Acc& acc, const Unit& u, int wr, int wc, int fr, int fq) const {
    const int ct = u.pn * 256;
    const bool do_gelu = ct < gelu_hi, do_ss = (ct >= ss_lo && ct < ss_hi), do_sc = ct >= sc_lo;
    float rsv[2][4];
#pragma unroll
    for (int ai = 0; ai < 2; ++ai)
#pragma unroll
      for (int m = 0; m < 4; ++m) rsv[ai][m] = rss ? rss[u.pm * 256 + ai * HALF + wr * 64 + m * 16 + fr] : 1.0f;
    f32x4 cq[2][2];
#pragma unroll
    for (int bj = 0; bj < 2; ++bj) { const int c0 = ct + bj * HALF + wc * 32 + 8 * fq;
      cq[bj][0] = css ? *(const f32x4*)(css + c0) : (f32x4){1.f, 1.f, 1.f, 1.f}; cq[bj][1] = css ? *(const f32x4*)(css + c0 + 4) : (f32x4){1.f, 1.f, 1.f, 1.f}; }
    if (rss) {
#pragma unroll
      for (int ai = 0; ai < 2; ++ai)
#pragma unroll
        for (int m = 0; m < 4; ++m) rsv[ai][m] = __builtin_amdgcn_rsqf(rsv[ai][m] * rinvD + EPS);
    }
    if (css) {
#pragma unroll
      for (int bj = 0; bj < 2; ++bj)
#pragma unroll
        for (int h = 0; h < 2; ++h)
#pragma unroll
          for (int j = 0; j < 4; ++j) cq[bj][h][j] = __builtin_amdgcn_rsqf(cq[bj][h][j] * cinvD + EPS);
    }
#pragma unroll
    for (int ai = 0; ai < 2; ++ai)
#pragma unroll
      for (int m = 0; m < 4; ++m) {
        const int row = u.pm * 256 + ai * HALF + wr * 64 + m * 16 + fr;
        const float rs = rsv[ai][m];
        float ss = 0.f;
#pragma unroll
        for (int bj = 0; bj < 2; ++bj) {
          const int c0 = ct + bj * HALF + wc * 32 + 8 * fq;
          f32x4 v0 = acc[ai][bj][m][0] * rs, v1 = acc[ai][bj][m][1] * rs;
          if (css) { v0 = v0 * cq[bj][0]; v1 = v1 * cq[bj][1]; }
          if (do_gelu) { v0 = gelu4(v0); v1 = gelu4(v1); }
          if (do_ss) ss += (v0[0] * v0[0] + v0[1] * v0[1]) + (v0[2] * v0[2] + v0[3] * v0[3]) + (v1[0] * v1[0] + v1[1] * v1[1]) + (v1[2] * v1[2] + v1[3] * v1[3]);
          int roff = -1;
          if (rope_mode == 1) { const int d = c0 % 192; if (d >= 128) roff = d - 128; }
          else if (rope_mode == 2) { if (c0 >= 512 && c0 < 576) roff = c0 - 512; }
          if (roff >= 0) {
            const f32x2* t = cs + (size_t)row * 32 + (roff >> 1);
            const f32x2 t0 = t[0], t1 = t[1], t2 = t[2], t3 = t[3];
            f32x4 w0, w1;
            w0[0] = v0[0] * t0.x - v0[1] * t0.y; w0[1] = v0[1] * t0.x + v0[0] * t0.y;
            w0[2] = v0[2] * t1.x - v0[3] * t1.y; w0[3] = v0[3] * t1.x + v0[2] * t1.y;
            w1[0] = v1[0] * t2.x - v1[1] * t2.y; w1[1] = v1[1] * t2.x + v1[0] * t2.y;
            w1[2] = v1[2] * t3.x - v1[3] * t3.y; w1[3] = v1[3] * t3.x + v1[2] * t3.y;
            v0 = w0; v1 = w1;
          }
          if (do_sc) { v0 = v0 * sc_val; v1 = v1 * sc_val; }
          u32x4 w; w.x = cvt_pk_bf16(v0[0], v0[1]); w.y = cvt_pk_bf16(v0[2], v0[3]); w.z = cvt_pk_bf16(v1[0], v1[1]); w.w = cvt_pk_bf16(v1[2], v1[3]);
          *(u32x4*)(O + (size_t)row * ldc + c0) = w;
        }
        if (do_ss) { ss += __shfl_xor(ss, 16); ss += __shfl_xor(ss, 32); if (fq == 0) atomicAdd(ssacc + row, ss); }
      }
  }
};

struct EpiRes {
  static constexpr bool PERM = false, INIT = true;
  const float* xold; float* xnew; bf16_t* xb; float* ssacc;
  __device__ __forceinline__ void init(Acc& acc, const Unit& u, int wr, int wc, int fr, int fq) const {
    const int col0 = u.pn * 256 + wc * 32 + 4 * fq;
#pragma unroll
    for (int ai = 0; ai < 2; ++ai)
#pragma unroll
      for (int bj = 0; bj < 2; ++bj)
#pragma unroll
        for (int m = 0; m < 4; ++m)
#pragma unroll
          for (int n = 0; n < 2; ++n) {
            const int row = u.pm * 256 + ai * HALF + wr * 64 + m * 16 + fr;
            acc[ai][bj][m][n] = *(const f32x4*)(xold + (size_t)row * DM + col0 + bj * HALF + n * 16);
          }
  }
  __device__ __forceinline__ void operator()(Acc& acc, const Unit& u, int wr, int wc, int fr, int fq) const {
    const int col0 = u.pn * 256 + wc * 32 + 4 * fq;
#pragma unroll
    for (int ai = 0; ai < 2; ++ai)
#pragma unroll
      for (int m = 0; m < 4; ++m) {
        const int row = u.pm * 256 + ai * HALF + wr * 64 + m * 16 + fr;
        float ss = 0.f;
#pragma unroll
        for (int bj = 0; bj < 2; ++bj)
#pragma unroll
          for (int n = 0; n < 2; ++n) {
            const size_t off = (size_t)row * DM + col0 + bj * HALF + n * 16;
            const f32x4 v = acc[ai][bj][m][n];
            *(f32x4*)(xnew + off) = v;
            u32x2 w; w.x = cvt_pk_bf16(v[0], v[1]); w.y = cvt_pk_bf16(v[2], v[3]);
            *(u32x2*)(xb + off) = w;
            ss += (v[0] * v[0] + v[1] * v[1]) + (v[2] * v[2] + v[3] * v[3]);
          }
        ss += __shfl_xor(ss, 16); ss += __shfl_xor(ss, 32);
        if (fq == 0) atomicAdd(ssacc + row, ss);
      }
  }
};

struct EpiUp {
  static constexpr bool PERM = true, INIT = false;
  bf16_t* g; float* halo; const float* rss; const float* cw; const float* cb; LAS unsigned char* epl;
  __device__ __forceinline__ void operator()(Acc& acc, const Unit& u, int wr, int wc, int fr, int fq) const {
    const int rowb = u.pm * 256 + wr * 64;
    const int c0 = u.pn * 128 + wc * 32 + 8 * fq;
    float rr[2][4];
#pragma unroll
    for (int ai = 0; ai < 2; ++ai)
#pragma unroll
      for (int m = 0; m < 4; ++m) rr[ai][m] = rss[rowb + ai * HALF + m * 16 + fr];
    LAS unsigned char* wl = epl + (wr * 4 + wc) * 1024;
    { const int lane = fq * 16 + fr, arr = lane >> 3, part = lane & 7, col = u.pn * 128 + wc * 32 + 4 * part;
      const float* sp = ((arr & 3) == 3 ? cb : cw + (size_t)(arr & 3) * DFF2) + (arr >> 2) * DFF + col;
      const f32x4 wv = *(const f32x4*)sp;
      *(LAS f32x4*)(wl + lane * 16) = wv; }
#pragma unroll
    for (int ai = 0; ai < 2; ++ai)
#pragma unroll
      for (int m = 0; m < 4; ++m) {
        const float r = __builtin_amdgcn_rsqf(rr[ai][m] * (1.0f / DM) + EPS);
#pragma unroll
        for (int bj = 0; bj < 2; ++bj)
#pragma unroll
          for (int n = 0; n < 2; ++n) acc[ai][bj][m][n] = acc[ai][bj][m][n] * r;
      }
    asm volatile("s_waitcnt lgkmcnt(0)" ::: "memory");
#pragma unroll
    for (int n = 0; n < 2; ++n) {
      const int cc = c0 + 4 * n;
      const LAS unsigned char* wp = wl + (8 * fq + 4 * n) * 4;
      const f32x4 wg0 = *(const LAS f32x4*)(wp), wg1 = *(const LAS f32x4*)(wp + 128), wg2 = *(const LAS f32x4*)(wp + 256), bg = *(const LAS f32x4*)(wp + 384);
      const f32x4 wv0 = *(const LAS f32x4*)(wp + 512), wv1 = *(const LAS f32x4*)(wp + 640), wv2 = *(const LAS f32x4*)(wp + 768), bv = *(const LAS f32x4*)(wp + 896);
#pragma unroll
      for (int ai = 0; ai < 2; ++ai) {
        f32x4 g1p = (f32x4){0.f, 0.f, 0.f, 0.f}, g2p = g1p, v1p = g1p, v2p = g1p;
#pragma unroll
        for (int m = 0; m < 4; ++m) {
          const f32x4 G = acc[ai][0][m][n], V = acc[ai][1][m][n];
          const f32x4 g1 = ror1v(G), g2 = ror2v(G), v1 = ror1v(V), v2 = ror2v(V);
          const f32x4 pg1 = fr >= 1 ? g1 : g1p, pg2 = fr >= 2 ? g2 : g2p, pv1 = fr >= 1 ? v1 : v1p, pv2 = fr >= 2 ? v2 : v2p;
          const f32x4 cgt = wg2 * G + wg1 * pg1 + wg0 * pg2 + bg;
          const f32x4 cvl = wv2 * V + wv1 * pv1 + wv0 * pv2 + bv;
          g1p = g1; g2p = g2; v1p = v1; v2p = v2;
          const int row = rowb + ai * HALF + m * 16 + fr;
          if (m > 0 || fr >= 2) {
            u32x2 w; w.x = cvt_pk_bf16(silu1(cgt[0]) * cvl[0], silu1(cgt[1]) * cvl[1]); w.y = cvt_pk_bf16(silu1(cgt[2]) * cvl[2], silu1(cgt[3]) * cvl[3]);
            *(u32x2*)(g + (size_t)row * DFF + cc) = w;
          }
          int slot = -1;
          if (m == 0 && fr < 2) slot = fr;
          if (m == 3 && fr >= 14) slot = fr - 12;
          if (slot >= 0) {
            float* hp = halo + ((size_t)(row >> 6) * 4 + slot) * DFF2 + cc;
            *(f32x4*)hp = G; *(f32x4*)(hp + DFF) = V;
          }
        }
      }
    }
  }
};

constexpr int ATT_KBUF = 64 * 400, ATT_VROWB = 136, ATT_VBUF = 128 * ATT_VROWB, ATT_BUF = ATT_KBUF + ATT_VBUF;
template <int DQK, bool CAUSAL>
__device__ __forceinline__ void attn_unit(LAS unsigned char* lds, const bf16_t* Q, int ldq, const bf16_t* K1, int ldk1, const bf16_t* K2, int ldk2,
                                          const bf16_t* VT, int ldv, int ntiles, int q0, bf16_t* O, int ldo) {
  constexpr int KROWB = (DQK + 8) * 2, NKS = DQK / 16, CPR = DQK / 8, NKCH = 64 * CPR / 512;
  int tid_o = threadIdx.x; asm volatile("" : "+v"(tid_o));
  const int tid = tid_o, wid = __builtin_amdgcn_readfirstlane(tid >> 6), lane = tid & 63, r32 = lane & 31, hi = lane >> 5;
  bf16x8 qf[NKS];
  { const bf16_t* qp = Q + (size_t)(wid * 32 + r32) * ldq + hi * 8;
#pragma unroll
    for (int ks = 0; ks < NKS; ++ks) qf[ks] = *(const bf16x8*)(qp + ks * 16); }
  u32x4 kreg[NKCH], vreg[2];
#define ATT_GLOAD(t_) do { const int k0_ = (t_) * 64; \
    _Pragma("unroll") for (int i = 0; i < NKCH; ++i) { const int ch = tid + i * 512, kr = ch / CPR, kc = ch - kr * CPR; \
      const bf16_t* src = (DQK == 128 || kc < 16) ? K1 + (size_t)(k0_ + kr) * ldk1 + kc * 8 : K2 + (size_t)(k0_ + kr) * ldk2 + (kc - 16) * 8; \
      kreg[i] = *(const u32x4*)src; } \
    _Pragma("unroll") for (int i = 0; i < 2; ++i) { const int ch = tid + i * 512, d = ch >> 3, cc = ch & 7; vreg[i] = *(const u32x4*)(VT + (size_t)d * ldv + k0_ + cc * 8); } } while (0)
#define ATT_LWRITE(buf_) do { LAS unsigned char* kb_ = lds + (buf_) * ATT_BUF; \
    _Pragma("unroll") for (int i = 0; i < NKCH; ++i) { const int ch = tid + i * 512, kr = ch / CPR, kc = ch - kr * CPR; *(LAS u32x4*)(kb_ + kr * KROWB + kc * 16) = kreg[i]; } \
    _Pragma("unroll") for (int i = 0; i < 2; ++i) { const int ch = tid + i * 512, d = ch >> 3, cc = ch & 7; LAS unsigned char* p = kb_ + ATT_KBUF + d * ATT_VROWB + cc * 16; \
      *(LAS u32x2*)p = (u32x2){vreg[i].x, vreg[i].y}; *(LAS u32x2*)(p + 8) = (u32x2){vreg[i].z, vreg[i].w}; } } while (0)
  f32x16 o[4];
#pragma unroll
  for (int d = 0; d < 4; ++d)
#pragma unroll
    for (int i = 0; i < 16; ++i) o[d][i] = 0.f;
  float mrow = -INFINITY, lsum = 0.f;
  const int qabs = q0 + wid * 32 + r32, qlo = q0 + wid * 32;
  ATT_GLOAD(0); ATT_LWRITE(0); __syncthreads();
  for (int t = 0; t < ntiles; ++t) {
    const int buf = t & 1;
    if (t + 1 < ntiles) ATT_GLOAD(t + 1);
    const int k0 = t * 64;
    if (!CAUSAL || k0 <= qlo + 31) {
      const LAS unsigned char* kb = lds + buf * ATT_BUF;
      f32x16 s0, s1;
#pragma unroll
      for (int i = 0; i < 16; ++i) { s0[i] = 0.f; s1[i] = 0.f; }
#pragma unroll
      for (int ks = 0; ks < NKS; ++ks) {
        const bf16x8 ka = *(const LAS bf16x8*)(kb + r32 * KROWB + ks * 32 + hi * 16);
        const bf16x8 kc = *(const LAS bf16x8*)(kb + (32 + r32) * KROWB + ks * 32 + hi * 16);
        s0 = __builtin_amdgcn_mfma_f32_32x32x16_bf16(ka, qf[ks], s0, 0, 0, 0);
        s1 = __builtin_amdgcn_mfma_f32_32x32x16_bf16(kc, qf[ks], s1, 0, 0, 0);
      }
      if (CAUSAL && k0 + 63 > qlo) {
#pragma unroll
        for (int i = 0; i < 16; ++i) { const int kv = k0 + (i & 3) + 8 * (i >> 2) + 4 * hi;
          if (kv > qabs) s0[i] = -INFINITY; if (kv + 32 > qabs) s1[i] = -INFINITY; }
      }
      float mx = s0[0];
#pragma unroll
      for (int i = 1; i < 16; ++i) mx = fmaxf(mx, s0[i]);
#pragma unroll
      for (int i = 0; i < 16; ++i) mx = fmaxf(mx, s1[i]);
      mx = fmaxf(mx, __shfl_xor(mx, 32));
      const float mnew = fmaxf(mrow, mx);
      const float alpha = __builtin_amdgcn_exp2f(mrow - mnew);
      mrow = mnew;
      float ps = 0.f;
#pragma unroll
      for (int i = 0; i < 16; ++i) { s0[i] = __builtin_amdgcn_exp2f(s0[i] - mnew); s1[i] = __builtin_amdgcn_exp2f(s1[i] - mnew); ps += s0[i] + s1[i]; }
      lsum = lsum * alpha + ps;
#pragma unroll
      for (int d = 0; d < 4; ++d)
#pragma unroll
        for (int i = 0; i < 16; ++i) o[d][i] *= alpha;
      bf16x8 pa[4];
#pragma unroll
      for (int s = 0; s < 4; ++s) {
        u32x4 w;
        if (s < 2) { w.x = cvt_pk_bf16(s0[8 * s + 0], s0[8 * s + 1]); w.y = cvt_pk_bf16(s0[8 * s + 2], s0[8 * s + 3]); w.z = cvt_pk_bf16(s0[8 * s + 4], s0[8 * s + 5]); w.w = cvt_pk_bf16(s0[8 * s + 6], s0[8 * s + 7]); }
        else { const int b = 8 * (s - 2); w.x = cvt_pk_bf16(s1[b + 0], s1[b + 1]); w.y = cvt_pk_bf16(s1[b + 2], s1[b + 3]); w.z = cvt_pk_bf16(s1[b + 4], s1[b + 5]); w.w = cvt_pk_bf16(s1[b + 6], s1[b + 7]); }
        pa[s] = __builtin_bit_cast(bf16x8, w);
      }
      const LAS unsigned char* vb = kb + ATT_KBUF;
#pragma unroll
      for (int d = 0; d < 4; ++d)
#pragma unroll
        for (int s = 0; s < 4; ++s) {
          const LAS unsigned char* p = vb + (32 * d + r32) * ATT_VROWB + (16 * s + 4 * hi) * 2;
          const u32x2 lo = *(const LAS u32x2*)p, hh = *(const LAS u32x2*)(p + 16);
          const bf16x8 vf = __builtin_bit_cast(bf16x8, (u32x4){lo.x, lo.y, hh.x, hh.y});
          o[d] = __builtin_amdgcn_mfma_f32_32x32x16_bf16(vf, pa[s], o[d], 0, 0, 0);
        }
    }
    if (t + 1 < ntiles) ATT_LWRITE(buf ^ 1);
    __syncthreads();
  }
#undef ATT_GLOAD
#undef ATT_LWRITE
  const float inv = 1.0f / (lsum + __shfl_xor(lsum, 32));
  bf16_t* op = O + (size_t)(wid * 32 + r32) * ldo + 4 * hi;
#pragma unroll
  for (int d = 0; d < 4; ++d)
#pragma unroll
    for (int ig = 0; ig < 4; ++ig) {
      u32x2 w; w.x = cvt_pk_bf16(o[d][4 * ig] * inv, o[d][4 * ig + 1] * inv); w.y = cvt_pk_bf16(o[d][4 * ig + 2] * inv, o[d][4 * ig + 3] * inv);
      *(u32x2*)(op + 32 * d + 8 * ig) = w;
    }
}


#define XB_TMO      128
#define XB_XCNT(j)  (256  + 64 * (j))
#define XB_XSUB(j)  (1280 + 64 * (j))
#define XB_XGEN(j)  (2304 + 64 * (j))
#define XB_TOP      3328
#define XB_TOPGEN   3392
#define XCD_BAR_WORDS 3456
#define XB_SPIN_CAP (1u << 18)
__device__ __forceinline__ unsigned xb_ld(unsigned* p)              { return __hip_atomic_load(p, __ATOMIC_RELAXED, __HIP_MEMORY_SCOPE_AGENT); }
__device__ __forceinline__ unsigned xb_add(unsigned* p, unsigned v) { return __hip_atomic_fetch_add(p, v, __ATOMIC_RELAXED, __HIP_MEMORY_SCOPE_AGENT); }
__device__ __forceinline__ unsigned xb_xcc_id() { return (unsigned)__builtin_amdgcn_s_getreg((3 << 11) | 20) & 0xFu; }
#define XB_SPIN(cond, bar) do { unsigned _sp = 0; while (cond) { __builtin_amdgcn_s_sleep(1); \
    if ((++_sp & 255u) == 0u) { if (xb_ld(&(bar)[XB_TMO])) break; if (_sp > XB_SPIN_CAP) { atomicAdd(&(bar)[XB_TMO], 1u); break; } } } } while (0)
struct XcdBarrier { unsigned* bar; unsigned x; volatile LAS unsigned* st; };
__device__ __forceinline__ XcdBarrier xcd_barrier_post(unsigned* bar, volatile LAS unsigned* st) {
  XcdBarrier b; b.bar = bar; b.x = xb_xcc_id(); b.st = st;
  if (threadIdx.x == 0) (void)xb_add(&bar[XB_XCNT(b.x)], 1u);
  return b;
}
__device__ __forceinline__ void xcd_barrier_complete(unsigned* bar, unsigned x, unsigned& nloc, unsigned& nx) {
  const unsigned G = gridDim.x * gridDim.y * gridDim.z;
  unsigned sum, cnt, mine, sp = 0u;
  for (;;) {
    sum = 0u; cnt = 0u; mine = 0u;
#pragma unroll
    for (unsigned j = 0; j < 16; ++j) { const unsigned c = xb_ld(&bar[XB_XCNT(j)]); sum += c; cnt += (c > 0u) ? 1u : 0u; mine = (j == x) ? c : mine; }
    if (sum == G) break;
    __builtin_amdgcn_s_sleep(1);
    if ((++sp & 255u) == 0u) { if (xb_ld(&bar[XB_TMO])) break; if (sp > XB_SPIN_CAP) { atomicAdd(&bar[XB_TMO], 1u); break; } }
  }
  nloc = mine > 0u ? mine : 1u; nx = cnt > 0u ? cnt : 1u;
}
__device__ __forceinline__ void xcd_barrier(const XcdBarrier& b) {
  asm volatile("s_waitcnt vmcnt(0)" ::: "memory");
  __syncthreads();
  if (threadIdx.x == 0) {
    unsigned* bar = b.bar;
    __builtin_amdgcn_s_waitcnt(0);
    unsigned nloc = b.st[0], nx = b.st[1];
    if (nloc == 0u) { xcd_barrier_complete(bar, b.x, nloc, nx); b.st[0] = nloc; b.st[1] = nx; }
    const unsigned old = xb_add(&bar[XB_XSUB(b.x)], 1u);
    const unsigned gen = old / nloc;
    if (old + 1u == (gen + 1u) * nloc) {
      __builtin_amdgcn_fence(__ATOMIC_RELEASE, "agent");
      asm volatile("s_waitcnt vmcnt(0)" ::: "memory");
      const unsigned og = xb_add(&bar[XB_TOP], 1u);
      const unsigned tg = og / nx;
      if (og + 1u == (tg + 1u) * nx) xb_add(&bar[XB_TOPGEN], 1u);
      else XB_SPIN(xb_ld(&bar[XB_TOPGEN]) == tg, bar);
      __builtin_amdgcn_fence(__ATOMIC_ACQUIRE, "agent");
      xb_add(&bar[XB_XGEN(b.x)], 1u);
      asm volatile("s_waitcnt vmcnt(0)" ::: "memory");
    } else {
      XB_SPIN(xb_ld(&bar[XB_XGEN(b.x)]) == gen, bar);
      __builtin_amdgcn_fence(__ATOMIC_ACQUIRE, "agent");
      asm volatile("s_waitcnt vmcnt(0)" ::: "memory");
    }
  }
  __syncthreads();
}

constexpr int NWD = 27;
struct WDesc { const float* src; const float* scale; bf16_t* dst; int K, Ns, Nd, kind, item0, pad; };
struct Args { const float* in[25]; float* out; unsigned char* ws; WDesc wd[NWD]; int nitems; int pad; };

__device__ __forceinline__ int srccol(int kind, int n) {
  if (kind == 0) return n;
  if (kind == 1) { if (n < 512) return n; if (n < 576) { const int r = n - 512; return 512 + ((r & 1) ? 32 : 0) + (r >> 1); } return -1; }
  if (kind == 2) { const int h = n / 192, d = n - h * 192; if (d < 128) return n; const int r = d - 128; return h * 192 + 128 + ((r & 1) ? 32 : 0) + (r >> 1); }
  { const int t = n >> 8, w = n & 255; return (w >> 7) * DFF + 128 * t + (w & 127); }
}

constexpr int LDS_BYTES = 140 * 1024;
#ifndef ONLY
#define ONLY 0
#endif
#define EN(k) (ONLY == 0 || ONLY == (k))
typedef __attribute__((address_space(4))) const Args CArgs;
#define DERIVE_PTRS(ap) \
  unsigned char* ws = (ap)->ws; \
  float* rsA = (float*)(ws + WS_RS); float* rsB = rsA + MTOK; float* rsV = rsB + MTOK; float* rsQ = rsV + MTOK; float* rsKV = rsQ + MTOK; float* rsM = rsKV + MTOK; \
  f32x2* cs = (f32x2*)(ws + WS_CS); \
  bf16_t* memb = (bf16_t*)(ws + WS_MEMB); bf16_t* memk = (bf16_t*)(ws + WS_MEMK); bf16_t* memvt = (bf16_t*)(ws + WS_MEMVT); \
  bf16_t* xb = (bf16_t*)(ws + WS_XB); bf16_t* kvb = (bf16_t*)(ws + WS_KVB); bf16_t* kn = (bf16_t*)(ws + WS_KN); bf16_t* vT = (bf16_t*)(ws + WS_VT); \
  float* halo = (float*)(ws + WS_HALO); \
  bf16_t* gbuf = (bf16_t*)(ws + WS_R); bf16_t* zbuf = (bf16_t*)(ws + WS_R); bf16_t* cat = (bf16_t*)(ws + WS_CAT); bf16_t* qbuf = (bf16_t*)(ws + WS_Q); \
  const float* x_in = (ap)->in[0]; float* xo = (ap)->out; \
  (void)rsA; (void)rsB; (void)rsV; (void)rsQ; (void)rsKV; (void)rsM; (void)cs; (void)memb; (void)memk; (void)memvt; (void)xb; (void)kvb; (void)kn; (void)vT; (void)halo; (void)gbuf; (void)zbuf; (void)cat; (void)qbuf; (void)x_in; (void)xo;
__global__ void __launch_bounds__(512, 2) yoco_fwd(Args a) {
  extern __shared__ __attribute__((aligned(16))) unsigned char lds_raw[];
  LAS unsigned char* lds = (LAS unsigned char*)lds_raw;
  cg::grid_group grid = cg::this_grid();
  volatile LAS unsigned* xst = (volatile LAS unsigned*)(lds + 131072 + 64);
  if (threadIdx.x < 4) xst[threadIdx.x] = 0u;
  __syncthreads();
#define DERIVE_IDS \
  int tid_o = threadIdx.x; asm volatile("" : "+v"(tid_o)); \
  const int tid = tid_o, lane = tid & 63, wave = __builtin_amdgcn_readfirstlane(tid >> 6); \
  const int G = gridDim.x, bx = blockIdx.x; \
  const int vcu = (G % 8 == 0) ? (bx % 8) * (G / 8) + bx / 8 : bx; \
  const int gw = vcu * 8 + wave, NGW = G * 8; \
  const size_t gtid = (size_t)bx * 512 + tid, NGT = (size_t)G * 512; \
  (void)lane; (void)wave; (void)vcu; (void)gw; (void)NGW; (void)gtid; (void)NGT;
  {
    const Args* ap = &a; DERIVE_PTRS(ap)
    DERIVE_IDS
    LAS float* scr = (LAS float*)(lds + wave * 8448);
    for (int it = gw; it < a.nitems; it += NGW) {
      int di = 0;
#pragma unroll 1
      for (int j = 1; j < NWD; ++j) if (it >= a.wd[j].item0) di = j;
      const float* src = a.wd[di].src; const float* scale = a.wd[di].scale; bf16_t* dst = a.wd[di].dst;
      const int K = a.wd[di].K, Ns = a.wd[di].Ns, Nd = a.wd[di].Nd, kind = a.wd[di].kind, item = it - a.wd[di].item0;
      const int nblk = Nd / 32, kb = item / nblk, nb = item - kb * nblk, k0 = 64 * kb, n0 = 32 * nb;
      const int sc = srccol(kind, n0 + (lane & 31));
      float wv[32];
      { const float* sp = src + (size_t)(k0 + (lane >> 5)) * Ns + (sc >= 0 ? sc : 0);
#pragma unroll
        for (int i = 0; i < 32; ++i) wv[i] = sp[(size_t)(2 * i) * Ns]; }
      if (scale) {
#pragma unroll
        for (int i = 0; i < 32; ++i) wv[i] *= scale[k0 + 2 * i + (lane >> 5)];
      }
#pragma unroll
      for (int i = 0; i < 32; ++i) scr[(2 * i + (lane >> 5)) * 33 + (lane & 31)] = (sc >= 0) ? wv[i] : 0.f;
      asm volatile("s_waitcnt lgkmcnt(0)" ::: "memory");
      const int c = lane & 7;
#pragma unroll
      for (int j = 0; j < 4; ++j) { const int n = (lane >> 3) + 8 * j; const LAS float* s = scr + (8 * c) * 33 + n;
        u32x4 o; o.x = cvt_pk_bf16(s[0 * 33], s[1 * 33]); o.y = cvt_pk_bf16(s[2 * 33], s[3 * 33]); o.z = cvt_pk_bf16(s[4 * 33], s[5 * 33]); o.w = cvt_pk_bf16(s[6 * 33], s[7 * 33]);
        *(u32x4*)(dst + (size_t)(n0 + n) * K + k0 + 8 * c) = o; }
      asm volatile("s_waitcnt lgkmcnt(0)" ::: "memory");
    }
    for (int r = gw; r < MTOK + MMEM; r += NGW) {
      const bool ism = r >= MTOK; const int rr = ism ? r - MTOK : r;
      const f32x4* xr = (const f32x4*)((ism ? a.in[1] : x_in) + (size_t)rr * DM) + lane;
      u32x2* o8 = (u32x2*)((ism ? memb : xb) + (size_t)rr * DM) + lane;
      float s = 0.f;
#pragma unroll
      for (int j = 0; j < 8; ++j) { const f32x4 v = xr[64 * j]; s += (v[0] * v[0] + v[1] * v[1]) + (v[2] * v[2] + v[3] * v[3]); u32x2 w; w.x = cvt_pk_bf16(v[0], v[1]); w.y = cvt_pk_bf16(v[2], v[3]); o8[64 * j] = w; }
      s = wave_sum(s);
      if (lane == 0) (ism ? rsM : rsA)[rr] = s;
    }
    const int* pos = (const int*)a.in[2];
    for (size_t i = gtid; i < (size_t)MTOK * 32; i += NGT) {
      const int row = (int)(i >> 5), j = (int)(i & 31);
      const float inv = 1.0f / powf(10000.0f, (float)(2 * j) / 64.0f);
      const float ang = (float)pos[row] * inv;
      const double rev = (double)ang * 0.15915494309189535;
      const float fr = (float)(rev - floor(rev));
      cs[i] = (f32x2){__builtin_amdgcn_cosf(fr), __builtin_amdgcn_sinf(fr)};
    }
    for (size_t i = gtid; i < (size_t)MTOK * 4; i += NGT) rsB[i] = 0.f;
    if (bx == 0) for (int i = tid; i < XCD_BAR_WORDS; i += 512) ((unsigned*)ws)[i] = 0u;
  }
  grid.sync();
  const XcdBarrier xbar = xcd_barrier_post((unsigned*)a.ws, xst);

  pg8::StaticOrder S;
#pragma unroll 1
  for (int l = -1; l < 4; ++l) {
    const bool isA = l < 2; const int j = l - 2;
#pragma unroll 1
    for (int s = 0; s < 10; ++s) {
      CArgs* ap = (CArgs*)__builtin_amdgcn_kernarg_segment_ptr(); asm volatile("" : "+s"(ap));
      DERIVE_PTRS(ap)
      DERIVE_IDS
      int type = 0; bool sync = false;
      pg8::Gemm g{nullptr, nullptr, 0, 0, 0, 0, 0}; int corder = bx;
      EpiG eg{nullptr, 0, nullptr, 0.f, nullptr, 0.f, 0, 0, 0, nullptr, 0, nullptr, 1 << 30, 1.f};
      EpiRes er{nullptr, nullptr, xb, nullptr};
      if (l < 0) {
        if (s < 8) {
          const int ml = s >> 1; const bf16_t* wt = ap->wd[9 + ml].dst;
          type = 1; corder = (bx + 16 * s) % G; sync = (s == 7);
          if (!(s & 1)) { g = pg8::Gemm{memb, wt, MMEM, 512, DM, DM, DM}; eg.O = memk + (size_t)ml * MMEM * 512; eg.ldc = 512; eg.rss = rsM; eg.rinvD = 1.0f / DM; }
          else { g = pg8::Gemm{wt + (size_t)512 * DM, memb, 512, MMEM, DM, DM, DM}; eg.O = memvt + (size_t)ml * 512 * MMEM; eg.ldc = MMEM; eg.css = rsM; eg.cinvD = 1.0f / DM; }
        }
      } else {
        switch (s) {
          case 0: if (l == 2) { type = 1; sync = true;
              g = pg8::Gemm{xb, ap->wd[4].dst, MTOK, KVW, DM, DM, DM};
              eg.O = kvb; eg.ldc = KVW; eg.rss = rsA; eg.rinvD = 1.0f / DM; eg.ss_lo = 0; eg.ss_hi = 512; eg.ssacc = rsKV; eg.rope_mode = 2; eg.cs = cs; } break;
          case 1: type = 1; eg.O = zbuf; eg.rss = rsA; eg.rinvD = 1.0f / DM; eg.sc_val = SC_MEM;
            if (isA) { sync = true; g = pg8::Gemm{xb, ap->wd[l].dst, MTOK, ZA_W, DM, DM, DM}; eg.ldc = ZA_W; eg.gelu_hi = 2 * GW; eg.ss_lo = GW; eg.ss_hi = 2 * GW; eg.ssacc = rsV; eg.sc_lo = 2 * GW; }
            else { g = pg8::Gemm{xb, ap->wd[2 + j].dst, MTOK, ZB_W, DM, DM, DM}; eg.ldc = ZB_W; eg.ss_lo = 0; eg.ss_hi = 512; eg.ssacc = rsQ; eg.sc_lo = 512; }
            break;
          case 2: if (!isA) { type = 1; g = pg8::Gemm{kvb, ap->wd[5 + j].dst, MTOK, GW, 512, KVW, 512}; eg.O = kn; eg.ldc = GW; eg.rss = rsKV; eg.rinvD = 1.0f / 512; } break;
          case 3: if (!isA) { type = 1; sync = true; g = pg8::Gemm{ap->wd[7 + j].dst, kvb, GW, MTOK, 512, 512, KVW}; eg.O = vT; eg.ldc = MTOK; eg.css = rsKV; eg.cinvD = 1.0f / 512; } break;
          case 4: if (!isA) { type = 1; sync = true; g = pg8::Gemm{zbuf, ap->wd[13 + j].dst, MTOK, QW, 512, ZB_W, 512};
              eg.O = qbuf; eg.ldc = QW; eg.rss = rsQ; eg.rinvD = 1.0f / 512; eg.rope_mode = 1; eg.cs = cs; eg.sc_lo = 0; eg.sc_val = SC_MLA; } break;
          case 5: type = 4; sync = true; break;
          case 6: type = 2; sync = true; g = pg8::Gemm{cat, ap->wd[15 + l].dst, MTOK, DM, DM, DM, DM}; er.xold = (l == 0) ? x_in : xo; er.xnew = xo; er.ssacc = rsB; break;
          case 7: type = 3; sync = true; g = pg8::Gemm{xb, ap->wd[19 + l].dst, MTOK, DFF2, DM, DM, DM}; break;
          case 8: type = 5; sync = true; break;
          case 9: type = 2; sync = true; g = pg8::Gemm{gbuf, ap->wd[23 + l].dst, MTOK, DM, DFF, DFF, DFF}; er.xold = xo; er.xnew = xo; er.ssacc = rsA; break;
        }
      }
      if (type == 1 && EN(1)) { S.init(g.M, g.N, G, corder); pg8::gemm_phase<EpiG>(lds, g, S, eg); }
      else if (type == 2 && EN(2)) {
        S.init(g.M, g.N, G, corder); pg8::gemm_phase<EpiRes>(lds, g, S, er);
        if (s == 6) for (size_t i = gtid; i < (size_t)MTOK; i += NGT) { rsA[i] = 0.f; rsV[i] = 0.f; rsQ[i] = 0.f; }
      }
      else if (type == 3 && EN(3)) {
        S.init(g.M, g.N, G, corder);
        EpiUp E{gbuf, halo, rsB, ap->in[22] + (size_t)l * 3 * DFF2, ap->in[23] + (size_t)l * DFF2, lds + 131072 + 1024};
        pg8::gemm_phase<EpiUp>(lds, g, S, E);
      }
      else if (type == 4 && (EN(4) || EN(6) || EN(7))) {
        if (isA && EN(4)) {
          const float* wsp = ap->in[8] + (size_t)l * 12 * 128 * 128; const float* bsp = ap->in[9] + (size_t)l * 12 * 128; const float* gv = ap->in[7] + (size_t)l * GW;
          LAS unsigned char* Wl = lds; LAS unsigned char* Vt = lds + 128 * 272;
          const int r32 = lane & 31, hi = lane >> 5, tb = wave & 3, chh = wave >> 2;
          for (int uidx = vcu; uidx < NB * 32 * 12; uidx += G) {
            const int gi = uidx % 12, bn = uidx / 12, tok0 = bn * 128;
#pragma unroll
            for (int i = 0; i < 8; ++i) { const int idx = tid + i * 512, t = idx >> 5, s4 = (idx & 31) * 4;
              f32x4 w = *(const f32x4*)(wsp + ((size_t)gi * 128 + t) * 128 + s4);
              const f32x4 q = *(const f32x4*)(rsV + tok0 + s4);
#pragma unroll
              for (int e = 0; e < 4; ++e) w[e] = (s4 + e <= t) ? w[e] * __builtin_amdgcn_rsqf(q[e] * (1.0f / GW) + EPS) : 0.f;
              *(LAS u32x2*)(Wl + t * 272 + s4 * 2) = (u32x2){cvt_pk_bf16(w[0], w[1]), cvt_pk_bf16(w[2], w[3])}; }
#pragma unroll
            for (int i = 0; i < 4; ++i) { const int idx = tid + i * 512, sr = idx >> 4, c8 = (idx & 15) * 8;
              const u32x4 v = *(const u32x4*)(zbuf + (size_t)(tok0 + sr) * ZA_W + GW + gi * 128 + c8);
              const unsigned vv[4] = {v.x, v.y, v.z, v.w};
#pragma unroll
              for (int e = 0; e < 4; ++e) { *(LAS unsigned short*)(Vt + (c8 + 2 * e) * 272 + sr * 2) = (unsigned short)(vv[e] & 0xffffu); *(LAS unsigned short*)(Vt + (c8 + 2 * e + 1) * 272 + sr * 2) = (unsigned short)(vv[e] >> 16); } }
            __syncthreads();
            f32x16 acc2[2];
#pragma unroll
            for (int cb = 0; cb < 2; ++cb)
#pragma unroll
              for (int i = 0; i < 16; ++i) acc2[cb][i] = 0.f;
            const int nks = 2 * (tb + 1);
            for (int ks = 0; ks < nks; ++ks) {
              const bf16x8 wf = *(const LAS bf16x8*)(Wl + (32 * tb + r32) * 272 + ks * 32 + hi * 16);
#pragma unroll
              for (int cb = 0; cb < 2; ++cb) {
                const bf16x8 vf = *(const LAS bf16x8*)(Vt + (64 * chh + 32 * cb + r32) * 272 + ks * 32 + hi * 16);
                acc2[cb] = __builtin_amdgcn_mfma_f32_32x32x16_bf16(vf, wf, acc2[cb], 0, 0, 0);
              }
            }
            const int t = 32 * tb + r32; const float bt = bsp[gi * 128 + t];
            const size_t rowoff = (size_t)(tok0 + t);
#pragma unroll
            for (int cb = 0; cb < 2; ++cb)
#pragma unroll
              for (int ig = 0; ig < 4; ++ig) {
                const int c = gi * 128 + 64 * chh + 32 * cb + 8 * ig + 4 * hi;
                const f32x4 gg = *(const f32x4*)(gv + c);
                const u32x2 uu = *(const u32x2*)(zbuf + rowoff * ZA_W + c);
                const float u0 = __uint_as_float(uu.x << 16), u1 = __uint_as_float(uu.x & 0xffff0000u), u2 = __uint_as_float(uu.y << 16), u3 = __uint_as_float(uu.y & 0xffff0000u);
                const float o0 = u0 * (acc2[cb][4 * ig] * gg[0] + bt), o1 = u1 * (acc2[cb][4 * ig + 1] * gg[1] + bt), o2 = u2 * (acc2[cb][4 * ig + 2] * gg[2] + bt), o3 = u3 * (acc2[cb][4 * ig + 3] * gg[3] + bt);
                *(u32x2*)(cat + rowoff * DM + c) = (u32x2){cvt_pk_bf16(o0, o1), cvt_pk_bf16(o2, o3)};
              }
            __syncthreads();
          }
        } else if (!isA && EN(6)) {
          for (int p = 6 * vcu; p < 1536; p += 6 * G)
#pragma unroll 1
            for (int uu = p; uu < p + 6 && uu < 1536; ++uu) {
              const int pp = uu >> 1, half = uu & 1, bh = pp >> 3, i8 = pp & 7, b = bh / 12, h = bh - b * 12;
              const int qblk = half ? i8 : 15 - i8; const size_t row0 = (size_t)b * SEQ + qblk * 256;
              attn_unit<192, true>(lds, qbuf + row0 * QW + h * 192, QW, kn + (size_t)b * SEQ * GW + h * 128, GW, kvb + (size_t)b * SEQ * KVW + 512, KVW,
                                   vT + (size_t)(h * 128) * MTOK + (size_t)b * SEQ, MTOK, (qblk + 1) * 4, qblk * 256, cat + row0 * DM + h * 128, DM);
            }
        }
        if (EN(7)) {
          const bf16_t* qm = zbuf + (isA ? 2 * GW : 512); const int ldq = isA ? ZA_W : ZB_W;
#pragma unroll 1
          for (int uidx = vcu; uidx < NB * 4 * 16; uidx += G) {
            const int qblk = uidx & 15, bh = uidx >> 4, b = bh >> 2, h = bh & 3; const size_t row0 = (size_t)b * SEQ + qblk * 256;
            attn_unit<128, false>(lds, qm + row0 * ldq + h * 128, ldq, memk + (size_t)l * MMEM * 512 + (size_t)b * NMEM * 512 + h * 128, 512, nullptr, 0,
                                  memvt + (size_t)l * 512 * MMEM + (size_t)(h * 128) * MMEM + b * NMEM, MMEM, 4, 0, cat + row0 * DM + GW + h * 128, DM);
          }
        }
        for (size_t i = gtid; i < (size_t)MTOK; i += NGT) rsB[i] = 0.f;
      }
      else if (type == 5 && EN(5)) {
        const float* cw = ap->in[22] + (size_t)l * 3 * DFF2; const float* cb = ap->in[23] + (size_t)l * DFF2;
        for (size_t idx = gtid; idx < (size_t)1024 * (DFF / 4); idx += NGT) {
          const int rowi = (int)(idx / (DFF / 4)), c4 = (int)(idx % (DFF / 4)) * 4, blk = rowi >> 1, rr = rowi & 1;
          const bool hp = (blk & 63) != 0;
          const float* H0 = halo + (size_t)blk * 4 * DFF2; const float* Hp = H0 - (size_t)4 * DFF2;
          f32x4 cv[2];
#pragma unroll
          for (int part = 0; part < 2; ++part) {
            const int off = part * DFF + c4; const f32x4 z4 = (f32x4){0.f, 0.f, 0.f, 0.f};
            const f32x4 a0 = *(const f32x4*)(H0 + (size_t)rr * DFF2 + off);
            const f32x4 p3 = hp ? *(const f32x4*)(Hp + (size_t)3 * DFF2 + off) : z4;
            const f32x4 a1 = rr ? *(const f32x4*)(H0 + off) : p3;
            const f32x4 a2 = rr ? p3 : (hp ? *(const f32x4*)(Hp + (size_t)2 * DFF2 + off) : z4);
            cv[part] = *(const f32x4*)(cw + 2 * DFF2 + off) * a0 + *(const f32x4*)(cw + DFF2 + off) * a1 + *(const f32x4*)(cw + off) * a2 + *(const f32x4*)(cb + off);
          }
          u32x2 w; w.x = cvt_pk_bf16(silu1(cv[0][0]) * cv[1][0], silu1(cv[0][1]) * cv[1][1]); w.y = cvt_pk_bf16(silu1(cv[0][2]) * cv[1][2], silu1(cv[0][3]) * cv[1][3]);
          *(u32x2*)(gbuf + (size_t)(blk * 64 + rr) * DFF + c4) = w;
        }
      }
      if (sync) xcd_barrier(xbar);
    }
  }
  {
    const Args* ap = &a; DERIVE_PTRS(ap)
    DERIVE_IDS
    const float* gf = a.in[5];
    for (size_t i = gtid; i < (size_t)MTOK * (DM / 4); i += NGT) {
      const int row = (int)(i / (DM / 4)), c4 = (int)(i % (DM / 4)) * 4;
      const float r = __builtin_amdgcn_rsqf(rsA[row] * (1.0f / DM) + EPS);
      f32x4* p = (f32x4*)(xo + (size_t)row * DM + c4);
      *p = *p * r * *(const f32x4*)(gf + c4);
    }
  }
}

extern "C" void kernel_launch(void* const* d_in, const int* in_sizes, int n_in, void* d_out, int out_size, void* d_ws, size_t ws_size, hipStream_t stream) {
  static int grid_blocks = 0;
  if (!grid_blocks) {
    int dev = 0, cus = 0, per_cu = 0;
    (void)hipGetDevice(&dev);
    (void)hipDeviceGetAttribute(&cus, hipDeviceAttributeMultiprocessorCount, dev);
    (void)hipFuncSetAttribute((const void*)yoco_fwd, hipFuncAttributeMaxDynamicSharedMemorySize, LDS_BYTES);
    (void)hipOccupancyMaxActiveBlocksPerMultiprocessor(&per_cu, (const void*)yoco_fwd, 512, LDS_BYTES);
    if (per_cu < 1) per_cu = 1;
    grid_blocks = cus * per_cu;
    if (ws_size < WS_END) fprintf(stderr, "kernel_launch: workspace too small: %zu < %zu\n", ws_size, (size_t)WS_END);
  }
  Args a; memset(&a, 0, sizeof(a));
  for (int i = 0; i < 25; ++i) a.in[i] = (const float*)d_in[i];
  a.out = (float*)d_out; a.ws = (unsigned char*)d_ws;
  const float* const* in = a.in;
  bf16_t* wp = (bf16_t*)((unsigned char*)d_ws + WS_W);
  int nd = 0, items = 0;
  auto add = [&](const float* src, const float* scale, int K, int Ns, int Nd, int kind) {
    WDesc& d = a.wd[nd++]; d.src = src; d.scale = scale; d.dst = wp; d.K = K; d.Ns = Ns; d.Nd = Nd; d.kind = kind; d.item0 = items; d.pad = 0;
    items += (K / 64) * (Nd / 32); wp += (size_t)K * Nd;
  };
  for (int l = 0; l < 2; ++l) add(in[6] + (size_t)l * DM * ZA_W, in[3] + (size_t)l * DM, DM, ZA_W, ZA_W, 0);
  for (int j = 0; j < 2; ++j) add(in[13] + (size_t)j * DM * ZB_W, in[3] + (size_t)(2 + j) * DM, DM, ZB_W, ZB_W, 0);
  add(in[11], in[10], DM, 576, KVW, 1);
  for (int j = 0; j < 2; ++j) add(in[16] + (size_t)j * 512 * GW, in[12], 512, GW, GW, 0);
  for (int j = 0; j < 2; ++j) add(in[17] + (size_t)j * 512 * GW, in[12], 512, GW, GW, 0);
  for (int l = 0; l < 4; ++l) add(in[19] + (size_t)l * DM * 1024, in[18] + (size_t)l * DM, DM, 1024, 1024, 0);
  for (int j = 0; j < 2; ++j) add(in[15] + (size_t)j * 512 * QW, in[14] + (size_t)j * 512, 512, QW, QW, 2);
  for (int l = 0; l < 4; ++l) add(in[20] + (size_t)l * DM * DM, nullptr, DM, DM, DM, 0);
  for (int l = 0; l < 4; ++l) add(in[21] + (size_t)l * DM * DFF2, in[4] + (size_t)l * DM, DM, DFF2, DFF2, 3);
  for (int l = 0; l < 4; ++l) add(in[24] + (size_t)l * DFF * DM, nullptr, DFF, DM, DM, 0);
  a.nitems = items;
  void* args[] = {&a};
  hipError_t e = hipLaunchCooperativeKernel((const void*)yoco_fwd, dim3(grid_blocks), dim3(512), args, LDS_BYTES, stream);
  if (e != hipSuccess) fprintf(stderr, "cooperative launch failed: %s (grid %d)\n", hipGetErrorString(e), grid_blocks);
}
```

```cpp
#include <hip/hip_runtime.h>
#include <hip/hip_cooperative_groups.h>
#include <cstdio>
#include <cstring>
namespace cg = cooperative_groups;

#define LAS __attribute__((address_space(3)))
typedef unsigned short bf16_t;
typedef short bf16x8 __attribute__((ext_vector_type(8)));
typedef short s16x4 __attribute__((ext_vector_type(4)));
typedef float f32x4 __attribute__((ext_vector_type(4)));
typedef float f32x2 __attribute__((ext_vector_type(2)));
typedef float f32x16 __attribute__((ext_vector_type(16)));
typedef unsigned u32x4 __attribute__((ext_vector_type(4)));
typedef unsigned u32x2 __attribute__((ext_vector_type(2)));

constexpr int DM = 2048, NB = 8, SEQ = 4096, MTOK = NB * SEQ, NMEM = 256, MMEM = NB * NMEM;
constexpr int GW = 1536, ZA_W = 3584, ZB_W = 1024, QW = 2304, KVW = 768, DFF = 5632, DFF2 = 11264;
constexpr float EPS = 1e-6f;
constexpr float LOG2E = 1.4426950408889634f;
constexpr float SC_MEM = 0.08838834764831845f * LOG2E;
constexpr float SC_MLA = 0.07216878364870323f * LOG2E;

constexpr size_t MiB = 1u << 20;
constexpr size_t WS_RS = 1 * MiB;
constexpr size_t WS_CS = 2 * MiB;
constexpr size_t WS_MEMB = 10 * MiB;
constexpr size_t WS_MEMK = 18 * MiB;
constexpr size_t WS_MEMVT = 26 * MiB;
constexpr size_t WS_W = 34 * MiB;
constexpr size_t WS_XB = 396 * MiB;
constexpr size_t WS_KVB = 524 * MiB;
constexpr size_t WS_KN = 572 * MiB;
constexpr size_t WS_VT = 668 * MiB;
constexpr size_t WS_HALO = 764 * MiB;
constexpr size_t WS_R = 852 * MiB;
constexpr size_t WS_CAT = WS_R + 224 * MiB;
constexpr size_t WS_Q = WS_R + 64 * MiB;
constexpr size_t WS_END = 1204 * MiB;

typedef __bf16 bf16x2_t __attribute__((ext_vector_type(2)));
__device__ __forceinline__ unsigned cvt_pk_bf16(float lo, float hi) { const f32x2 v = {lo, hi}; const bf16x2_t b = __builtin_convertvector(v, bf16x2_t); return __builtin_bit_cast(unsigned, b); }
__device__ __forceinline__ float wave_sum(float v) {
#pragma unroll
  for (int o = 1; o < 64; o <<= 1) v += __shfl_xor(v, o);
  return v;
}
__device__ __forceinline__ f32x2 gelu_pk(f32x2 v) {
  const f32x2 av = __builtin_elementwise_abs(v), d = av * 0.2316418882f + 1.0f;
  f32x2 t; t.x = __builtin_amdgcn_rcpf(d.x); t.y = __builtin_amdgcn_rcpf(d.y);
  f32x2 q = t * 0.5307027145f + (-0.7265760135f); q = q * t + 0.7107068705f; q = q * t + (-0.142248368f); q = q * t + 0.127414796f; q = q * t;
  const f32x2 s = (v * v) * (-0.72134752044f);
  f32x2 e; e.x = __builtin_amdgcn_exp2f(s.x); e.y = __builtin_amdgcn_exp2f(s.y);
  const f32x2 m = v * (q * e), r = v - m;
  f32x2 o; o.x = v.x < 0.f ? m.x : r.x; o.y = v.y < 0.f ? m.y : r.y; return o;
}
__device__ __forceinline__ f32x4 gelu4(f32x4 v) { f32x2 a = gelu_pk((f32x2){v[0], v[1]}), b = gelu_pk((f32x2){v[2], v[3]}); return (f32x4){a.x, a.y, b.x, b.y}; }
__device__ __forceinline__ float silu1(float x) { return x * __builtin_amdgcn_rcpf(1.0f + __builtin_amdgcn_exp2f(-x * LOG2E)); }
__device__ __forceinline__ float ror1(float v) { return __builtin_bit_cast(float, __builtin_amdgcn_update_dpp(0, __builtin_bit_cast(int, v), 0x121, 0xf, 0xf, false)); }
__device__ __forceinline__ float ror2(float v) { return __builtin_bit_cast(float, __builtin_amdgcn_update_dpp(0, __builtin_bit_cast(int, v), 0x122, 0xf, 0xf, false)); }
__device__ __forceinline__ f32x4 ror1v(f32x4 v) { return (f32x4){ror1(v[0]), ror1(v[1]), ror1(v[2]), ror1(v[3])}; }
__device__ __forceinline__ f32x4 ror2v(f32x4 v) { return (f32x4){ror2(v[0]), ror2(v[1]), ror2(v[2]), ror2(v[3])}; }

namespace pg8 {
constexpr int BM = 256, BK = 64, HALF = 128, HTB = HALF * BK * 2, STAGE_BYTES = 8 * HTB, NXCD = 8, WGM = 8;
__device__ __forceinline__ int lds_byte(int r, int c) { const int st = (r >> 4) * 2 + (c >> 5), rr = r & 15, cc = c & 31, ob = rr * 64 + cc * 2; return st * 1024 + (ob ^ (((ob >> 9) & 1) << 5)); }
__device__ __forceinline__ void stage_rc(int b, int& R, int& C) { const int st = b / 1024, sb = b % 1024, swz = sb ^ (((sb >> 9) & 1) << 5); R = (st >> 1) * 16 + swz / 64; C = (st & 1) * 32 + (swz % 64) / 2; }
__device__ __forceinline__ int perm32(int rho) { const int n = rho >> 4, i = rho & 15; return 8 * (i >> 2) + 4 * n + (i & 3); }
struct Unit { int pm, pn; };
struct Gemm { const bf16_t* A; const bf16_t* Bt; int M, N, K, lda, ldb; };
struct StaticOrder {
  int nM, nN, nwg, G, c;
  __device__ void init(int M, int N, int G_, int c_) { nM = M / BM; nN = N / BM; nwg = nM * nN; G = G_; c = c_; }
  __device__ bool next(int i, Unit& u) const {
    const long L = (long)i * G + c; if (L >= nwg) return false;
    int wgid = (int)L; { const int q = nwg / NXCD, r = nwg % NXCD, xcd = wgid % NXCD, off = wgid / NXCD; wgid = (xcd < r ? xcd * (q + 1) : r * (q + 1) + (xcd - r) * q) + off; }
    const int nig = WGM * nN, gid = wgid / nig, fm = gid * WGM, gsz = (nM - fm) < WGM ? (nM - fm) : WGM;
    u.pm = fm + ((wgid % nig) % gsz); u.pn = (wgid % nig) / gsz; return true;
  }
};

template <class Epi>
__device__ __forceinline__ void gemm_phase(LAS unsigned char* lds, const Gemm g, const StaticOrder& S, const Epi& E) {
  int tid_o = threadIdx.x; asm volatile("" : "+v"(tid_o));
  const int tid = tid_o, wid = __builtin_amdgcn_readfirstlane(tid >> 6), lane = tid & 63, wr = wid >> 2, wc = wid & 3, fr = lane & 15, fq = lane >> 4;
  const int K = g.K, nt = K / BK;
  unsigned voffA[2], voffB[2];
#pragma unroll
  for (int i = 0; i < 2; ++i) { int R, C; stage_rc(tid * 16 + i * 8192, R, C); const int Rb = Epi::PERM ? ((R & ~31) + perm32(R & 31)) : R;
    voffA[i] = (unsigned)(R * g.lda + C) * 2u; voffB[i] = (unsigned)(Rb * g.ldb + C) * 2u; }
  const size_t kstep = (size_t)(BK * 2);
  const size_t hstepA = (size_t)HALF * g.lda * 2, hstepB = (size_t)HALF * g.ldb * 2;
  const size_t tstepA = 2 * hstepA, tstepB = 2 * hstepB;
  const unsigned ldsw = (unsigned)wid * 1024u;
  const int aoff = lds_byte(wr * 64 + fr, fq * 8), boff = lds_byte(wc * 32 + fr, fq * 8);
#define PG8_SA(b, h) (((b) * 2 + (h)) * HTB)
#define PG8_SB(b, h) ((4 + (b) * 2 + (h)) * HTB)
#define PG8_STAGE(bufoff, gbase, voff) do { _Pragma("unroll") for (int _i = 0; _i < 2; ++_i) \
    __builtin_amdgcn_global_load_lds((const unsigned*)((const char*)(gbase) + (voff)[_i]), (LAS unsigned*)(lds + (bufoff) + ldsw + _i * 8192), 16, 0, 0); } while (0)
#define PG8_LDA(dst, b, h) do { _Pragma("unroll") for (int m = 0; m < 4; ++m) _Pragma("unroll") for (int k = 0; k < 2; ++k) dst[m][k] = *(const LAS bf16x8*)(lds + PG8_SA(b, h) + aoff + m * 2048 + k * 1024); } while (0)
#define PG8_LDB(dst, b, h) do { _Pragma("unroll") for (int n = 0; n < 2; ++n) _Pragma("unroll") for (int k = 0; k < 2; ++k) dst[n][k] = *(const LAS bf16x8*)(lds + PG8_SB(b, h) + boff + n * 2048 + k * 1024); } while (0)
#define PG8_MMA(ai, bj, At, Bt) do { __builtin_amdgcn_s_setprio(1); _Pragma("unroll") for (int m = 0; m < 4; ++m) _Pragma("unroll") for (int n = 0; n < 2; ++n) _Pragma("unroll") for (int k = 0; k < 2; ++k) \
    acc[ai][bj][m][n] = __builtin_amdgcn_mfma_f32_16x16x32_bf16(Bt[n][k], At[m][k], acc[ai][bj][m][n], 0, 0, 0); __builtin_amdgcn_s_setprio(0); } while (0)
#define PG8_WAIT_V(n) asm volatile("s_waitcnt vmcnt(" #n ")" ::: "memory")
#define PG8_WAIT_L(n) asm volatile("s_waitcnt lgkmcnt(" #n ")" ::: "memory")
#define PG8_BAR __builtin_amdgcn_s_barrier()
#define PG8_SCHED __builtin_amdgcn_sched_barrier(0)
  Unit cur, nxt; int ui = 0;
  if (!S.next(0, cur)) return;
  f32x4 acc[2][2][4][2];
  if constexpr (Epi::INIT) E.init(acc, cur, wr, wc, fr, fq);
  else {
#pragma unroll
  for (int a = 0; a < 2; ++a)
#pragma unroll
    for (int b = 0; b < 2; ++b)
#pragma unroll
      for (int m = 0; m < 4; ++m)
#pragma unroll
        for (int n = 0; n < 2; ++n) acc[a][b][m][n] = (f32x4){0.f, 0.f, 0.f, 0.f};
  }
  bf16x8 At[4][2], B0[2][2], B1[2][2];
  const char* cA = (const char*)g.A + (size_t)cur.pm * tstepA; const char* cB = (const char*)g.Bt + (size_t)cur.pn * tstepB;
  PG8_STAGE(PG8_SB(0, 0), cB, voffB); PG8_STAGE(PG8_SA(0, 0), cA, voffA); PG8_STAGE(PG8_SB(0, 1), cB + hstepB, voffB); PG8_STAGE(PG8_SA(0, 1), cA + hstepA, voffA);
  if (wr == 1) PG8_BAR;
  PG8_WAIT_V(4); PG8_BAR;
  PG8_STAGE(PG8_SB(1, 0), cB + kstep, voffB); PG8_STAGE(PG8_SA(1, 0), cA + kstep, voffA); PG8_STAGE(PG8_SB(1, 1), cB + hstepB + kstep, voffB);
  PG8_WAIT_V(6); PG8_BAR;
  for (;;) {
    const bool has_next = S.next(ui + 1, nxt);
    const char* nA = has_next ? (const char*)g.A + (size_t)nxt.pm * tstepA : cA; const char* nB = has_next ? (const char*)g.Bt + (size_t)nxt.pn * tstepB : cB;
    for (int t = 0; t < nt; t += 2) {
      const bool last = (t == nt - 2);
      const char* a1 = cA + (size_t)(t + 1) * kstep;
      const char* a2 = last ? nA : cA + (size_t)(t + 2) * kstep; const char* b2 = last ? nB : cB + (size_t)(t + 2) * kstep;
      const char* a3 = a2 + kstep; const char* b3 = b2 + kstep;
      PG8_LDB(B0, 0, 0); PG8_SCHED; PG8_LDA(At, 0, 0); PG8_STAGE(PG8_SA(1, 1), a1 + hstepA, voffA);
      PG8_WAIT_L(8); PG8_BAR; PG8_WAIT_L(0); PG8_MMA(0, 0, At, B0); PG8_BAR; PG8_SCHED;
      PG8_LDB(B1, 0, 1); PG8_STAGE(PG8_SB(0, 0), b2, voffB);
      PG8_BAR; PG8_WAIT_L(0); PG8_MMA(0, 1, At, B1); PG8_BAR;
      PG8_LDA(At, 0, 1); PG8_STAGE(PG8_SA(0, 0), a2, voffA);
      PG8_BAR; PG8_WAIT_L(0); PG8_MMA(1, 0, At, B0); PG8_BAR; PG8_SCHED;
      PG8_STAGE(PG8_SB(0, 1), b2 + hstepB, voffB);
      PG8_WAIT_V(6); PG8_BAR; PG8_MMA(1, 1, At, B1); PG8_BAR;
      PG8_LDB(B0, 1, 0); PG8_SCHED; PG8_LDA(At, 1, 0); PG8_STAGE(PG8_SA(0, 1), a2 + hstepA, voffA);
      PG8_WAIT_L(8); PG8_BAR; PG8_WAIT_L(0); PG8_MMA(0, 0, At, B0); PG8_BAR; PG8_SCHED;
      PG8_LDB(B1, 1, 1); PG8_STAGE(PG8_SB(1, 0), b3, voffB);
      PG8_BAR; PG8_WAIT_L(0); PG8_MMA(0, 1, At, B1); PG8_BAR;
      PG8_LDA(At, 1, 1); PG8_STAGE(PG8_SA(1, 0), a3, voffA);
      PG8_BAR; PG8_WAIT_L(0); PG8_MMA(1, 0, At, B0); PG8_BAR; PG8_SCHED;
      PG8_STAGE(PG8_SB(1, 1), b3 + hstepB, voffB);
      PG8_WAIT_V(6); PG8_BAR; PG8_MMA(1, 1, At, B1); PG8_BAR;
    }
    E(acc, cur, wr, wc, fr, fq);
    if (!has_next) break;
    if constexpr (Epi::INIT) E.init(acc, nxt, wr, wc, fr, fq);
    else {
#pragma unroll
    for (int a = 0; a < 2; ++a)
#pragma unroll
      for (int b = 0; b < 2; ++b)
#pragma unroll
        for (int m = 0; m < 4; ++m)
#pragma unroll
          for (int n = 0; n < 2; ++n) acc[a][b][m][n] = (f32x4){0.f, 0.f, 0.f, 0.f};
    }
    cur = nxt; cA = nA; cB = nB; ++ui;
  }
  PG8_WAIT_V(0);
  if (wr == 0) PG8_BAR;
  PG8_BAR;
#undef PG8_SA
#undef PG8_SB
#undef PG8_STAGE
#undef PG8_LDA
#undef PG8_LDB
#undef PG8_MMA
#undef PG8_WAIT_V
#undef PG8_WAIT_L
#undef PG8_BAR
#undef PG8_SCHED
}
}
using pg8::Unit; using pg8::HALF;
typedef f32x4 Acc[2][2][4][2];

struct EpiG {
  static constexpr bool PERM = true, INIT = false;
  bf16_t* O; int ldc;
  const float* rss; float rinvD;
  const float* css; float cinvD;
  int gelu_hi;
  int ss_lo, ss_hi; float* ssacc;
  int rope_mode;
  const f32x2* cs;
  int sc_lo; float sc_val;
  __device__ __forceinline__ void operator()(Acc& acc, const Unit& u, int wr, int wc, int fr, int fq) const {
    const int ct = u.pn * 256;
    const bool do_gelu = ct < gelu_hi, do_ss = (ct >= ss_lo && ct < ss_hi), do_sc = ct >= sc_lo;
    float rsv[2][4];
#pragma unroll
    for (int ai = 0; ai < 2; ++ai)
#pragma unroll
      for (int m = 0; m < 4; ++m) rsv[ai][m] = rss ? rss[u.pm * 256 + ai * HALF + wr * 64 + m * 16 + fr] : 1.0f;
    f32x4 cq[2][2];
#pragma unroll
    for (int bj = 0; bj < 2; ++bj) { const int c0 = ct + bj * HALF + wc * 32 + 8 * fq;
      cq[bj][0] = css ? *(const f32x4*)(css + c0) : (f32x4){1.f, 1.f, 1.f, 1.f}; cq[bj][1] = css ? *(const f32x4*)(css + c0 + 4) : (f32x4){1.f, 1.f, 1.f, 1.f}; }
    if (rss) {
#pragma unroll
      for (int ai = 0; ai < 2; ++ai)
#pragma unroll
        for (int m = 0; m < 4; ++m) rsv[ai][m] = __builtin_amdgcn_rsqf(rsv[ai][m] * rinvD + EPS);
    }
    if (css) {
#pragma unroll
      for (int bj = 0; bj < 2; ++bj)
#pragma unroll
        for (int h = 0; h < 2; ++h)
#pragma unroll
          for (int j = 0; j < 4; ++j) cq[bj][h][j] = __builtin_amdgcn_rsqf(cq[bj][h][j] * cinvD + EPS);
    }
#pragma unroll
    for (int ai = 0; ai < 2; ++ai)
#pragma unroll
      for (int m = 0; m < 4; ++m) {
        const int row = u.pm * 256 + ai * HALF + wr * 64 + m * 16 + fr;
        const float rs = rsv[ai][m];
        float ss = 0.f;
#pragma unroll
        for (int bj = 0; bj < 2; ++bj) {
          const int c0 = ct + bj * HALF + wc * 32 + 8 * fq;
          f32x4 v0 = acc[ai][bj][m][0] * rs, v1 = acc[ai][bj][m][1] * rs;
          if (css) { v0 = v0 * cq[bj][0]; v1 = v1 * cq[bj][1]; }
          if (do_gelu) { v0 = gelu4(v0); v1 = gelu4(v1); }
          if (do_ss) ss += (v0[0] * v0[0] + v0[1] * v0[1]) + (v0[2] * v0[2] + v0[3] * v0[3]) + (v1[0] * v1[0] + v1[1] * v1[1]) + (v1[2] * v1[2] + v1[3] * v1[3]);
          int roff = -1;
          if (rope_mode == 1) { const int d = c0 % 192; if (d >= 128) roff = d - 128; }
          else if (rope_mode == 2) { if (c0 >= 512 && c0 < 576) roff = c0 - 512; }
          if (roff >= 0) {
            const f32x2* t = cs + (size_t)row * 32 + (roff >> 1);
            const f32x2 t0 = t[0], t1 = t[1], t2 = t[2], t3 = t[3];
            f32x4 w0, w1;
            w0[0] = v0[0] * t0.x - v0[1] * t0.y; w0[1] = v0[1] * t0.x + v0[0] * t0.y;
            w0[2] = v0[2] * t1.x - v0[3] * t1.y; w0[3] = v0[3] * t1.x + v0[2] * t1.y;
            w1[0] = v1[0] * t2.x - v1[1] * t2.y; w1[1] = v1[1] * t2.x + v1[0] * t2.y;
            w1[2] = v1[2] * t3.x - v1[3] * t3.y; w1[3] = v1[3] * t3.x + v1[2] * t3.y;
            v0 = w0; v1 = w1;
          }
          if (do_sc) { v0 = v0 * sc_val; v1 = v1 * sc_val; }
          u32x4 w; w.x = cvt_pk_bf16(v0[0], v0[1]); w.y = cvt_pk_bf16(v0[2], v0[3]); w.z = cvt_pk_bf16(v1[0], v1[1]); w.w = cvt_pk_bf16(v1[2], v1[3]);
          *(u32x4*)(O + (size_t)row * ldc + c0) = w;
        }
        if (do_ss) { ss += __shfl_xor(ss, 16); ss += __shfl_xor(ss, 32); if (fq == 0) atomicAdd(ssacc + row, ss); }
      }
  }
};

struct EpiRes {
  static constexpr bool PERM = false, INIT = true;
  const float* xold; float* xnew; bf16_t* xb; float* ssacc;
  __device__ __forceinline__ void init(Acc& acc, const Unit& u, int wr, int wc, int fr, int fq) const {
    const int col0 = u.pn * 256 + wc * 32 + 4 * fq;
#pragma unroll
    for (int ai = 0; ai < 2; ++ai)
#pragma unroll
      for (int bj = 0; bj < 2; ++bj)
#pragma unroll
        for (int m = 0; m < 4; ++m)
#pragma unroll
          for (int n = 0; n < 2; ++n) {
            const int row = u.pm * 256 + ai * HALF + wr * 64 + m * 16 + fr;
            acc[ai][bj][m][n] = *(const f32x4*)(xold + (size_t)row * DM + col0 + bj * HALF + n * 16);
          }
  }
  __device__ __forceinline__ void operator()(Acc& acc, const Unit& u, int wr, int wc, int fr, int fq) const {
    const int col0 = u.pn * 256 + wc * 32 + 4 * fq;
#pragma unroll
    for (int ai = 0; ai < 2; ++ai)
#pragma unroll
      for (int m = 0; m < 4; ++m) {
        const int row = u.pm * 256 + ai * HALF + wr * 64 + m * 16 + fr;
        float ss = 0.f;
#pragma unroll
        for (int bj = 0; bj < 2; ++bj)
#pragma unroll
          for (int n = 0; n < 2; ++n) {
            const size_t off = (size_t)row * DM + col0 + bj * HALF + n * 16;
            const f32x4 v = acc[ai][bj][m][n];
            *(f32x4*)(xnew + off) = v;
            u32x2 w; w.x = cvt_pk_bf16(v[0], v[1]); w.y = cvt_pk_bf16(v[2], v[3]);
            *(u32x2*)(xb + off) = w;
            ss += (v[0] * v[0] + v[1] * v[1]) + (v[2] * v[2] + v[3] * v[3]);
          }
        ss += __shfl_xor(ss, 16); ss += __shfl_xor(ss, 32);
        if (fq == 0) atomicAdd(ssacc + row, ss);
      }
  }
};

struct EpiUp {
  static constexpr bool PERM = true, INIT = false;
  bf16_t* g; float* halo; const float* rss; const float* cw; const float* cb; LAS unsigned char* epl;
  __device__ __forceinline__ void operator()(Acc& acc, const Unit& u, int wr, int wc, int fr, int fq) const {
    const int rowb = u.pm * 256 + wr * 64;
    const int c0 = u.pn * 128 + wc * 32 + 8 * fq;
    float rr[2][4];
#pragma unroll
    for (int ai = 0; ai < 2; ++ai)
#pragma unroll
      for (int m = 0; m < 4; ++m) rr[ai][m] = rss[rowb + ai * HALF + m * 16 + fr];
    LAS unsigned char* wl = epl + (wr * 4 + wc) * 1024;
    { const int lane = fq * 16 + fr, arr = lane >> 3, part = lane & 7, col = u.pn * 128 + wc * 32 + 4 * part;
      const float* sp = ((arr & 3) == 3 ? cb : cw + (size_t)(arr & 3) * DFF2) + (arr >> 2) * DFF + col;
      const f32x4 wv = *(const f32x4*)sp;
      *(LAS f32x4*)(wl + lane * 16) = wv; }
#pragma unroll
    for (int ai = 0; ai < 2; ++ai)
#pragma unroll
      for (int m = 0; m < 4; ++m) {
        const float r = __builtin_amdgcn_rsqf(rr[ai][m] * (1.0f / DM) + EPS);
#pragma unroll
        for (int bj = 0; bj < 2; ++bj)
#pragma unroll
          for (int n = 0; n < 2; ++n) acc[ai][bj][m][n] = acc[ai][bj][m][n] * r;
      }
    asm volatile("s_waitcnt lgkmcnt(0)" ::: "memory");
#pragma unroll
    for (int n = 0; n < 2; ++n) {
      const int cc = c0 + 4 * n;
      const LAS unsigned char* wp = wl + (8 * fq + 4 * n) * 4;
      const f32x4 wg0 = *(const LAS f32x4*)(wp), wg1 = *(const LAS f32x4*)(wp + 128), wg2 = *(const LAS f32x4*)(wp + 256), bg = *(const LAS f32x4*)(wp + 384);
      const f32x4 wv0 = *(const LAS f32x4*)(wp + 512), wv1 = *(const LAS f32x4*)(wp + 640), wv2 = *(const LAS f32x4*)(wp + 768), bv = *(const LAS f32x4*)(wp + 896);
#pragma unroll
      for (int ai = 0; ai < 2; ++ai) {
        f32x4 g1p = (f32x4){0.f, 0.f, 0.f, 0.f}, g2p = g1p, v1p = g1p, v2p = g1p;
#pragma unroll
        for (int m = 0; m < 4; ++m) {
          const f32x4 G = acc[ai][0][m][n], V = acc[ai][1][m][n];
          const f32x4 g1 = ror1v(G), g2 = ror2v(G), v1 = ror1v(V), v2 = ror2v(V);
          const f32x4 pg1 = fr >= 1 ? g1 : g1p, pg2 = fr >= 2 ? g2 : g2p, pv1 = fr >= 1 ? v1 : v1p, pv2 = fr >= 2 ? v2 : v2p;
          const f32x4 cgt = wg2 * G + wg1 * pg1 + wg0 * pg2 + bg;
          const f32x4 cvl = wv2 * V + wv1 * pv1 + wv0 * pv2 + bv;
          g1p = g1; g2p = g2; v1p = v1; v2p = v2;
          const int row = rowb + ai * HALF + m * 16 + fr;
          if (m > 0 || fr >= 2) {
            u32x2 w; w.x = cvt_pk_bf16(silu1(cgt[0]) * cvl[0], silu1(cgt[1]) * cvl[1]); w.y = cvt_pk_bf16(silu1(cgt[2]) * cvl[2], silu1(cgt[3]) * cvl[3]);
            *(u32x2*)(g + (size_t)row * DFF + cc) = w;
          }
          int slot = -1;
          if (m == 0 && fr < 2) slot = fr;
          if (m == 3 && fr >= 14) slot = fr - 12;
          if (slot >= 0) {
            float* hp = halo + ((size_t)(row >> 6) * 4 + slot) * DFF2 + cc;
            *(f32x4*)hp = G; *(f32x4*)(hp + DFF) = V;
          }
        }
      }
    }
  }
};

constexpr int ATT_KBUF = 64 * 400, ATT_VROWB = 136, ATT_VBUF = 128 * ATT_VROWB, ATT_BUF = ATT_KBUF + ATT_VBUF;
template <int DQK, bool CAUSAL>
__device__ __forceinline__ void attn_unit(LAS unsigned char* lds, const bf16_t* Q, int ldq, const bf16_t* K1, int ldk1, const bf16_t* K2, int ldk2,
                                          const bf16_t* VT, int ldv, int ntiles, int q0, bf16_t* O, int ldo) {
  constexpr int KROWB = (DQK + 8) * 2, NKS = DQK / 16, CPR = DQK / 8, NKCH = 64 * CPR / 512;
  int tid_o = threadIdx.x; asm volatile("" : "+v"(tid_o));
  const int tid = tid_o, wid = __builtin_amdgcn_readfirstlane(tid >> 6), lane = tid & 63, r32 = lane & 31, hi = lane >> 5;
  bf16x8 qf[NKS];
  { const bf16_t* qp = Q + (size_t)(wid * 32 + r32) * ldq + hi * 8;
#pragma unroll
    for (int ks = 0; ks < NKS; ++ks) qf[ks] = *(const bf16x8*)(qp + ks * 16); }
  u32x4 kreg[NKCH], vreg[2];
#define ATT_GLOAD(t_) do { const int k0_ = (t_) * 64; \
    _Pragma("unroll") for (int i = 0; i < NKCH; ++i) { const int ch = tid + i * 512, kr = ch / CPR, kc = ch - kr * CPR; \
      const bf16_t* src = (DQK == 128 || kc < 16) ? K1 + (size_t)(k0_ + kr) * ldk1 + kc * 8 : K2 + (size_t)(k0_ + kr) * ldk2 + (kc - 16) * 8; \
      kreg[i] = *(const u32x4*)src; } \
    _Pragma("unroll") for (int i = 0; i < 2; ++i) { const int ch = tid + i * 512, d = ch >> 3, cc = ch & 7; vreg[i] = *(const u32x4*)(VT + (size_t)d * ldv + k0_ + cc * 8); } } while (0)
#define ATT_LWRITE(buf_) do { LAS unsigned char* kb_ = lds + (buf_) * ATT_BUF; \
    _Pragma("unroll") for (int i = 0; i < NKCH; ++i) { const int ch = tid + i * 512, kr = ch / CPR, kc = ch - kr * CPR; *(LAS u32x4*)(kb_ + kr * KROWB + kc * 16) = kreg[i]; } \
    _Pragma("unroll") for (int i = 0; i < 2; ++i) { const int ch = tid + i * 512, d = ch >> 3, cc = ch & 7; LAS unsigned char* p = kb_ + ATT_KBUF + d * ATT_VROWB + cc * 16; \
      *(LAS u32x2*)p = (u32x2){vreg[i].x, vreg[i].y}; *(LAS u32x2*)(p + 8) = (u32x2){vreg[i].z, vreg[i].w}; } } while (0)
  f32x16 o[4];
#pragma unroll
  for (int d = 0; d < 4; ++d)
#pragma unroll
    for (int i = 0; i < 16; ++i) o[d][i] = 0.f;
  float mrow = 0.f, lsum = 0.f;
  const int qabs = q0 + wid * 32 + r32, qlo = q0 + wid * 32;
  ATT_GLOAD(0); ATT_LWRITE(0); __syncthreads();
  for (int t = 0; t < ntiles; ++t) {
    const int buf = t & 1;
    if (t + 1 < ntiles) ATT_GLOAD(t + 1);
    const int k0 = t * 64;
    if (!CAUSAL || k0 <= qlo + 31) {
      const LAS unsigned char* kb = lds + buf * ATT_BUF;
      const bool first = (t == 0);
      const float nm = first ? 0.f : -mrow;
      f32x16 s0, s1;
#pragma unroll
      for (int i = 0; i < 16; ++i) { s0[i] = nm; s1[i] = nm; }
#pragma unroll
      for (int ks = 0; ks < NKS; ++ks) {
        const bf16x8 ka = *(const LAS bf16x8*)(kb + r32 * KROWB + ks * 32 + hi * 16);
        const bf16x8 kc = *(const LAS bf16x8*)(kb + (32 + r32) * KROWB + ks * 32 + hi * 16);
        s0 = __builtin_amdgcn_mfma_f32_32x32x16_bf16(ka, qf[ks], s0, 0, 0, 0);
        s1 = __builtin_amdgcn_mfma_f32_32x32x16_bf16(kc, qf[ks], s1, 0, 0, 0);
      }
      if (CAUSAL && k0 + 63 > qlo) {
#pragma unroll
        for (int i = 0; i < 16; ++i) { const int kv = k0 + (i & 3) + 8 * (i >> 2) + 4 * hi;
          if (kv > qabs) s0[i] = -INFINITY; if (kv + 32 > qabs) s1[i] = -INFINITY; }
      }
      float mx = s0[0];
#pragma unroll
      for (int i = 1; i < 16; ++i) mx = fmaxf(mx, s0[i]);
#pragma unroll
      for (int i = 0; i < 16; ++i) mx = fmaxf(mx, s1[i]);
      mx = fmaxf(mx, __shfl_xor(mx, 32));
      const bool need = first || (mx > 8.0f);
      if (__ballot(need) != 0ull) {
        const float d = need ? mx : 0.f;
        const float alpha = first ? 0.f : __builtin_amdgcn_exp2f(-d);
        mrow = first ? mx : mrow + d;
        lsum *= alpha;
#pragma unroll
        for (int dd = 0; dd < 4; ++dd)
#pragma unroll
          for (int i = 0; i < 16; ++i) o[dd][i] *= alpha;
#pragma unroll
        for (int i = 0; i < 16; ++i) { s0[i] -= d; s1[i] -= d; }
      }
      float ps = 0.f;
#pragma unroll
      for (int i = 0; i < 16; ++i) { s0[i] = __builtin_amdgcn_exp2f(s0[i]); s1[i] = __builtin_amdgcn_exp2f(s1[i]); ps += s0[i] + s1[i]; }
      lsum += ps;
      bf16x8 pa[4];
#pragma unroll
      for (int s = 0; s < 4; ++s) {
        u32x4 w;
        if (s < 2) { w.x = cvt_pk_bf16(s0[8 * s + 0], s0[8 * s + 1]); w.y = cvt_pk_bf16(s0[8 * s + 2], s0[8 * s + 3]); w.z = cvt_pk_bf16(s0[8 * s + 4], s0[8 * s + 5]); w.w = cvt_pk_bf16(s0[8 * s + 6], s0[8 * s + 7]); }
        else { const int b = 8 * (s - 2); w.x = cvt_pk_bf16(s1[b + 0], s1[b + 1]); w.y = cvt_pk_bf16(s1[b + 2], s1[b + 3]); w.z = cvt_pk_bf16(s1[b + 4], s1[b + 5]); w.w = cvt_pk_bf16(s1[b + 6], s1[b + 7]); }
        pa[s] = __builtin_bit_cast(bf16x8, w);
      }
      const LAS unsigned char* vb = kb + ATT_KBUF;
#pragma unroll
      for (int d = 0; d < 4; ++d)
#pragma unroll
        for (int s = 0; s < 4; ++s) {
          const LAS unsigned char* p = vb + (32 * d + r32) * ATT_VROWB + (16 * s + 4 * hi) * 2;
          const u32x2 lo = *(const LAS u32x2*)p, hh = *(const LAS u32x2*)(p + 16);
          const bf16x8 vf = __builtin_bit_cast(bf16x8, (u32x4){lo.x, lo.y, hh.x, hh.y});
          o[d] = __builtin_amdgcn_mfma_f32_32x32x16_bf16(vf, pa[s], o[d], 0, 0, 0);
        }
    }
    if (t + 1 < ntiles) ATT_LWRITE(buf ^ 1);
    __syncthreads();
  }
#undef ATT_GLOAD
#undef ATT_LWRITE
  const float inv = 1.0f / (lsum + __shfl_xor(lsum, 32));
  bf16_t* op = O + (size_t)(wid * 32 + r32) * ldo + 4 * hi;
#pragma unroll
  for (int d = 0; d < 4; ++d)
#pragma unroll
    for (int ig = 0; ig < 4; ++ig) {
      u32x2 w; w.x = cvt_pk_bf16(o[d][4 * ig] * inv, o[d][4 * ig + 1] * inv); w.y = cvt_pk_bf16(o[d][4 * ig + 2] * inv, o[d][4 * ig + 3] * inv);
      *(u32x2*)(op + 32 * d + 8 * ig) = w;
    }
}


#define XB_TMO      128
#define XB_XCNT(j)  (256  + 64 * (j))
#define XB_XSUB(j)  (1280 + 64 * (j))
#define XB_XGEN(j)  (2304 + 64 * (j))
#define XB_TOP      3328
#define XB_TOPGEN   3392
#define XCD_BAR_WORDS 3456
#define XB_SPIN_CAP (1u << 18)
__device__ __forceinline__ unsigned xb_ld(unsigned* p)              { return __hip_atomic_load(p, __ATOMIC_RELAXED, __HIP_MEMORY_SCOPE_AGENT); }
__device__ __forceinline__ unsigned xb_add(unsigned* p, unsigned v) { return __hip_atomic_fetch_add(p, v, __ATOMIC_RELAXED, __HIP_MEMORY_SCOPE_AGENT); }
__device__ __forceinline__ unsigned xb_xcc_id() { return (unsigned)__builtin_amdgcn_s_getreg((3 << 11) | 20) & 0xFu; }
#define XB_SPIN(cond, bar) do { unsigned _sp = 0; while (cond) { __builtin_amdgcn_s_sleep(1); \
    if ((++_sp & 255u) == 0u) { if (xb_ld(&(bar)[XB_TMO])) break; if (_sp > XB_SPIN_CAP) { atomicAdd(&(bar)[XB_TMO], 1u); break; } } } } while (0)
struct XcdBarrier { unsigned* bar; unsigned x; volatile LAS unsigned* st; };
__device__ __forceinline__ XcdBarrier xcd_barrier_post(unsigned* bar, volatile LAS unsigned* st) {
  XcdBarrier b; b.bar = bar; b.x = xb_xcc_id(); b.st = st;
  if (threadIdx.x == 0) (void)xb_add(&bar[XB_XCNT(b.x)], 1u);
  return b;
}
__device__ __forceinline__ void xcd_barrier_complete(unsigned* bar, unsigned x, unsigned& nloc, unsigned& nx) {
  const unsigned G = gridDim.x * gridDim.y * gridDim.z;
  unsigned sum, cnt, mine, sp = 0u;
  for (;;) {
    sum = 0u; cnt = 0u; mine = 0u;
#pragma unroll
    for (unsigned j = 0; j < 16; ++j) { const unsigned c = xb_ld(&bar[XB_XCNT(j)]); sum += c; cnt += (c > 0u) ? 1u : 0u; mine = (j == x) ? c : mine; }
    if (sum == G) break;
    __builtin_amdgcn_s_sleep(1);
    if ((++sp & 255u) == 0u) { if (xb_ld(&bar[XB_TMO])) break; if (sp > XB_SPIN_CAP) { atomicAdd(&bar[XB_TMO], 1u); break; } }
  }
  nloc = mine > 0u ? mine : 1u; nx = cnt > 0u ? cnt : 1u;
}
__device__ __forceinline__ void xcd_barrier(const XcdBarrier& b) {
  asm volatile("s_waitcnt vmcnt(0)" ::: "memory");
  __syncthreads();
  if (threadIdx.x == 0) {
    unsigned* bar = b.bar;
    __builtin_amdgcn_s_waitcnt(0);
    unsigned nloc = b.st[0], nx = b.st[1];
    if (nloc == 0u) { xcd_barrier_complete(bar, b.x, nloc, nx); b.st[0] = nloc; b.st[1] = nx; }
    const unsigned old = xb_add(&bar[XB_XSUB(b.x)], 1u);
    const unsigned gen = old / nloc;
    if (old + 1u == (gen + 1u) * nloc) {
      __builtin_amdgcn_fence(__ATOMIC_RELEASE, "agent");
      asm volatile("s_waitcnt vmcnt(0)" ::: "memory");
      const unsigned og = xb_add(&bar[XB_TOP], 1u);
      const unsigned tg = og / nx;
      if (og + 1u == (tg + 1u) * nx) xb_add(&bar[XB_TOPGEN], 1u);
      else XB_SPIN(xb_ld(&bar[XB_TOPGEN]) == tg, bar);
      __builtin_amdgcn_fence(__ATOMIC_ACQUIRE, "agent");
      xb_add(&bar[XB_XGEN(b.x)], 1u);
      asm volatile("s_waitcnt vmcnt(0)" ::: "memory");
    } else {
      XB_SPIN(xb_ld(&bar[XB_XGEN(b.x)]) == gen, bar);
      __builtin_amdgcn_fence(__ATOMIC_ACQUIRE, "agent");
      asm volatile("s_waitcnt vmcnt(0)" ::: "memory");
    }
  }
  __syncthreads();
}

constexpr int NWD = 27;
struct WDesc { const float* src; const float* scale; bf16_t* dst; int K, Ns, Nd, kind, item0, pad; };
struct Args { const float* in[25]; float* out; unsigned char* ws; WDesc wd[NWD]; int nitems; int pad; };

__device__ __forceinline__ int srccol(int kind, int n) {
  if (kind == 0) return n;
  if (kind == 1) { if (n < 512) return n; if (n < 576) { const int r = n - 512; return 512 + ((r & 1) ? 32 : 0) + (r >> 1); } return -1; }
  if (kind == 2) { const int h = n / 192, d = n - h * 192; if (d < 128) return n; const int r = d - 128; return h * 192 + 128 + ((r & 1) ? 32 : 0) + (r >> 1); }
  { const int t = n >> 8, w = n & 255; return (w >> 7) * DFF + 128 * t + (w & 127); }
}

constexpr int LDS_BYTES = 140 * 1024;
#ifndef ONLY
#define ONLY 0
#endif
#define EN(k) (ONLY == 0 || ONLY == (k))
typedef __attribute__((address_space(4))) const Args CArgs;
#define DERIVE_PTRS(ap) \
  unsigned char* ws = (ap)->ws; \
  float* rsA = (float*)(ws + WS_RS); float* rsB = rsA + MTOK; float* rsV = rsB + MTOK; float* rsQ = rsV + MTOK; float* rsKV = rsQ + MTOK; float* rsM = rsKV + MTOK; \
  f32x2* cs = (f32x2*)(ws + WS_CS); \
  bf16_t* memb = (bf16_t*)(ws + WS_MEMB); bf16_t* memk = (bf16_t*)(ws + WS_MEMK); bf16_t* memvt = (bf16_t*)(ws + WS_MEMVT); \
  bf16_t* xb = (bf16_t*)(ws + WS_XB); bf16_t* kvb = (bf16_t*)(ws + WS_KVB); bf16_t* kn = (bf16_t*)(ws + WS_KN); bf16_t* vT = (bf16_t*)(ws + WS_VT); \
  float* halo = (float*)(ws + WS_HALO); \
  bf16_t* gbuf = (bf16_t*)(ws + WS_R); bf16_t* zbuf = (bf16_t*)(ws + WS_R); bf16_t* cat = (bf16_t*)(ws + WS_CAT); bf16_t* qbuf = (bf16_t*)(ws + WS_Q); \
  const float* x_in = (ap)->in[0]; float* xo = (ap)->out; \
  (void)rsA; (void)rsB; (void)rsV; (void)rsQ; (void)rsKV; (void)rsM; (void)cs; (void)memb; (void)memk; (void)memvt; (void)xb; (void)kvb; (void)kn; (void)vT; (void)halo; (void)gbuf; (void)zbuf; (void)cat; (void)qbuf; (void)x_in; (void)xo;
__global__ void __launch_bounds__(512, 2) yoco_fwd(Args a) {
  extern __shared__ __attribute__((aligned(16))) unsigned char lds_raw[];
  LAS unsigned char* lds = (LAS unsigned char*)lds_raw;
  cg::grid_group grid = cg::this_grid();
  volatile LAS unsigned* xst = (volatile LAS unsigned*)(lds + 131072 + 64);
  if (threadIdx.x < 4) xst[threadIdx.x] = 0u;
  __syncthreads();
#define DERIVE_IDS \
  int tid_o = threadIdx.x; asm volatile("" : "+v"(tid_o)); \
  const int tid = tid_o, lane = tid & 63, wave = __builtin_amdgcn_readfirstlane(tid >> 6); \
  const int G = gridDim.x, bx = blockIdx.x; \
  const int vcu = (G % 8 == 0) ? (bx % 8) * (G / 8) + bx / 8 : bx; \
  const int gw = vcu * 8 + wave, NGW = G * 8; \
  const size_t gtid = (size_t)bx * 512 + tid, NGT = (size_t)G * 512; \
  (void)lane; (void)wave; (void)vcu; (void)gw; (void)NGW; (void)gtid; (void)NGT;
  {
    const Args* ap = &a; DERIVE_PTRS(ap)
    DERIVE_IDS
    LAS float* scr = (LAS float*)(lds + wave * 8448);
    for (int it = gw; it < a.nitems; it += NGW) {
      int di = 0;
#pragma unroll 1
      for (int j = 1; j < NWD; ++j) if (it >= a.wd[j].item0) di = j;
      const float* src = a.wd[di].src; const float* scale = a.wd[di].scale; bf16_t* dst = a.wd[di].dst;
      const int K = a.wd[di].K, Ns = a.wd[di].Ns, Nd = a.wd[di].Nd, kind = a.wd[di].kind, item = it - a.wd[di].item0;
      const int nblk = Nd / 32, kb = item / nblk, nb = item - kb * nblk, k0 = 64 * kb, n0 = 32 * nb;
      const int sc = srccol(kind, n0 + (lane & 31));
      float wv[32];
      { const float* sp = src + (size_t)(k0 + (lane >> 5)) * Ns + (sc >= 0 ? sc : 0);
#pragma unroll
        for (int i = 0; i < 32; ++i) wv[i] = sp[(size_t)(2 * i) * Ns]; }
      if (scale) {
#pragma unroll
        for (int i = 0; i < 32; ++i) wv[i] *= scale[k0 + 2 * i + (lane >> 5)];
      }
#pragma unroll
      for (int i = 0; i < 32; ++i) scr[(2 * i + (lane >> 5)) * 33 + (lane & 31)] = (sc >= 0) ? wv[i] : 0.f;
      asm volatile("s_waitcnt lgkmcnt(0)" ::: "memory");
      const int c = lane & 7;
#pragma unroll
      for (int j = 0; j < 4; ++j) { const int n = (lane >> 3) + 8 * j; const LAS float* s = scr + (8 * c) * 33 + n;
        u32x4 o; o.x = cvt_pk_bf16(s[0 * 33], s[1 * 33]); o.y = cvt_pk_bf16(s[2 * 33], s[3 * 33]); o.z = cvt_pk_bf16(s[4 * 33], s[5 * 33]); o.w = cvt_pk_bf16(s[6 * 33], s[7 * 33]);
        *(u32x4*)(dst + (size_t)(n0 + n) * K + k0 + 8 * c) = o; }
      asm volatile("s_waitcnt lgkmcnt(0)" ::: "memory");
    }
    for (int r = gw; r < MTOK + MMEM; r += NGW) {
      const bool ism = r >= MTOK; const int rr = ism ? r - MTOK : r;
      const f32x4* xr = (const f32x4*)((ism ? a.in[1] : x_in) + (size_t)rr * DM) + lane;
      u32x2* o8 = (u32x2*)((ism ? memb : xb) + (size_t)rr * DM) + lane;
      float s = 0.f;
#pragma unroll
      for (int j = 0; j < 8; ++j) { const f32x4 v = xr[64 * j]; s += (v[0] * v[0] + v[1] * v[1]) + (v[2] * v[2] + v[3] * v[3]); u32x2 w; w.x = cvt_pk_bf16(v[0], v[1]); w.y = cvt_pk_bf16(v[2], v[3]); o8[64 * j] = w; }
      s = wave_sum(s);
      if (lane == 0) (ism ? rsM : rsA)[rr] = s;
    }
    const int* pos = (const int*)a.in[2];
    for (size_t i = gtid; i < (size_t)MTOK * 32; i += NGT) {
      const int row = (int)(i >> 5), j = (int)(i & 31);
      const float inv = 1.0f / powf(10000.0f, (float)(2 * j) / 64.0f);
      const float ang = (float)pos[row] * inv;
      const double rev = (double)ang * 0.15915494309189535;
      const float fr = (float)(rev - floor(rev));
      cs[i] = (f32x2){__builtin_amdgcn_cosf(fr), __builtin_amdgcn_sinf(fr)};
    }
    for (size_t i = gtid; i < (size_t)MTOK * 4; i += NGT) rsB[i] = 0.f;
    if (bx == 0) for (int i = tid; i < XCD_BAR_WORDS; i += 512) ((unsigned*)ws)[i] = 0u;
  }
  grid.sync();
  const XcdBarrier xbar = xcd_barrier_post((unsigned*)a.ws, xst);

  pg8::StaticOrder S;
#pragma unroll 1
  for (int l = -1; l < 4; ++l) {
    const bool isA = l < 2; const int j = l - 2;
#pragma unroll 1
    for (int s = 0; s < 10; ++s) {
      CArgs* ap = (CArgs*)__builtin_amdgcn_kernarg_segment_ptr(); asm volatile("" : "+s"(ap));
      DERIVE_PTRS(ap)
      DERIVE_IDS
      int type = 0; bool sync = false;
      pg8::Gemm g{nullptr, nullptr, 0, 0, 0, 0, 0}; int corder = bx;
      EpiG eg{nullptr, 0, nullptr, 0.f, nullptr, 0.f, 0, 0, 0, nullptr, 0, nullptr, 1 << 30, 1.f};
      EpiRes er{nullptr, nullptr, xb, nullptr};
      if (l < 0) {
        if (s < 8) {
          const int ml = s >> 1; const bf16_t* wt = ap->wd[9 + ml].dst;
          type = 1; corder = (bx + 16 * s) % G; sync = (s == 7);
          if (!(s & 1)) { g = pg8::Gemm{memb, wt, MMEM, 512, DM, DM, DM}; eg.O = memk + (size_t)ml * MMEM * 512; eg.ldc = 512; eg.rss = rsM; eg.rinvD = 1.0f / DM; }
          else { g = pg8::Gemm{wt + (size_t)512 * DM, memb, 512, MMEM, DM, DM, DM}; eg.O = memvt + (size_t)ml * 512 * MMEM; eg.ldc = MMEM; eg.css = rsM; eg.cinvD = 1.0f / DM; }
        }
      } else {
        switch (s) {
          case 0: if (l == 2) { type = 1; sync = true;
              g = pg8::Gemm{xb, ap->wd[4].dst, MTOK, KVW, DM, DM, DM};
              eg.O = kvb; eg.ldc = KVW; eg.rss = rsA; eg.rinvD = 1.0f / DM; eg.ss_lo = 0; eg.ss_hi = 512; eg.ssacc = rsKV; eg.rope_mode = 2; eg.cs = cs; } break;
          case 1: type = 1; eg.O = zbuf; eg.rss = rsA; eg.rinvD = 1.0f / DM; eg.sc_val = SC_MEM;
            if (isA) { sync = true; g = pg8::Gemm{xb, ap->wd[l].dst, MTOK, ZA_W, DM, DM, DM}; eg.ldc = ZA_W; eg.gelu_hi = 2 * GW; eg.ss_lo = GW; eg.ss_hi = 2 * GW; eg.ssacc = rsV; eg.sc_lo = 2 * GW; }
            else { g = pg8::Gemm{xb, ap->wd[2 + j].dst, MTOK, ZB_W, DM, DM, DM}; eg.ldc = ZB_W; eg.ss_lo = 0; eg.ss_hi = 512; eg.ssacc = rsQ; eg.sc_lo = 512; }
            break;
          case 2: if (!isA) { type = 1; g = pg8::Gemm{kvb, ap->wd[5 + j].dst, MTOK, GW, 512, KVW, 512}; eg.O = kn; eg.ldc = GW; eg.rss = rsKV; eg.rinvD = 1.0f / 512; } break;
          case 3: if (!isA) { type = 1; sync = true; g = pg8::Gemm{ap->wd[7 + j].dst, kvb, GW, MTOK, 512, 512, KVW}; eg.O = vT; eg.ldc = MTOK; eg.css = rsKV; eg.cinvD = 1.0f / 512; } break;
          case 4: if (!isA) { type = 1; sync = true; g = pg8::Gemm{zbuf, ap->wd[13 + j].dst, MTOK, QW, 512, ZB_W, 512};
              eg.O = qbuf; eg.ldc = QW; eg.rss = rsQ; eg.rinvD = 1.0f / 512; eg.rope_mode = 1; eg.cs = cs; eg.sc_lo = 0; eg.sc_val = SC_MLA; } break;
          case 5: type = 4; sync = true; break;
          case 6: type = 2; sync = true; g = pg8::Gemm{cat, ap->wd[15 + l].dst, MTOK, DM, DM, DM, DM}; er.xold = (l == 0) ? x_in : xo; er.xnew = xo; er.ssacc = rsB; break;
          case 7: type = 3; sync = true; g = pg8::Gemm{xb, ap->wd[19 + l].dst, MTOK, DFF2, DM, DM, DM}; break;
          case 8: type = 5; sync = true; break;
          case 9: type = 2; sync = true; g = pg8::Gemm{gbuf, ap->wd[23 + l].dst, MTOK, DM, DFF, DFF, DFF}; er.xold = xo; er.xnew = xo; er.ssacc = rsA; break;
        }
      }
      if (type == 1 && EN(1)) { S.init(g.M, g.N, G, corder); pg8::gemm_phase<EpiG>(lds, g, S, eg); }
      else if (type == 2 && EN(2)) {
        S.init(g.M, g.N, G, corder); pg8::gemm_phase<EpiRes>(lds, g, S, er);
        if (s == 6) for (size_t i = gtid; i < (size_t)MTOK; i += NGT) { rsA[i] = 0.f; rsV[i] = 0.f; rsQ[i] = 0.f; }
      }
      else if (type == 3 && EN(3)) {
        S.init(g.M, g.N, G, corder);
        EpiUp E{gbuf, halo, rsB, ap->in[22] + (size_t)l * 3 * DFF2, ap->in[23] + (size_t)l * DFF2, lds + 131072 + 1024};
        pg8::gemm_phase<EpiUp>(lds, g, S, E);
      }
      else if (type == 4 && (EN(4) || EN(6) || EN(7))) {
        if (isA && EN(4)) {
          const float* wsp = ap->in[8] + (size_t)l * 12 * 128 * 128; const float* bsp = ap->in[9] + (size_t)l * 12 * 128; const float* gv = ap->in[7] + (size_t)l * GW;
          LAS unsigned char* Wl = lds; LAS unsigned char* Vt = lds + 128 * 272;
          const int r32 = lane & 31, hi = lane >> 5, tb = wave & 3, chh = wave >> 2;
          for (int uidx = vcu; uidx < NB * 32 * 12; uidx += G) {
            const int gi = uidx % 12, bn = uidx / 12, tok0 = bn * 128;
#pragma unroll
            for (int i = 0; i < 8; ++i) { const int idx = tid + i * 512, t = idx >> 5, s4 = (idx & 31) * 4;
              f32x4 w = *(const f32x4*)(wsp + ((size_t)gi * 128 + t) * 128 + s4);
              const f32x4 q = *(const f32x4*)(rsV + tok0 + s4);
#pragma unroll
              for (int e = 0; e < 4; ++e) w[e] = (s4 + e <= t) ? w[e] * __builtin_amdgcn_rsqf(q[e] * (1.0f / GW) + EPS) : 0.f;
              *(LAS u32x2*)(Wl + t * 272 + s4 * 2) = (u32x2){cvt_pk_bf16(w[0], w[1]), cvt_pk_bf16(w[2], w[3])}; }
#pragma unroll
            for (int i = 0; i < 4; ++i) { const int idx = tid + i * 512, sr = idx >> 4, c8 = (idx & 15) * 8;
              const u32x4 v = *(const u32x4*)(zbuf + (size_t)(tok0 + sr) * ZA_W + GW + gi * 128 + c8);
              const unsigned vv[4] = {v.x, v.y, v.z, v.w};
#pragma unroll
              for (int e = 0; e < 4; ++e) { *(LAS unsigned short*)(Vt + (c8 + 2 * e) * 272 + sr * 2) = (unsigned short)(vv[e] & 0xffffu); *(LAS unsigned short*)(Vt + (c8 + 2 * e + 1) * 272 + sr * 2) = (unsigned short)(vv[e] >> 16); } }
            __syncthreads();
            f32x16 acc2[2];
#pragma unroll
            for (int cb = 0; cb < 2; ++cb)
#pragma unroll
              for (int i = 0; i < 16; ++i) acc2[cb][i] = 0.f;
            const int nks = 2 * (tb + 1);
            for (int ks = 0; ks < nks; ++ks) {
              const bf16x8 wf = *(const LAS bf16x8*)(Wl + (32 * tb + r32) * 272 + ks * 32 + hi * 16);
#pragma unroll
              for (int cb = 0; cb < 2; ++cb) {
                const bf16x8 vf = *(const LAS bf16x8*)(Vt + (64 * chh + 32 * cb + r32) * 272 + ks * 32 + hi * 16);
                acc2[cb] = __builtin_amdgcn_mfma_f32_32x32x16_bf16(vf, wf, acc2[cb], 0, 0, 0);
              }
            }
            const int t = 32 * tb + r32; const float bt = bsp[gi * 128 + t];
            const size_t rowoff = (size_t)(tok0 + t);
#pragma unroll
            for (int cb = 0; cb < 2; ++cb)
#pragma unroll
              for (int ig = 0; ig < 4; ++ig) {
                const int c = gi * 128 + 64 * chh + 32 * cb + 8 * ig + 4 * hi;
                const f32x4 gg = *(const f32x4*)(gv + c);
                const u32x2 uu = *(const u32x2*)(zbuf + rowoff * ZA_W + c);
                const float u0 = __uint_as_float(uu.x << 16), u1 = __uint_as_float(uu.x & 0xffff0000u), u2 = __uint_as_float(uu.y << 16), u3 = __uint_as_float(uu.y & 0xffff0000u);
                const float o0 = u0 * (acc2[cb][4 * ig] * gg[0] + bt), o1 = u1 * (acc2[cb][4 * ig + 1] * gg[1] + bt), o2 = u2 * (acc2[cb][4 * ig + 2] * gg[2] + bt), o3 = u3 * (acc2[cb][4 * ig + 3] * gg[3] + bt);
                *(u32x2*)(cat + rowoff * DM + c) = (u32x2){cvt_pk_bf16(o0, o1), cvt_pk_bf16(o2, o3)};
              }
            __syncthreads();
          }
        } else if (!isA && EN(6)) {
          for (int p = 6 * vcu; p < 1536; p += 6 * G)
#pragma unroll 1
            for (int uu = p; uu < p + 6 && uu < 1536; ++uu) {
              const int pp = uu >> 1, half = uu & 1, bh = pp >> 3, i8 = pp & 7, b = bh / 12, h = bh - b * 12;
              const int qblk = half ? i8 : 15 - i8; const size_t row0 = (size_t)b * SEQ + qblk * 256;
              attn_unit<192, true>(lds, qbuf + row0 * QW + h * 192, QW, kn + (size_t)b * SEQ * GW + h * 128, GW, kvb + (size_t)b * SEQ * KVW + 512, KVW,
                                   vT + (size_t)(h * 128) * MTOK + (size_t)b * SEQ, MTOK, (qblk + 1) * 4, qblk * 256, cat + row0 * DM + h * 128, DM);
            }
        }
        if (EN(7)) {
          const bf16_t* qm = zbuf + (isA ? 2 * GW : 512); const int ldq = isA ? ZA_W : ZB_W;
#pragma unroll 1
          for (int uidx = vcu; uidx < NB * 4 * 16; uidx += G) {
            const int qblk = uidx & 15, bh = uidx >> 4, b = bh >> 2, h = bh & 3; const size_t row0 = (size_t)b * SEQ + qblk * 256;
            attn_unit<128, false>(lds, qm + row0 * ldq + h * 128, ldq, memk + (size_t)l * MMEM * 512 + (size_t)b * NMEM * 512 + h * 128, 512, nullptr, 0,
                                  memvt + (size_t)l * 512 * MMEM + (size_t)(h * 128) * MMEM + b * NMEM, MMEM, 4, 0, cat + row0 * DM + GW + h * 128, DM);
          }
        }
        for (size_t i = gtid; i < (size_t)MTOK; i += NGT) rsB[i] = 0.f;
      }
      else if (type == 5 && EN(5)) {
        const float* cw = ap->in[22] + (size_t)l * 3 * DFF2; const float* cb = ap->in[23] + (size_t)l * DFF2;
        for (size_t idx = gtid; idx < (size_t)1024 * (DFF / 4); idx += NGT) {
          const int rowi = (int)(idx / (DFF / 4)), c4 = (int)(idx % (DFF / 4)) * 4, blk = rowi >> 1, rr = rowi & 1;
          const bool hp = (blk & 63) != 0;
          const float* H0 = halo + (size_t)blk * 4 * DFF2; const float* Hp = H0 - (size_t)4 * DFF2;
          f32x4 cv[2];
#pragma unroll
          for (int part = 0; part < 2; ++part) {
            const int off = part * DFF + c4; const f32x4 z4 = (f32x4){0.f, 0.f, 0.f, 0.f};
            const f32x4 a0 = *(const f32x4*)(H0 + (size_t)rr * DFF2 + off);
            const f32x4 p3 = hp ? *(const f32x4*)(Hp + (size_t)3 * DFF2 + off) : z4;
            const f32x4 a1 = rr ? *(const f32x4*)(H0 + off) : p3;
            const f32x4 a2 = rr ? p3 : (hp ? *(const f32x4*)(Hp + (size_t)2 * DFF2 + off) : z4);
            cv[part] = *(const f32x4*)(cw + 2 * DFF2 + off) * a0 + *(const f32x4*)(cw + DFF2 + off) * a1 + *(const f32x4*)(cw + off) * a2 + *(const f32x4*)(cb + off);
          }
          u32x2 w; w.x = cvt_pk_bf16(silu1(cv[0][0]) * cv[1][0], silu1(cv[0][1]) * cv[1][1]); w.y = cvt_pk_bf16(silu1(cv[0][2]) * cv[1][2], silu1(cv[0][3]) * cv[1][3]);
          *(u32x2*)(gbuf + (size_t)(blk * 64 + rr) * DFF + c4) = w;
        }
      }
      if (sync) xcd_barrier(xbar);
    }
  }
  {
    const Args* ap = &a; DERIVE_PTRS(ap)
    DERIVE_IDS
    const float* gf = a.in[5];
    for (size_t i = gtid; i < (size_t)MTOK * (DM / 4); i += NGT) {
      const int row = (int)(i / (DM / 4)), c4 = (int)(i % (DM / 4)) * 4;
      const float r = __builtin_amdgcn_rsqf(rsA[row] * (1.0f / DM) + EPS);
      f32x4* p = (f32x4*)(xo + (size_t)row * DM + c4);
      *p = *p * r * *(const f32x4*)(gf + c4);
    }
  }
}

extern "C" void kernel_launch(void* const* d_in, const int* in_sizes, int n_in, void* d_out, int out_size, void* d_ws, size_t ws_size, hipStream_t stream) {
  static int grid_blocks = 0;
  if (!grid_blocks) {
    int dev = 0, cus = 0, per_cu = 0;
    (void)hipGetDevice(&dev);
    (void)hipDeviceGetAttribute(&cus, hipDeviceAttributeMultiprocessorCount, dev);
    (void)hipFuncSetAttribute((const void*)yoco_fwd, hipFuncAttributeMaxDynamicSharedMemorySize, LDS_BYTES);
    (void)hipOccupancyMaxActiveBlocksPerMultiprocessor(&per_cu, (const void*)yoco_fwd, 512, LDS_BYTES);
    if (per_cu < 1) per_cu = 1;
    grid_blocks = cus * per_cu;
    if (ws_size < WS_END) fprintf(stderr, "kernel_launch: workspace too small: %zu < %zu\n", ws_size, (size_t)WS_END);
  }
  Args a; memset(&a, 0, sizeof(a));
  for (int i = 0; i < 25; ++i) a.in[i] = (const float*)d_in[i];
  a.out = (float*)d_out; a.ws = (unsigned char*)d_ws;
  const float* const* in = a.in;
  bf16_t* wp = (bf16_t*)((unsigned char*)d_ws + WS_W);
  int nd = 0, items = 0;
  auto add = [&](const float* src, const float* scale, int K, int Ns, int Nd, int kind) {
    WDesc& d = a.wd[nd++]; d.src = src; d.scale = scale; d.dst = wp; d.K = K; d.Ns = Ns; d.Nd = Nd; d.kind = kind; d.item0 = items; d.pad = 0;
    items += (K / 64) * (Nd / 32); wp += (size_t)K * Nd;
  };
  for (int l = 0; l < 2; ++l) add(in[6] + (size_t)l * DM * ZA_W, in[3] + (size_t)l * DM, DM, ZA_W, ZA_W, 0);
  for (int j = 0; j < 2; ++j) add(in[13] + (size_t)j * DM * ZB_W, in[3] + (size_t)(2 + j) * DM, DM, ZB_W, ZB_W, 0);
  add(in[11], in[10], DM, 576, KVW, 1);
  for (int j = 0; j < 2; ++j) add(in[16] + (size_t)j * 512 * GW, in[12], 512, GW, GW, 0);
  for (int j = 0; j < 2; ++j) add(in[17] + (size_t)j * 512 * GW, in[12], 512, GW, GW, 0);
  for (int l = 0; l < 4; ++l) add(in[19] + (size_t)l * DM * 1024, in[18] + (size_t)l * DM, DM, 1024, 1024, 0);
  for (int j = 0; j < 2; ++j) add(in[15] + (size_t)j * 512 * QW, in[14] + (size_t)j * 512, 512, QW, QW, 2);
  for (int l = 0; l < 4; ++l) add(in[20] + (size_t)l * DM * DM, nullptr, DM, DM, DM, 0);
  for (int l = 0; l < 4; ++l) add(in[21] + (size_t)l * DM * DFF2, in[4] + (size_t)l * DM, DM, DFF2, DFF2, 3);
  for (int l = 0; l < 4; ++l) add(in[24] + (size_t)l * DFF * DM, nullptr, DFF, DM, DM, 0);
  a.nitems = items;
  void* args[] = {&a};
  hipError_t e = hipLaunchCooperativeKernel((const void*)yoco_fwd, dim3(grid_blocks), dim3(512), args, LDS_BYTES, stream);
  if (e != hipSuccess) fprintf(stderr, "cooperative launch failed: %s (grid %d)\n", hipGetErrorString(e), grid_blocks);
}
```

```cpp
#include <hip/hip_runtime.h>
#include <hip/hip_cooperative_groups.h>
#include <cstdio>
#include <cstring>
namespace cg = cooperative_groups;

#define LAS __attribute__((address_space(3)))
typedef unsigned short bf16_t;
typedef short bf16x8 __attribute__((ext_vector_type(8)));
typedef short s16x4 __attribute__((ext_vector_type(4)));
typedef float f32x4 __attribute__((ext_vector_type(4)));
typedef float f32x2 __attribute__((ext_vector_type(2)));
typedef float f32x16 __attribute__((ext_vector_type(16)));
typedef unsigned u32x4 __attribute__((ext_vector_type(4)));
typedef unsigned u32x2 __attribute__((ext_vector_type(2)));

constexpr int DM = 2048, NB = 8, SEQ = 4096, MTOK = NB * SEQ, NMEM = 256, MMEM = NB * NMEM;
constexpr int GW = 1536, ZA_W = 3584, ZB_W = 1024, QW = 2304, KVW = 768, DFF = 5632, DFF2 = 11264;
constexpr float EPS = 1e-6f;
constexpr float LOG2E = 1.4426950408889634f;
constexpr float SC_MEM = 0.08838834764831845f * LOG2E;
constexpr float SC_MLA = 0.07216878364870323f * LOG2E;

constexpr size_t MiB = 1u << 20;
constexpr size_t WS_RS = 1 * MiB;
constexpr size_t WS_CS = 2 * MiB;
constexpr size_t WS_MEMB = 10 * MiB;
constexpr size_t WS_MEMK = 18 * MiB;
constexpr size_t WS_MEMVT = 26 * MiB;
constexpr size_t WS_W = 34 * MiB;
constexpr size_t WS_XB = 396 * MiB;
constexpr size_t WS_KVB = 524 * MiB;
constexpr size_t WS_KN = 572 * MiB;
constexpr size_t WS_VT = 668 * MiB;
constexpr size_t WS_HALO = 764 * MiB;
constexpr size_t WS_R = 852 * MiB;
constexpr size_t WS_CAT = WS_R + 224 * MiB;
constexpr size_t WS_Q = WS_R + 64 * MiB;
constexpr size_t WS_END = 1204 * MiB;

typedef __bf16 bf16x2_t __attribute__((ext_vector_type(2)));
__device__ __forceinline__ unsigned cvt_pk_bf16(float lo, float hi) { const f32x2 v = {lo, hi}; const bf16x2_t b = __builtin_convertvector(v, bf16x2_t); return __builtin_bit_cast(unsigned, b); }
__device__ __forceinline__ float wave_sum(float v) {
#pragma unroll
  for (int o = 1; o < 64; o <<= 1) v += __shfl_xor(v, o);
  return v;
}
__device__ __forceinline__ f32x2 gelu_pk(f32x2 v) {
  const f32x2 av = __builtin_elementwise_abs(v), d = av * 0.2316418882f + 1.0f;
  f32x2 t; t.x = __builtin_amdgcn_rcpf(d.x); t.y = __builtin_amdgcn_rcpf(d.y);
  f32x2 q = t * 0.5307027145f + (-0.7265760135f); q = q * t + 0.7107068705f; q = q * t + (-0.142248368f); q = q * t + 0.127414796f; q = q * t;
  const f32x2 s = (v * v) * (-0.72134752044f);
  f32x2 e; e.x = __builtin_amdgcn_exp2f(s.x); e.y = __builtin_amdgcn_exp2f(s.y);
  const f32x2 m = v * (q * e), r = v - m;
  f32x2 o; o.x = v.x < 0.f ? m.x : r.x; o.y = v.y < 0.f ? m.y : r.y; return o;
}
__device__ __forceinline__ f32x4 gelu4(f32x4 v) { f32x2 a = gelu_pk((f32x2){v[0], v[1]}), b = gelu_pk((f32x2){v[2], v[3]}); return (f32x4){a.x, a.y, b.x, b.y}; }
__device__ __forceinline__ float silu1(float x) { return x * __builtin_amdgcn_rcpf(1.0f + __builtin_amdgcn_exp2f(-x * LOG2E)); }
__device__ __forceinline__ float ror1(float v) { return __builtin_bit_cast(float, __builtin_amdgcn_update_dpp(0, __builtin_bit_cast(int, v), 0x121, 0xf, 0xf, false)); }
__device__ __forceinline__ float ror2(float v) { return __builtin_bit_cast(float, __builtin_amdgcn_update_dpp(0, __builtin_bit_cast(int, v), 0x122, 0xf, 0xf, false)); }
__device__ __forceinline__ f32x4 ror1v(f32x4 v) { return (f32x4){ror1(v[0]), ror1(v[1]), ror1(v[2]), ror1(v[3])}; }
__device__ __forceinline__ f32x4 ror2v(f32x4 v) { return (f32x4){ror2(v[0]), ror2(v[1]), ror2(v[2]), ror2(v[3])}; }

namespace pg8 {
constexpr int BM = 256, BK = 64, HALF = 128, HTB = HALF * BK * 2, STAGE_BYTES = 8 * HTB, NXCD = 8, WGM = 8;
__device__ __forceinline__ int lds_byte(int r, int c) { const int st = (r >> 4) * 2 + (c >> 5), rr = r & 15, cc = c & 31, ob = rr * 64 + cc * 2; return st * 1024 + (ob ^ (((ob >> 9) & 1) << 5)); }
__device__ __forceinline__ void stage_rc(int b, int& R, int& C) { const int st = b / 1024, sb = b % 1024, swz = sb ^ (((sb >> 9) & 1) << 5); R = (st >> 1) * 16 + swz / 64; C = (st & 1) * 32 + (swz % 64) / 2; }
__device__ __forceinline__ int perm32(int rho) { const int n = rho >> 4, i = rho & 15; return 8 * (i >> 2) + 4 * n + (i & 3); }
struct Unit { int pm, pn; };
struct Gemm { const bf16_t* A; const bf16_t* Bt; int M, N, K, lda, ldb; };
struct StaticOrder {
  int nM, nN, nwg, G, c;
  __device__ void init(int M, int N, int G_, int c_) { nM = M / BM; nN = N / BM; nwg = nM * nN; G = G_; c = c_; }
  __device__ bool next(int i, Unit& u) const {
    const long L = (long)i * G + c; if (L >= nwg) return false;
    int wgid = (int)L; { const int q = nwg / NXCD, r = nwg % NXCD, xcd = wgid % NXCD, off = wgid / NXCD; wgid = (xcd < r ? xcd * (q + 1) : r * (q + 1) + (xcd - r) * q) + off; }
    const int nig = WGM * nN, gid = wgid / nig, fm = gid * WGM, gsz = (nM - fm) < WGM ? (nM - fm) : WGM;
    u.pm = fm + ((wgid % nig) % gsz); u.pn = (wgid % nig) / gsz; return true;
  }
};

#ifndef PG8_SP2
#define PG8_SP2 true
#endif
#ifndef PG8_ALIGN
#define PG8_ALIGN true
#endif
template <class Epi, bool SP2 = PG8_SP2, bool ALIGN_EPI = PG8_ALIGN>
__device__ __forceinline__ void gemm_phase(LAS unsigned char* lds, const Gemm g, const StaticOrder& S, const Epi& E) {
  int tid_o = threadIdx.x; asm volatile("" : "+v"(tid_o));
  const int tid = tid_o, wid = __builtin_amdgcn_readfirstlane(tid >> 6), lane = tid & 63, wr = wid >> 2, wc = wid & 3, fr = lane & 15, fq = lane >> 4;
  const int K = g.K, nt = K / BK;
  unsigned voffA[2], voffB[2];
#pragma unroll
  for (int i = 0; i < 2; ++i) { int R, C; stage_rc(tid * 16 + i * 8192, R, C); const int Rb = Epi::PERM ? ((R & ~31) + perm32(R & 31)) : R;
    voffA[i] = (unsigned)(R * g.lda + C) * 2u; voffB[i] = (unsigned)(Rb * g.ldb + C) * 2u; }
  const size_t kstep = (size_t)(BK * 2);
  const size_t hstepA = (size_t)HALF * g.lda * 2, hstepB = (size_t)HALF * g.ldb * 2;
  const size_t tstepA = 2 * hstepA, tstepB = 2 * hstepB;
  const unsigned ldsw = (unsigned)wid * 1024u;
  const int aoff = lds_byte(wr * 64 + fr, fq * 8), boff = lds_byte(wc * 32 + fr, fq * 8);
#define PG8_SA(b, h) (((b) * 2 + (h)) * HTB)
#define PG8_SB(b, h) ((4 + (b) * 2 + (h)) * HTB)
#define PG8_STAGE(bufoff, gbase, voff) do { _Pragma("unroll") for (int _i = 0; _i < 2; ++_i) \
    __builtin_amdgcn_global_load_lds((const unsigned*)((const char*)(gbase) + (voff)[_i]), (LAS unsigned*)(lds + (bufoff) + ldsw + _i * 8192), 16, 0, 0); } while (0)
#define PG8_LDA(dst, b, h) do { _Pragma("unroll") for (int m = 0; m < 4; ++m) _Pragma("unroll") for (int k = 0; k < 2; ++k) dst[m][k] = *(const LAS bf16x8*)(lds + PG8_SA(b, h) + aoff + m * 2048 + k * 1024); } while (0)
#define PG8_LDB(dst, b, h) do { _Pragma("unroll") for (int n = 0; n < 2; ++n) _Pragma("unroll") for (int k = 0; k < 2; ++k) dst[n][k] = *(const LAS bf16x8*)(lds + PG8_SB(b, h) + boff + n * 2048 + k * 1024); } while (0)
#define PG8_MMA(ai, bj, At, Bt) do { __builtin_amdgcn_s_setprio(1); _Pragma("unroll") for (int m = 0; m < 4; ++m) _Pragma("unroll") for (int n = 0; n < 2; ++n) _Pragma("unroll") for (int k = 0; k < 2; ++k) \
    acc[ai][bj][m][n] = __builtin_amdgcn_mfma_f32_16x16x32_bf16(Bt[n][k], At[m][k], acc[ai][bj][m][n], 0, 0, 0); __builtin_amdgcn_s_setprio(0); } while (0)
#define PG8_WAIT_V(n) asm volatile("s_waitcnt vmcnt(" #n ")" ::: "memory")
#define PG8_WAIT_L(n) asm volatile("s_waitcnt lgkmcnt(" #n ")" ::: "memory")
#define PG8_BAR __builtin_amdgcn_s_barrier()
#define PG8_SCHED __builtin_amdgcn_sched_barrier(0)
  Unit cur, nxt; int ui = 0;
  if (!S.next(0, cur)) return;
  f32x4 acc[2][2][4][2];
  if constexpr (Epi::INIT) E.init(acc, cur, wr, wc, fr, fq);
  else {
#pragma unroll
  for (int a = 0; a < 2; ++a)
#pragma unroll
    for (int b = 0; b < 2; ++b)
#pragma unroll
      for (int m = 0; m < 4; ++m)
#pragma unroll
        for (int n = 0; n < 2; ++n) acc[a][b][m][n] = (f32x4){0.f, 0.f, 0.f, 0.f};
  }
  bf16x8 At[4][2], B0[2][2], B1[2][2];
  const char* cA = (const char*)g.A + (size_t)cur.pm * tstepA; const char* cB = (const char*)g.Bt + (size_t)cur.pn * tstepB;
  if constexpr (SP2) {
    PG8_STAGE(PG8_SB(0, 0), cB, voffB); PG8_STAGE(PG8_SB(0, 1), cB + hstepB, voffB); PG8_STAGE(PG8_SA(0, 0), cA, voffA); PG8_STAGE(PG8_SA(0, 1), cA + hstepA, voffA);
    if (wr == 1) PG8_BAR;
    PG8_WAIT_V(2); PG8_BAR;
    PG8_STAGE(PG8_SB(1, 0), cB + kstep, voffB); PG8_STAGE(PG8_SA(1, 0), cA + kstep, voffA); PG8_STAGE(PG8_SB(1, 1), cB + hstepB + kstep, voffB);
    PG8_WAIT_V(6); PG8_BAR;
  } else {
  PG8_STAGE(PG8_SB(0, 0), cB, voffB); PG8_STAGE(PG8_SA(0, 0), cA, voffA); PG8_STAGE(PG8_SB(0, 1), cB + hstepB, voffB); PG8_STAGE(PG8_SA(0, 1), cA + hstepA, voffA);
  if (wr == 1) PG8_BAR;
  PG8_WAIT_V(4); PG8_BAR;
  PG8_STAGE(PG8_SB(1, 0), cB + kstep, voffB); PG8_STAGE(PG8_SA(1, 0), cA + kstep, voffA); PG8_STAGE(PG8_SB(1, 1), cB + hstepB + kstep, voffB);
  PG8_WAIT_V(6); PG8_BAR;
  }
  for (;;) {
    const bool has_next = S.next(ui + 1, nxt);
    const char* nA = has_next ? (const char*)g.A + (size_t)nxt.pm * tstepA : cA; const char* nB = has_next ? (const char*)g.Bt + (size_t)nxt.pn * tstepB : cB;
    for (int t = 0; t < nt; t += 2) {
      const bool last = (t == nt - 2);
      const char* a1 = cA + (size_t)(t + 1) * kstep;
      const char* a2 = last ? nA : cA + (size_t)(t + 2) * kstep; const char* b2 = last ? nB : cB + (size_t)(t + 2) * kstep;
      const char* a3 = a2 + kstep; const char* b3 = b2 + kstep;
      if constexpr (SP2) {
      PG8_LDB(B0, 0, 0); PG8_LDB(B1, 0, 1); PG8_SCHED; PG8_LDA(At, 0, 0); PG8_STAGE(PG8_SA(1, 1), a1 + hstepA, voffA);
      PG8_WAIT_V(8); PG8_WAIT_L(0); PG8_BAR; PG8_MMA(0, 0, At, B0); PG8_MMA(0, 1, At, B1); PG8_BAR; PG8_SCHED;
      PG8_LDA(At, 0, 1); PG8_STAGE(PG8_SB(0, 0), b2, voffB); PG8_STAGE(PG8_SB(0, 1), b2 + hstepB, voffB); PG8_STAGE(PG8_SA(0, 0), a2, voffA);
      PG8_WAIT_V(8); PG8_WAIT_L(0); PG8_BAR; PG8_MMA(1, 0, At, B0); PG8_MMA(1, 1, At, B1); PG8_BAR; PG8_SCHED;
      PG8_LDB(B0, 1, 0); PG8_LDB(B1, 1, 1); PG8_SCHED; PG8_LDA(At, 1, 0); PG8_STAGE(PG8_SA(0, 1), a2 + hstepA, voffA);
      PG8_WAIT_V(8); PG8_WAIT_L(0); PG8_BAR; PG8_MMA(0, 0, At, B0); PG8_MMA(0, 1, At, B1); PG8_BAR; PG8_SCHED;
      PG8_LDA(At, 1, 1); PG8_STAGE(PG8_SB(1, 0), b3, voffB); PG8_STAGE(PG8_SB(1, 1), b3 + hstepB, voffB); PG8_STAGE(PG8_SA(1, 0), a3, voffA);
      PG8_WAIT_V(8); PG8_WAIT_L(0); PG8_BAR; PG8_MMA(1, 0, At, B0); PG8_MMA(1, 1, At, B1); PG8_BAR; PG8_SCHED;
      } else {
      PG8_LDB(B0, 0, 0); PG8_SCHED; PG8_LDA(At, 0, 0); PG8_STAGE(PG8_SA(1, 1), a1 + hstepA, voffA);
      PG8_WAIT_L(8); PG8_BAR; PG8_WAIT_L(0); PG8_MMA(0, 0, At, B0); PG8_BAR; PG8_SCHED;
      PG8_LDB(B1, 0, 1); PG8_STAGE(PG8_SB(0, 0), b2, voffB);
      PG8_BAR; PG8_WAIT_L(0); PG8_MMA(0, 1, At, B1); PG8_BAR;
      PG8_LDA(At, 0, 1); PG8_STAGE(PG8_SA(0, 0), a2, voffA);
      PG8_BAR; PG8_WAIT_L(0); PG8_MMA(1, 0, At, B0); PG8_BAR; PG8_SCHED;
      PG8_STAGE(PG8_SB(0, 1), b2 + hstepB, voffB);
      PG8_WAIT_V(6); PG8_BAR; PG8_MMA(1, 1, At, B1); PG8_BAR;
      PG8_LDB(B0, 1, 0); PG8_SCHED; PG8_LDA(At, 1, 0); PG8_STAGE(PG8_SA(0, 1), a2 + hstepA, voffA);
      PG8_WAIT_L(8); PG8_BAR; PG8_WAIT_L(0); PG8_MMA(0, 0, At, B0); PG8_BAR; PG8_SCHED;
      PG8_LDB(B1, 1, 1); PG8_STAGE(PG8_SB(1, 0), b3, voffB);
      PG8_BAR; PG8_WAIT_L(0); PG8_MMA(0, 1, At, B1); PG8_BAR;
      PG8_LDA(At, 1, 1); PG8_STAGE(PG8_SA(1, 0), a3, voffA);
      PG8_BAR; PG8_WAIT_L(0); PG8_MMA(1, 0, At, B0); PG8_BAR; PG8_SCHED;
      PG8_STAGE(PG8_SB(1, 1), b3 + hstepB, voffB);
      PG8_WAIT_V(6); PG8_BAR; PG8_MMA(1, 1, At, B1); PG8_BAR;
      }
    }
    if constexpr (ALIGN_EPI) { if (wr == 0) PG8_BAR; }
    E(acc, cur, wr, wc, fr, fq);
    if (!has_next) break;
    if constexpr (Epi::INIT) E.init(acc, nxt, wr, wc, fr, fq);
    else {
#pragma unroll
    for (int a = 0; a < 2; ++a)
#pragma unroll
      for (int b = 0; b < 2; ++b)
#pragma unroll
        for (int m = 0; m < 4; ++m)
#pragma unroll
          for (int n = 0; n < 2; ++n) acc[a][b][m][n] = (f32x4){0.f, 0.f, 0.f, 0.f};
    }
    cur = nxt; cA = nA; cB = nB; ++ui;
    if constexpr (ALIGN_EPI) { if (wr == 1) PG8_BAR; }
  }
  PG8_WAIT_V(0);
  if constexpr (!ALIGN_EPI) { if (wr == 0) PG8_BAR; }
  PG8_BAR;
#undef PG8_SA
#undef PG8_SB
#undef PG8_STAGE
#undef PG8_LDA
#undef PG8_LDB
#undef PG8_MMA
#undef PG8_WAIT_V
#undef PG8_WAIT_L
#undef PG8_BAR
#undef PG8_SCHED
}
}
using pg8::Unit; using pg8::HALF;
typedef f32x4 Acc[2][2][4][2];

struct EpiG {
  static constexpr bool PERM = true, INIT = false;
  bf16_t* O; int ldc;
  const float* rss; float rinvD;
  const float* css; float cinvD;
  int gelu_hi;
  int ss_lo, ss_hi; float* ssacc;
  int rope_mode;
  const f32x2* cs;
  int sc_lo; float sc_val;
  __device__ __forceinline__ void operator()(Acc& acc, const Unit& u, int wr, int wc, int fr, int fq) const {
    const int ct = u.pn * 256;
    const bool do_gelu = ct < gelu_hi, do_ss = (ct >= ss_lo && ct < ss_hi), do_sc = ct >= sc_lo;
    float rsv[2][4];
#pragma unroll
    for (int ai = 0; ai < 2; ++ai)
#pragma unroll
      for (int m = 0; m < 4; ++m) rsv[ai][m] = rss ? rss[u.pm * 256 + ai * HALF + wr * 64 + m * 16 + fr] : 1.0f;
    f32x4 cq[2][2];
#pragma unroll
    for (int bj = 0; bj < 2; ++bj) { const int c0 = ct + bj * HALF + wc * 32 + 8 * fq;
      cq[bj][0] = css ? *(const f32x4*)(css + c0) : (f32x4){1.f, 1.f, 1.f, 1.f}; cq[bj][1] = css ? *(const f32x4*)(css + c0 + 4) : (f32x4){1.f, 1.f, 1.f, 1.f}; }
    if (rss) {
#pragma unroll
      for (int ai = 0; ai < 2; ++ai)
#pragma unroll
        for (int m = 0; m < 4; ++m) rsv[ai][m] = __builtin_amdgcn_rsqf(rsv[ai][m] * rinvD + EPS);
    }
    if (css) {
#pragma unroll
      for (int bj = 0; bj < 2; ++bj)
#pragma unroll
        for (int h = 0; h < 2; ++h)
#pragma unroll
          for (int j = 0; j < 4; ++j) cq[bj][h][j] = __builtin_amdgcn_rsqf(cq[bj][h][j] * cinvD + EPS);
    }
#pragma unroll
    for (int ai = 0; ai < 2; ++ai)
#pragma unroll
      for (int m = 0; m < 4; ++m) {
        const int row = u.pm * 256 + ai * HALF + wr * 64 + m * 16 + fr;
        const float rs = rsv[ai][m];
        float ss = 0.f;
#pragma unroll
        for (int bj = 0; bj < 2; ++bj) {
          const int c0 = ct + bj * HALF + wc * 32 + 8 * fq;
          f32x4 v0 = acc[ai][bj][m][0] * rs, v1 = acc[ai][bj][m][1] * rs;
          if (css) { v0 = v0 * cq[bj][0]; v1 = v1 * cq[bj][1]; }
          if (do_gelu) { v0 = gelu4(v0); v1 = gelu4(v1); }
          if (do_ss) ss += (v0[0] * v0[0] + v0[1] * v0[1]) + (v0[2] * v0[2] + v0[3] * v0[3]) + (v1[0] * v1[0] + v1[1] * v1[1]) + (v1[2] * v1[2] + v1[3] * v1[3]);
          int roff = -1;
          if (rope_mode == 1) { const int d = c0 % 192; if (d >= 128) roff = d - 128; }
          else if (rope_mode == 2) { if (c0 >= 512 && c0 < 576) roff = c0 - 512; }
          if (roff >= 0) {
            const f32x2* t = cs + (size_t)row * 32 + (roff >> 1);
            const f32x2 t0 = t[0], t1 = t[1], t2 = t[2], t3 = t[3];
            f32x4 w0, w1;
            w0[0] = v0[0] * t0.x - v0[1] * t0.y; w0[1] = v0[1] * t0.x + v0[0] * t0.y;
            w0[2] = v0[2] * t1.x - v0[3] * t1.y; w0[3] = v0[3] * t1.x + v0[2] * t1.y;
            w1[0] = v1[0] * t2.x - v1[1] * t2.y; w1[1] = v1[1] * t2.x + v1[0] * t2.y;
            w1[2] = v1[2] * t3.x - v1[3] * t3.y; w1[3] = v1[3] * t3.x + v1[2] * t3.y;
            v0 = w0; v1 = w1;
          }
          if (do_sc) { v0 = v0 * sc_val; v1 = v1 * sc_val; }
          u32x4 w; w.x = cvt_pk_bf16(v0[0], v0[1]); w.y = cvt_pk_bf16(v0[2], v0[3]); w.z = cvt_pk_bf16(v1[0], v1[1]); w.w = cvt_pk_bf16(v1[2], v1[3]);
          *(u32x4*)(O + (size_t)row * ldc + c0) = w;
        }
        if (do_ss) { ss += __shfl_xor(ss, 16); ss += __shfl_xor(ss, 32); if (fq == 0) atomicAdd(ssacc + row, ss); }
      }
  }
};

struct EpiRes {
  static constexpr bool PERM = false, INIT = true;
  const float* xold; float* xnew; bf16_t* xb; float* ssacc;
  __device__ __forceinline__ void init(Acc& acc, const Unit& u, int wr, int wc, int fr, int fq) const {
    const int col0 = u.pn * 256 + wc * 32 + 4 * fq;
#pragma unroll
    for (int ai = 0; ai < 2; ++ai)
#pragma unroll
      for (int bj = 0; bj < 2; ++bj)
#pragma unroll
        for (int m = 0; m < 4; ++m)
#pragma unroll
          for (int n = 0; n < 2; ++n) {
            const int row = u.pm * 256 + ai * HALF + wr * 64 + m * 16 + fr;
            acc[ai][bj][m][n] = *(const f32x4*)(xold + (size_t)row * DM + col0 + bj * HALF + n * 16);
          }
  }
  __device__ __forceinline__ void operator()(Acc& acc, const Unit& u, int wr, int wc, int fr, int fq) const {
    const int col0 = u.pn * 256 + wc * 32 + 4 * fq;
#pragma unroll
    for (int ai = 0; ai < 2; ++ai)
#pragma unroll
      for (int m = 0; m < 4; ++m) {
        const int row = u.pm * 256 + ai * HALF + wr * 64 + m * 16 + fr;
        float ss = 0.f;
#pragma unroll
        for (int bj = 0; bj < 2; ++bj)
#pragma unroll
          for (int n = 0; n < 2; ++n) {
            const size_t off = (size_t)row * DM + col0 + bj * HALF + n * 16;
            const f32x4 v = acc[ai][bj][m][n];
            *(f32x4*)(xnew + off) = v;
            u32x2 w; w.x = cvt_pk_bf16(v[0], v[1]); w.y = cvt_pk_bf16(v[2], v[3]);
            *(u32x2*)(xb + off) = w;
            ss += (v[0] * v[0] + v[1] * v[1]) + (v[2] * v[2] + v[3] * v[3]);
          }
        ss += __shfl_xor(ss, 16); ss += __shfl_xor(ss, 32);
        if (fq == 0) atomicAdd(ssacc + row, ss);
      }
  }
};

struct EpiUp {
  static constexpr bool PERM = true, INIT = false;
  bf16_t* g; float* halo; const float* rss; const float* cw; const float* cb; LAS unsigned char* epl;
  __device__ __forceinline__ void operator()(Acc& acc, const Unit& u, int wr, int wc, int fr, int fq) const {
    const int rowb = u.pm * 256 + wr * 64;
    const int c0 = u.pn * 128 + wc * 32 + 8 * fq;
    float rr[2][4];
#pragma unroll
    for (int ai = 0; ai < 2; ++ai)
#pragma unroll
      for (int m = 0; m < 4; ++m) rr[ai][m] = rss[rowb + ai * HALF + m * 16 + fr];
    LAS unsigned char* wl = epl + (wr * 4 + wc) * 1024;
    { const int lane = fq * 16 + fr, arr = lane >> 3, part = lane & 7, col = u.pn * 128 + wc * 32 + 4 * part;
      const float* sp = ((arr & 3) == 3 ? cb : cw + (size_t)(arr & 3) * DFF2) + (arr >> 2) * DFF + col;
      const f32x4 wv = *(const f32x4*)sp;
      *(LAS f32x4*)(wl + lane * 16) = wv; }
#pragma unroll
    for (int ai = 0; ai < 2; ++ai)
#pragma unroll
      for (int m = 0; m < 4; ++m) {
        const float r = __builtin_amdgcn_rsqf(rr[ai][m] * (1.0f / DM) + EPS);
#pragma unroll
        for (int bj = 0; bj < 2; ++bj)
#pragma unroll
          for (int n = 0; n < 2; ++n) acc[ai][bj][m][n] = acc[ai][bj][m][n] * r;
      }
    asm volatile("s_waitcnt lgkmcnt(0)" ::: "memory");
#pragma unroll
    for (int n = 0; n < 2; ++n) {
      const int cc = c0 + 4 * n;
      const LAS unsigned char* wp = wl + (8 * fq + 4 * n) * 4;
      const f32x4 wg0 = *(const LAS f32x4*)(wp), wg1 = *(const LAS f32x4*)(wp + 128), wg2 = *(const LAS f32x4*)(wp + 256), bg = *(const LAS f32x4*)(wp + 384);
      const f32x4 wv0 = *(const LAS f32x4*)(wp + 512), wv1 = *(const LAS f32x4*)(wp + 640), wv2 = *(const LAS f32x4*)(wp + 768), bv = *(const LAS f32x4*)(wp + 896);
#pragma unroll
      for (int ai = 0; ai < 2; ++ai) {
        f32x4 g1p = (f32x4){0.f, 0.f, 0.f, 0.f}, g2p = g1p, v1p = g1p, v2p = g1p;
#pragma unroll
        for (int m = 0; m < 4; ++m) {
          const f32x4 G = acc[ai][0][m][n], V = acc[ai][1][m][n];
          const f32x4 g1 = ror1v(G), g2 = ror2v(G), v1 = ror1v(V), v2 = ror2v(V);
          const f32x4 pg1 = fr >= 1 ? g1 : g1p, pg2 = fr >= 2 ? g2 : g2p, pv1 = fr >= 1 ? v1 : v1p, pv2 = fr >= 2 ? v2 : v2p;
          const f32x4 cgt = wg2 * G + wg1 * pg1 + wg0 * pg2 + bg;
          const f32x4 cvl = wv2 * V + wv1 * pv1 + wv0 * pv2 + bv;
          g1p = g1; g2p = g2; v1p = v1; v2p = v2;
          const int row = rowb + ai * HALF + m * 16 + fr;
          if (m > 0 || fr >= 2) {
            u32x2 w; w.x = cvt_pk_bf16(silu1(cgt[0]) * cvl[0], silu1(cgt[1]) * cvl[1]); w.y = cvt_pk_bf16(silu1(cgt[2]) * cvl[2], silu1(cgt[3]) * cvl[3]);
            *(u32x2*)(g + (size_t)row * DFF + cc) = w;
          }
          int slot = -1;
          if (m == 0 && fr < 2) slot = fr;
          if (m == 3 && fr >= 14) slot = fr - 12;
          if (slot >= 0) {
            float* hp = halo + ((size_t)(row >> 6) * 4 + slot) * DFF2 + cc;
            *(f32x4*)hp = G; *(f32x4*)(hp + DFF) = V;
          }
        }
      }
    }
  }
};

constexpr int ATT_KBUF = 64 * 400, ATT_VROWB = 136, ATT_VBUF = 128 * ATT_VROWB, ATT_BUF = ATT_KBUF + ATT_VBUF;
template <int DQK, bool CAUSAL>
__device__ __forceinline__ void attn_unit(LAS unsigned char* lds, const bf16_t* Q, int ldq, const bf16_t* K1, int ldk1, const bf16_t* K2, int ldk2,
                                          const bf16_t* VT, int ldv, int ntiles, int q0, bf16_t* O, int ldo) {
  constexpr int KROWB = (DQK + 8) * 2, NKS = DQK / 16, CPR = DQK / 8, NKCH = 64 * CPR / 512;
  int tid_o = threadIdx.x; asm volatile("" : "+v"(tid_o));
  const int tid = tid_o, wid = __builtin_amdgcn_readfirstlane(tid >> 6), lane = tid & 63, r32 = lane & 31, hi = lane >> 5;
  bf16x8 qf[NKS];
  { const bf16_t* qp = Q + (size_t)(wid * 32 + r32) * ldq + hi * 8;
#pragma unroll
    for (int ks = 0; ks < NKS; ++ks) qf[ks] = *(const bf16x8*)(qp + ks * 16); }
  u32x4 kreg[NKCH], vreg[2];
#define ATT_GLOAD(t_) do { const int k0_ = (t_) * 64; \
    _Pragma("unroll") for (int i = 0; i < NKCH; ++i) { const int ch = tid + i * 512, kr = ch / CPR, kc = ch - kr * CPR; \
      const bf16_t* src = (DQK == 128 || kc < 16) ? K1 + (size_t)(k0_ + kr) * ldk1 + kc * 8 : K2 + (size_t)(k0_ + kr) * ldk2 + (kc - 16) * 8; \
      kreg[i] = *(const u32x4*)src; } \
    _Pragma("unroll") for (int i = 0; i < 2; ++i) { const int ch = tid + i * 512, d = ch >> 3, cc = ch & 7; vreg[i] = *(const u32x4*)(VT + (size_t)d * ldv + k0_ + cc * 8); } } while (0)
#define ATT_LWRITE(buf_) do { LAS unsigned char* kb_ = lds + (buf_) * ATT_BUF; \
    _Pragma("unroll") for (int i = 0; i < NKCH; ++i) { const int ch = tid + i * 512, kr = ch / CPR, kc = ch - kr * CPR; *(LAS u32x4*)(kb_ + kr * KROWB + kc * 16) = kreg[i]; } \
    _Pragma("unroll") for (int i = 0; i < 2; ++i) { const int ch = tid + i * 512, d = ch >> 3, cc = ch & 7; LAS unsigned char* p = kb_ + ATT_KBUF + d * ATT_VROWB + cc * 16; \
      *(LAS u32x2*)p = (u32x2){vreg[i].x, vreg[i].y}; *(LAS u32x2*)(p + 8) = (u32x2){vreg[i].z, vreg[i].w}; } } while (0)
  f32x16 o[4];
#pragma unroll
  for (int d = 0; d < 4; ++d)
#pragma unroll
    for (int i = 0; i < 16; ++i) o[d][i] = 0.f;
  float mrow = 0.f, lsum = 0.f;
  const int qabs = q0 + wid * 32 + r32, qlo = q0 + wid * 32;
  ATT_GLOAD(0); ATT_LWRITE(0); __syncthreads();
  for (int t = 0; t < ntiles; ++t) {
    const int buf = t & 1;
    if (t + 1 < ntiles) ATT_GLOAD(t + 1);
    const int k0 = t * 64;
    if (!CAUSAL || k0 <= qlo + 31) {
      const LAS unsigned char* kb = lds + buf * ATT_BUF;
      const bool first = (t == 0);
      const float nm = first ? 0.f : -mrow;
      f32x16 s0, s1;
#pragma unroll
      for (int i = 0; i < 16; ++i) { s0[i] = nm; s1[i] = nm; }
#pragma unroll
      for (int ks = 0; ks < NKS; ++ks) {
        const bf16x8 ka = *(const LAS bf16x8*)(kb + r32 * KROWB + ks * 32 + hi * 16);
        const bf16x8 kc = *(const LAS bf16x8*)(kb + (32 + r32) * KROWB + ks * 32 + hi * 16);
        s0 = __builtin_amdgcn_mfma_f32_32x32x16_bf16(ka, qf[ks], s0, 0, 0, 0);
        s1 = __builtin_amdgcn_mfma_f32_32x32x16_bf16(kc, qf[ks], s1, 0, 0, 0);
      }
      if (CAUSAL && k0 + 63 > qlo) {
#pragma unroll
        for (int i = 0; i < 16; ++i) { const int kv = k0 + (i & 3) + 8 * (i >> 2) + 4 * hi;
          if (kv > qabs) s0[i] = -INFINITY; if (kv + 32 > qabs) s1[i] = -INFINITY; }
      }
      float mx = s0[0];
#pragma unroll
      for (int i = 1; i < 16; ++i) mx = fmaxf(mx, s0[i]);
#pragma unroll
      for (int i = 0; i < 16; ++i) mx = fmaxf(mx, s1[i]);
      mx = fmaxf(mx, __shfl_xor(mx, 32));
      const bool need = first || (mx > 8.0f);
      if (__ballot(need) != 0ull) {
        const float d = need ? mx : 0.f;
        const float alpha = first ? 0.f : __builtin_amdgcn_exp2f(-d);
        mrow = first ? mx : mrow + d;
        lsum *= alpha;
#pragma unroll
        for (int dd = 0; dd < 4; ++dd)
#pragma unroll
          for (int i = 0; i < 16; ++i) o[dd][i] *= alpha;
#pragma unroll
        for (int i = 0; i < 16; ++i) { s0[i] -= d; s1[i] -= d; }
      }
      float ps = 0.f;
#pragma unroll
      for (int i = 0; i < 16; ++i) { s0[i] = __builtin_amdgcn_exp2f(s0[i]); s1[i] = __builtin_amdgcn_exp2f(s1[i]); ps += s0[i] + s1[i]; }
      lsum += ps;
      bf16x8 pa[4];
#pragma unroll
      for (int s = 0; s < 4; ++s) {
        u32x4 w;
        if (s < 2) { w.x = cvt_pk_bf16(s0[8 * s + 0], s0[8 * s + 1]); w.y = cvt_pk_bf16(s0[8 * s + 2], s0[8 * s + 3]); w.z = cvt_pk_bf16(s0[8 * s + 4], s0[8 * s + 5]); w.w = cvt_pk_bf16(s0[8 * s + 6], s0[8 * s + 7]); }
        else { const int b = 8 * (s - 2); w.x = cvt_pk_bf16(s1[b + 0], s1[b + 1]); w.y = cvt_pk_bf16(s1[b + 2], s1[b + 3]); w.z = cvt_pk_bf16(s1[b + 4], s1[b + 5]); w.w = cvt_pk_bf16(s1[b + 6], s1[b + 7]); }
        pa[s] = __builtin_bit_cast(bf16x8, w);
      }
      const LAS unsigned char* vb = kb + ATT_KBUF;
#pragma unroll
      for (int d = 0; d < 4; ++d)
#pragma unroll
        for (int s = 0; s < 4; ++s) {
          const LAS unsigned char* p = vb + (32 * d + r32) * ATT_VROWB + (16 * s + 4 * hi) * 2;
          const u32x2 lo = *(const LAS u32x2*)p, hh = *(const LAS u32x2*)(p + 16);
          const bf16x8 vf = __builtin_bit_cast(bf16x8, (u32x4){lo.x, lo.y, hh.x, hh.y});
          o[d] = __builtin_amdgcn_mfma_f32_32x32x16_bf16(vf, pa[s], o[d], 0, 0, 0);
        }
    }
    if (t + 1 < ntiles) ATT_LWRITE(buf ^ 1);
    __syncthreads();
  }
#undef ATT_GLOAD
#undef ATT_LWRITE
  const float inv = 1.0f / (lsum + __shfl_xor(lsum, 32));
  bf16_t* op = O + (size_t)(wid * 32 + r32) * ldo + 4 * hi;
#pragma unroll
  for (int d = 0; d < 4; ++d)
#pragma unroll
    for (int ig = 0; ig < 4; ++ig) {
      u32x2 w; w.x = cvt_pk_bf16(o[d][4 * ig] * inv, o[d][4 * ig + 1] * inv); w.y = cvt_pk_bf16(o[d][4 * ig + 2] * inv, o[d][4 * ig + 3] * inv);
      *(u32x2*)(op + 32 * d + 8 * ig) = w;
    }
}


#define XB_TMO      128
#define XB_XCNT(j)  (256  + 64 * (j))
#define XB_XSUB(j)  (1280 + 64 * (j))
#define XB_XGEN(j)  (2304 + 64 * (j))
#define XB_TOP      3328
#define XB_TOPGEN   3392
#define XCD_BAR_WORDS 3456
#define XB_SPIN_CAP (1u << 18)
__device__ __forceinline__ unsigned xb_ld(unsigned* p)              { return __hip_atomic_load(p, __ATOMIC_RELAXED, __HIP_MEMORY_SCOPE_AGENT); }
__device__ __forceinline__ unsigned xb_add(unsigned* p, unsigned v) { return __hip_atomic_fetch_add(p, v, __ATOMIC_RELAXED, __HIP_MEMORY_SCOPE_AGENT); }
__device__ __forceinline__ unsigned xb_xcc_id() { return (unsigned)__builtin_amdgcn_s_getreg((3 << 11) | 20) & 0xFu; }
#define XB_SPIN(cond, bar) do { unsigned _sp = 0; while (cond) { __builtin_amdgcn_s_sleep(1); \
    if ((++_sp & 255u) == 0u) { if (xb_ld(&(bar)[XB_TMO])) break; if (_sp > XB_SPIN_CAP) { atomicAdd(&(bar)[XB_TMO], 1u); break; } } } } while (0)
struct XcdBarrier { unsigned* bar; unsigned x; volatile LAS unsigned* st; };
__device__ __forceinline__ XcdBarrier xcd_barrier_post(unsigned* bar, volatile LAS unsigned* st) {
  XcdBarrier b; b.bar = bar; b.x = xb_xcc_id(); b.st = st;
  if (threadIdx.x == 0) (void)xb_add(&bar[XB_XCNT(b.x)], 1u);
  return b;
}
__device__ __forceinline__ void xcd_barrier_complete(unsigned* bar, unsigned x, unsigned& nloc, unsigned& nx) {
  const unsigned G = gridDim.x * gridDim.y * gridDim.z;
  unsigned sum, cnt, mine, sp = 0u;
  for (;;) {
    sum = 0u; cnt = 0u; mine = 0u;
#pragma unroll
    for (unsigned j = 0; j < 16; ++j) { const unsigned c = xb_ld(&bar[XB_XCNT(j)]); sum += c; cnt += (c > 0u) ? 1u : 0u; mine = (j == x) ? c : mine; }
    if (sum == G) break;
    __builtin_amdgcn_s_sleep(1);
    if ((++sp & 255u) == 0u) { if (xb_ld(&bar[XB_TMO])) break; if (sp > XB_SPIN_CAP) { atomicAdd(&bar[XB_TMO], 1u); break; } }
  }
  nloc = mine > 0u ? mine : 1u; nx = cnt > 0u ? cnt : 1u;
}
__device__ __forceinline__ void xcd_barrier(const XcdBarrier& b) {
  asm volatile("s_waitcnt vmcnt(0)" ::: "memory");
  __syncthreads();
  if (threadIdx.x == 0) {
    unsigned* bar = b.bar;
    __builtin_amdgcn_s_waitcnt(0);
    unsigned nloc = b.st[0], nx = b.st[1];
    if (nloc == 0u) { xcd_barrier_complete(bar, b.x, nloc, nx); b.st[0] = nloc; b.st[1] = nx; }
    const unsigned old = xb_add(&bar[XB_XSUB(b.x)], 1u);
    const unsigned gen = old / nloc;
    if (old + 1u == (gen + 1u) * nloc) {
      __builtin_amdgcn_fence(__ATOMIC_RELEASE, "agent");
      asm volatile("s_waitcnt vmcnt(0)" ::: "memory");
      const unsigned og = xb_add(&bar[XB_TOP], 1u);
      const unsigned tg = og / nx;
      if (og + 1u == (tg + 1u) * nx) xb_add(&bar[XB_TOPGEN], 1u);
      else XB_SPIN(xb_ld(&bar[XB_TOPGEN]) == tg, bar);
      __builtin_amdgcn_fence(__ATOMIC_ACQUIRE, "agent");
      xb_add(&bar[XB_XGEN(b.x)], 1u);
      asm volatile("s_waitcnt vmcnt(0)" ::: "memory");
    } else {
      XB_SPIN(xb_ld(&bar[XB_XGEN(b.x)]) == gen, bar);
      __builtin_amdgcn_fence(__ATOMIC_ACQUIRE, "agent");
      asm volatile("s_waitcnt vmcnt(0)" ::: "memory");
    }
  }
  __syncthreads();
}

constexpr int NWD = 27;
struct WDesc { const float* src; const float* scale; bf16_t* dst; int K, Ns, Nd, kind, item0, pad; };
struct Args { const float* in[25]; float* out; unsigned char* ws; WDesc wd[NWD]; int nitems; int pad; };

__device__ __forceinline__ int srccol(int kind, int n) {
  if (kind == 0) return n;
  if (kind == 1) { if (n < 512) return n; if (n < 576) { const int r = n - 512; return 512 + ((r & 1) ? 32 : 0) + (r >> 1); } return -1; }
  if (kind == 2) { const int h = n / 192, d = n - h * 192; if (d < 128) return n; const int r = d - 128; return h * 192 + 128 + ((r & 1) ? 32 : 0) + (r >> 1); }
  { const int t = n >> 8, w = n & 255; return (w >> 7) * DFF + 128 * t + (w & 127); }
}

constexpr int LDS_BYTES = 140 * 1024;
#ifndef ONLY
#define ONLY 0
#endif
#define EN(k) (ONLY == 0 || ONLY == (k))
typedef __attribute__((address_space(4))) const Args CArgs;
#define DERIVE_PTRS(ap) \
  unsigned char* ws = (ap)->ws; \
  float* rsA = (float*)(ws + WS_RS); float* rsB = rsA + MTOK; float* rsV = rsB + MTOK; float* rsQ = rsV + MTOK; float* rsKV = rsQ + MTOK; float* rsM = rsKV + MTOK; \
  f32x2* cs = (f32x2*)(ws + WS_CS); \
  bf16_t* memb = (bf16_t*)(ws + WS_MEMB); bf16_t* memk = (bf16_t*)(ws + WS_MEMK); bf16_t* memvt = (bf16_t*)(ws + WS_MEMVT); \
  bf16_t* xb = (bf16_t*)(ws + WS_XB); bf16_t* kvb = (bf16_t*)(ws + WS_KVB); bf16_t* kn = (bf16_t*)(ws + WS_KN); bf16_t* vT = (bf16_t*)(ws + WS_VT); \
  float* halo = (float*)(ws + WS_HALO); \
  bf16_t* gbuf = (bf16_t*)(ws + WS_R); bf16_t* zbuf = (bf16_t*)(ws + WS_R); bf16_t* cat = (bf16_t*)(ws + WS_CAT); bf16_t* qbuf = (bf16_t*)(ws + WS_Q); \
  const float* x_in = (ap)->in[0]; float* xo = (ap)->out; \
  (void)rsA; (void)rsB; (void)rsV; (void)rsQ; (void)rsKV; (void)rsM; (void)cs; (void)memb; (void)memk; (void)memvt; (void)xb; (void)kvb; (void)kn; (void)vT; (void)halo; (void)gbuf; (void)zbuf; (void)cat; (void)qbuf; (void)x_in; (void)xo;
__global__ void __launch_bounds__(512, 2) yoco_fwd(Args a) {
  extern __shared__ __attribute__((aligned(16))) unsigned char lds_raw[];
  LAS unsigned char* lds = (LAS unsigned char*)lds_raw;
  cg::grid_group grid = cg::this_grid();
  volatile LAS unsigned* xst = (volatile LAS unsigned*)(lds + 131072 + 64);
  if (threadIdx.x < 4) xst[threadIdx.x] = 0u;
  __syncthreads();
#define DERIVE_IDS \
  int tid_o = threadIdx.x; asm volatile("" : "+v"(tid_o)); \
  const int tid = tid_o, lane = tid & 63, wave = __builtin_amdgcn_readfirstlane(tid >> 6); \
  const int G = gridDim.x, bx = blockIdx.x; \
  const int vcu = (G % 8 == 0) ? (bx % 8) * (G / 8) + bx / 8 : bx; \
  const int gw = vcu * 8 + wave, NGW = G * 8; \
  const size_t gtid = (size_t)bx * 512 + tid, NGT = (size_t)G * 512; \
  (void)lane; (void)wave; (void)vcu; (void)gw; (void)NGW; (void)gtid; (void)NGT;
  {
    const Args* ap = &a; DERIVE_PTRS(ap)
    DERIVE_IDS
    LAS float* scr = (LAS float*)(lds + wave * 8448);
    for (int it = gw; it < a.nitems; it += NGW) {
      int di = 0;
#pragma unroll 1
      for (int j = 1; j < NWD; ++j) if (it >= a.wd[j].item0) di = j;
      const float* src = a.wd[di].src; const float* scale = a.wd[di].scale; bf16_t* dst = a.wd[di].dst;
      const int K = a.wd[di].K, Ns = a.wd[di].Ns, Nd = a.wd[di].Nd, kind = a.wd[di].kind, item = it - a.wd[di].item0;
      const int nblk = Nd / 32, kb = item / nblk, nb = item - kb * nblk, k0 = 64 * kb, n0 = 32 * nb;
      const int sc = srccol(kind, n0 + (lane & 31));
      float wv[32];
      { const float* sp = src + (size_t)(k0 + (lane >> 5)) * Ns + (sc >= 0 ? sc : 0);
#pragma unroll
        for (int i = 0; i < 32; ++i) wv[i] = sp[(size_t)(2 * i) * Ns]; }
      if (scale) {
#pragma unroll
        for (int i = 0; i < 32; ++i) wv[i] *= scale[k0 + 2 * i + (lane >> 5)];
      }
#pragma unroll
      for (int i = 0; i < 32; ++i) scr[(2 * i + (lane >> 5)) * 33 + (lane & 31)] = (sc >= 0) ? wv[i] : 0.f;
      asm volatile("s_waitcnt lgkmcnt(0)" ::: "memory");
      const int c = lane & 7;
#pragma unroll
      for (int j = 0; j < 4; ++j) { const int n = (lane >> 3) + 8 * j; const LAS float* s = scr + (8 * c) * 33 + n;
        u32x4 o; o.x = cvt_pk_bf16(s[0 * 33], s[1 * 33]); o.y = cvt_pk_bf16(s[2 * 33], s[3 * 33]); o.z = cvt_pk_bf16(s[4 * 33], s[5 * 33]); o.w = cvt_pk_bf16(s[6 * 33], s[7 * 33]);
        *(u32x4*)(dst + (size_t)(n0 + n) * K + k0 + 8 * c) = o; }
      asm volatile("s_waitcnt lgkmcnt(0)" ::: "memory");
    }
    for (int r = gw; r < MTOK + MMEM; r += NGW) {
      const bool ism = r >= MTOK; const int rr = ism ? r - MTOK : r;
      const f32x4* xr = (const f32x4*)((ism ? a.in[1] : x_in) + (size_t)rr * DM) + lane;
      u32x2* o8 = (u32x2*)((ism ? memb : xb) + (size_t)rr * DM) + lane;
      float s = 0.f;
#pragma unroll
      for (int j = 0; j < 8; ++j) { const f32x4 v = xr[64 * j]; s += (v[0] * v[0] + v[1] * v[1]) + (v[2] * v[2] + v[3] * v[3]); u32x2 w; w.x = cvt_pk_bf16(v[0], v[1]); w.y = cvt_pk_bf16(v[2], v[3]); o8[64 * j] = w; }
      s = wave_sum(s);
      if (lane == 0) (ism ? rsM : rsA)[rr] = s;
    }
    const int* pos = (const int*)a.in[2];
    for (size_t i = gtid; i < (size_t)MTOK * 32; i += NGT) {
      const int row = (int)(i >> 5), j = (int)(i & 31);
      const float inv = 1.0f / powf(10000.0f, (float)(2 * j) / 64.0f);
      const float ang = (float)pos[row] * inv;
      const double rev = (double)ang * 0.15915494309189535;
      const float fr = (float)(rev - floor(rev));
      cs[i] = (f32x2){__builtin_amdgcn_cosf(fr), __builtin_amdgcn_sinf(fr)};
    }
    for (size_t i = gtid; i < (size_t)MTOK * 4; i += NGT) rsB[i] = 0.f;
    if (bx == 0) for (int i = tid; i < XCD_BAR_WORDS; i += 512) ((unsigned*)ws)[i] = 0u;
  }
  grid.sync();
  const XcdBarrier xbar = xcd_barrier_post((unsigned*)a.ws, xst);

  pg8::StaticOrder S;
#pragma unroll 1
  for (int l = -1; l < 4; ++l) {
    const bool isA = l < 2; const int j = l - 2;
#pragma unroll 1
    for (int s = 0; s < 10; ++s) {
      CArgs* ap = (CArgs*)__builtin_amdgcn_kernarg_segment_ptr(); asm volatile("" : "+s"(ap));
      DERIVE_PTRS(ap)
      DERIVE_IDS
      int type = 0; bool sync = false;
      pg8::Gemm g{nullptr, nullptr, 0, 0, 0, 0, 0}; int corder = bx;
      EpiG eg{nullptr, 0, nullptr, 0.f, nullptr, 0.f, 0, 0, 0, nullptr, 0, nullptr, 1 << 30, 1.f};
      EpiRes er{nullptr, nullptr, xb, nullptr};
      if (l < 0) {
        if (s < 8) {
          const int ml = s >> 1; const bf16_t* wt = ap->wd[9 + ml].dst;
          type = 1; corder = (bx + 16 * s) % G; sync = (s == 7);
          if (!(s & 1)) { g = pg8::Gemm{memb, wt, MMEM, 512, DM, DM, DM}; eg.O = memk + (size_t)ml * MMEM * 512; eg.ldc = 512; eg.rss = rsM; eg.rinvD = 1.0f / DM; }
          else { g = pg8::Gemm{wt + (size_t)512 * DM, memb, 512, MMEM, DM, DM, DM}; eg.O = memvt + (size_t)ml * 512 * MMEM; eg.ldc = MMEM; eg.css = rsM; eg.cinvD = 1.0f / DM; }
        }
      } else {
        switch (s) {
          case 0: if (l == 2) { type = 1; sync = true;
              g = pg8::Gemm{xb, ap->wd[4].dst, MTOK, KVW, DM, DM, DM};
              eg.O = kvb; eg.ldc = KVW; eg.rss = rsA; eg.rinvD = 1.0f / DM; eg.ss_lo = 0; eg.ss_hi = 512; eg.ssacc = rsKV; eg.rope_mode = 2; eg.cs = cs; } break;
          case 1: type = 1; eg.O = zbuf; eg.rss = rsA; eg.rinvD = 1.0f / DM; eg.sc_val = SC_MEM;
            if (isA) { sync = true; g = pg8::Gemm{xb, ap->wd[l].dst, MTOK, ZA_W, DM, DM, DM}; eg.ldc = ZA_W; eg.gelu_hi = 2 * GW; eg.ss_lo = GW; eg.ss_hi = 2 * GW; eg.ssacc = rsV; eg.sc_lo = 2 * GW; }
            else { g = pg8::Gemm{xb, ap->wd[2 + j].dst, MTOK, ZB_W, DM, DM, DM}; eg.ldc = ZB_W; eg.ss_lo = 0; eg.ss_hi = 512; eg.ssacc = rsQ; eg.sc_lo = 512; }
            break;
          case 2: if (!isA) { type = 1; g = pg8::Gemm{kvb, ap->wd[5 + j].dst, MTOK, GW, 512, KVW, 512}; eg.O = kn; eg.ldc = GW; eg.rss = rsKV; eg.rinvD = 1.0f / 512; } break;
          case 3: if (!isA) { type = 1; sync = true; g = pg8::Gemm{ap->wd[7 + j].dst, kvb, GW, MTOK, 512, 512, KVW}; eg.O = vT; eg.ldc = MTOK; eg.css = rsKV; eg.cinvD = 1.0f / 512; } break;
          case 4: if (!isA) { type = 1; sync = true; g = pg8::Gemm{zbuf, ap->wd[13 + j].dst, MTOK, QW, 512, ZB_W, 512};
              eg.O = qbuf; eg.ldc = QW; eg.rss = rsQ; eg.rinvD = 1.0f / 512; eg.rope_mode = 1; eg.cs = cs; eg.sc_lo = 0; eg.sc_val = SC_MLA; } break;
          case 5: type = 4; sync = true; break;
          case 6: type = 2; sync = true; g = pg8::Gemm{cat, ap->wd[15 + l].dst, MTOK, DM, DM, DM, DM}; er.xold = (l == 0) ? x_in : xo; er.xnew = xo; er.ssacc = rsB; break;
          case 7: type = 3; sync = true; g = pg8::Gemm{xb, ap->wd[19 + l].dst, MTOK, DFF2, DM, DM, DM}; break;
          case 8: type = 5; sync = true; break;
          case 9: type = 2; sync = true; g = pg8::Gemm{gbuf, ap->wd[23 + l].dst, MTOK, DM, DFF, DFF, DFF}; er.xold = xo; er.xnew = xo; er.ssacc = rsA; break;
        }
      }
      if (type == 1 && EN(1)) { S.init(g.M, g.N, G, corder); pg8::gemm_phase<EpiG>(lds, g, S, eg); }
      else if (type == 2 && EN(2)) {
        S.init(g.M, g.N, G, corder); pg8::gemm_phase<EpiRes>(lds, g, S, er);
        if (s == 6) for (size_t i = gtid; i < (size_t)MTOK; i += NGT) { rsA[i] = 0.f; rsV[i] = 0.f; rsQ[i] = 0.f; }
      }
      else if (type == 3 && EN(3)) {
        S.init(g.M, g.N, G, corder);
        EpiUp E{gbuf, halo, rsB, ap->in[22] + (size_t)l * 3 * DFF2, ap->in[23] + (size_t)l * DFF2, lds + 131072 + 1024};
        pg8::gemm_phase<EpiUp>(lds, g, S, E);
      }
      else if (type == 4 && (EN(4) || EN(6) || EN(7))) {
        if (isA && EN(4)) {
          const float* wsp = ap->in[8] + (size_t)l * 12 * 128 * 128; const float* bsp = ap->in[9] + (size_t)l * 12 * 128; const float* gv = ap->in[7] + (size_t)l * GW;
          LAS unsigned char* Wl = lds; LAS unsigned char* Vt = lds + 128 * 272;
          const int r32 = lane & 31, hi = lane >> 5, tb = wave & 3, chh = wave >> 2;
          for (int uidx = vcu; uidx < NB * 32 * 12; uidx += G) {
            const int gi = uidx % 12, bn = uidx / 12, tok0 = bn * 128;
#pragma unroll
            for (int i = 0; i < 8; ++i) { const int idx = tid + i * 512, t = idx >> 5, s4 = (idx & 31) * 4;
              f32x4 w = *(const f32x4*)(wsp + ((size_t)gi * 128 + t) * 128 + s4);
              const f32x4 q = *(const f32x4*)(rsV + tok0 + s4);
#pragma unroll
              for (int e = 0; e < 4; ++e) w[e] = (s4 + e <= t) ? w[e] * __builtin_amdgcn_rsqf(q[e] * (1.0f / GW) + EPS) : 0.f;
              *(LAS u32x2*)(Wl + t * 272 + s4 * 2) = (u32x2){cvt_pk_bf16(w[0], w[1]), cvt_pk_bf16(w[2], w[3])}; }
#pragma unroll
            for (int i = 0; i < 4; ++i) { const int idx = tid + i * 512, sr = idx >> 4, c8 = (idx & 15) * 8;
              const u32x4 v = *(const u32x4*)(zbuf + (size_t)(tok0 + sr) * ZA_W + GW + gi * 128 + c8);
              const unsigned vv[4] = {v.x, v.y, v.z, v.w};
#pragma unroll
              for (int e = 0; e < 4; ++e) { *(LAS unsigned short*)(Vt + (c8 + 2 * e) * 272 + sr * 2) = (unsigned short)(vv[e] & 0xffffu); *(LAS unsigned short*)(Vt + (c8 + 2 * e + 1) * 272 + sr * 2) = (unsigned short)(vv[e] >> 16); } }
            __syncthreads();
            f32x16 acc2[2];
#pragma unroll
            for (int cb = 0; cb < 2; ++cb)
#pragma unroll
              for (int i = 0; i < 16; ++i) acc2[cb][i] = 0.f;
            const int nks = 2 * (tb + 1);
            for (int ks = 0; ks < nks; ++ks) {
              const bf16x8 wf = *(const LAS bf16x8*)(Wl + (32 * tb + r32) * 272 + ks * 32 + hi * 16);
#pragma unroll
              for (int cb = 0; cb < 2; ++cb) {
                const bf16x8 vf = *(const LAS bf16x8*)(Vt + (64 * chh + 32 * cb + r32) * 272 + ks * 32 + hi * 16);
                acc2[cb] = __builtin_amdgcn_mfma_f32_32x32x16_bf16(vf, wf, acc2[cb], 0, 0, 0);
              }
            }
            const int t = 32 * tb + r32; const float bt = bsp[gi * 128 + t];
            const size_t rowoff = (size_t)(tok0 + t);
#pragma unroll
            for (int cb = 0; cb < 2; ++cb)
#pragma unroll
              for (int ig = 0; ig < 4; ++ig) {
                const int c = gi * 128 + 64 * chh + 32 * cb + 8 * ig + 4 * hi;
                const f32x4 gg = *(const f32x4*)(gv + c);
                const u32x2 uu = *(const u32x2*)(zbuf + rowoff * ZA_W + c);
                const float u0 = __uint_as_float(uu.x << 16), u1 = __uint_as_float(uu.x & 0xffff0000u), u2 = __uint_as_float(uu.y << 16), u3 = __uint_as_float(uu.y & 0xffff0000u);
                const float o0 = u0 * (acc2[cb][4 * ig] * gg[0] + bt), o1 = u1 * (acc2[cb][4 * ig + 1] * gg[1] + bt), o2 = u2 * (acc2[cb][4 * ig + 2] * gg[2] + bt), o3 = u3 * (acc2[cb][4 * ig + 3] * gg[3] + bt);
                *(u32x2*)(cat + rowoff * DM + c) = (u32x2){cvt_pk_bf16(o0, o1), cvt_pk_bf16(o2, o3)};
              }
            __syncthreads();
          }
        } else if (!isA && EN(6)) {
          for (int p = 6 * vcu; p < 1536; p += 6 * G)
#pragma unroll 1
            for (int uu = p; uu < p + 6 && uu < 1536; ++uu) {
              const int pp = uu >> 1, half = uu & 1, bh = pp >> 3, i8 = pp & 7, b = bh / 12, h = bh - b * 12;
              const int qblk = half ? i8 : 15 - i8; const size_t row0 = (size_t)b * SEQ + qblk * 256;
              attn_unit<192, true>(lds, qbuf + row0 * QW + h * 192, QW, kn + (size_t)b * SEQ * GW + h * 128, GW, kvb + (size_t)b * SEQ * KVW + 512, KVW,
                                   vT + (size_t)(h * 128) * MTOK + (size_t)b * SEQ, MTOK, (qblk + 1) * 4, qblk * 256, cat + row0 * DM + h * 128, DM);
            }
        }
        if (EN(7)) {
          const bf16_t* qm = zbuf + (isA ? 2 * GW : 512); const int ldq = isA ? ZA_W : ZB_W;
#pragma unroll 1
          for (int uidx = vcu; uidx < NB * 4 * 16; uidx += G) {
            const int qblk = uidx & 15, bh = uidx >> 4, b = bh >> 2, h = bh & 3; const size_t row0 = (size_t)b * SEQ + qblk * 256;
            attn_unit<128, false>(lds, qm + row0 * ldq + h * 128, ldq, memk + (size_t)l * MMEM * 512 + (size_t)b * NMEM * 512 + h * 128, 512, nullptr, 0,
                                  memvt + (size_t)l * 512 * MMEM + (size_t)(h * 128) * MMEM + b * NMEM, MMEM, 4, 0, cat + row0 * DM + GW + h * 128, DM);
          }
        }
        for (size_t i = gtid; i < (size_t)MTOK; i += NGT) rsB[i] = 0.f;
      }
      else if (type == 5 && EN(5)) {
        const float* cw = ap->in[22] + (size_t)l * 3 * DFF2; const float* cb = ap->in[23] + (size_t)l * DFF2;
        for (size_t idx = gtid; idx < (size_t)1024 * (DFF / 4); idx += NGT) {
          const int rowi = (int)(idx / (DFF / 4)), c4 = (int)(idx % (DFF / 4)) * 4, blk = rowi >> 1, rr = rowi & 1;
          const bool hp = (blk & 63) != 0;
          const float* H0 = halo + (size_t)blk * 4 * DFF2; const float* Hp = H0 - (size_t)4 * DFF2;
          f32x4 cv[2];
#pragma unroll
          for (int part = 0; part < 2; ++part) {
            const int off = part * DFF + c4; const f32x4 z4 = (f32x4){0.f, 0.f, 0.f, 0.f};
            const f32x4 a0 = *(const f32x4*)(H0 + (size_t)rr * DFF2 + off);
            const f32x4 p3 = hp ? *(const f32x4*)(Hp + (size_t)3 * DFF2 + off) : z4;
            const f32x4 a1 = rr ? *(const f32x4*)(H0 + off) : p3;
            const f32x4 a2 = rr ? p3 : (hp ? *(const f32x4*)(Hp + (size_t)2 * DFF2 + off) : z4);
            cv[part] = *(const f32x4*)(cw + 2 * DFF2 + off) * a0 + *(const f32x4*)(cw + DFF2 + off) * a1 + *(const f32x4*)(cw + off) * a2 + *(const f32x4*)(cb + off);
          }
          u32x2 w; w.x = cvt_pk_bf16(silu1(cv[0][0]) * cv[1][0], silu1(cv[0][1]) * cv[1][1]); w.y = cvt_pk_bf16(silu1(cv[0][2]) * cv[1][2], silu1(cv[0][3]) * cv[1][3]);
          *(u32x2*)(gbuf + (size_t)(blk * 64 + rr) * DFF + c4) = w;
        }
      }
      if (sync) xcd_barrier(xbar);
    }
  }
  {
    const Args* ap = &a; DERIVE_PTRS(ap)
    DERIVE_IDS
    const float* gf = a.in[5];
    for (size_t i = gtid; i < (size_t)MTOK * (DM / 4); i += NGT) {
      const int row = (int)(i / (DM / 4)), c4 = (int)(i % (DM / 4)) * 4;
      const float r = __builtin_amdgcn_rsqf(rsA[row] * (1.0f / DM) + EPS);
      f32x4* p = (f32x4*)(xo + (size_t)row * DM + c4);
      *p = *p * r * *(const f32x4*)(gf + c4);
    }
  }
}

extern "C" void kernel_launch(void* const* d_in, const int* in_sizes, int n_in, void* d_out, int out_size, void* d_ws, size_t ws_size, hipStream_t stream) {
  static int grid_blocks = 0;
  if (!grid_blocks) {
    int dev = 0, cus = 0, per_cu = 0;
    (void)hipGetDevice(&dev);
    (void)hipDeviceGetAttribute(&cus, hipDeviceAttributeMultiprocessorCount, dev);
    (void)hipFuncSetAttribute((const void*)yoco_fwd, hipFuncAttributeMaxDynamicSharedMemorySize, LDS_BYTES);
    (void)hipOccupancyMaxActiveBlocksPerMultiprocessor(&per_cu, (const void*)yoco_fwd, 512, LDS_BYTES);
    if (per_cu < 1) per_cu = 1;
    grid_blocks = cus * per_cu;
    if (ws_size < WS_END) fprintf(stderr, "kernel_launch: workspace too small: %zu < %zu\n", ws_size, (size_t)WS_END);
  }
  Args a; memset(&a, 0, sizeof(a));
  for (int i = 0; i < 25; ++i) a.in[i] = (const float*)d_in[i];
  a.out = (float*)d_out; a.ws = (unsigned char*)d_ws;
  const float* const* in = a.in;
  bf16_t* wp = (bf16_t*)((unsigned char*)d_ws + WS_W);
  int nd = 0, items = 0;
  auto add = [&](const float* src, const float* scale, int K, int Ns, int Nd, int kind) {
    WDesc& d = a.wd[nd++]; d.src = src; d.scale = scale; d.dst = wp; d.K = K; d.Ns = Ns; d.Nd = Nd; d.kind = kind; d.item0 = items; d.pad = 0;
    items += (K / 64) * (Nd / 32); wp += (size_t)K * Nd;
  };
  for (int l = 0; l < 2; ++l) add(in[6] + (size_t)l * DM * ZA_W, in[3] + (size_t)l * DM, DM, ZA_W, ZA_W, 0);
  for (int j = 0; j < 2; ++j) add(in[13] + (size_t)j * DM * ZB_W, in[3] + (size_t)(2 + j) * DM, DM, ZB_W, ZB_W, 0);
  add(in[11], in[10], DM, 576, KVW, 1);
  for (int j = 0; j < 2; ++j) add(in[16] + (size_t)j * 512 * GW, in[12], 512, GW, GW, 0);
  for (int j = 0; j < 2; ++j) add(in[17] + (size_t)j * 512 * GW, in[12], 512, GW, GW, 0);
  for (int l = 0; l < 4; ++l) add(in[19] + (size_t)l * DM * 1024, in[18] + (size_t)l * DM, DM, 1024, 1024, 0);
  for (int j = 0; j < 2; ++j) add(in[15] + (size_t)j * 512 * QW, in[14] + (size_t)j * 512, 512, QW, QW, 2);
  for (int l = 0; l < 4; ++l) add(in[20] + (size_t)l * DM * DM, nullptr, DM, DM, DM, 0);
  for (int l = 0; l < 4; ++l) add(in[21] + (size_t)l * DM * DFF2, in[4] + (size_t)l * DM, DM, DFF2, DFF2, 3);
  for (int l = 0; l < 4; ++l) add(in[24] + (size_t)l * DFF * DM, nullptr, DFF, DM, DM, 0);
  a.nitems = items;
  void* args[] = {&a};
  hipError_t e = hipLaunchCooperativeKernel((const void*)yoco_fwd, dim3(grid_blocks), dim3(512), args, LDS_BYTES, stream);
  if (e != hipSuccess) fprintf(stderr, "cooperative launch failed: %s (grid %d)\n", hipGetErrorString(e), grid_blocks);
}
```

```cpp
#include <hip/hip_runtime.h>
#include <hip/hip_cooperative_groups.h>
#include <cstdio>
#include <cstring>
namespace cg = cooperative_groups;

#define LAS __attribute__((address_space(3)))
typedef unsigned short bf16_t;
typedef short bf16x8 __attribute__((ext_vector_type(8)));
typedef short s16x4 __attribute__((ext_vector_type(4)));
typedef float f32x4 __attribute__((ext_vector_type(4)));
typedef float f32x2 __attribute__((ext_vector_type(2)));
typedef float f32x16 __attribute__((ext_vector_type(16)));
typedef unsigned u32x4 __attribute__((ext_vector_type(4)));
typedef unsigned u32x2 __attribute__((ext_vector_type(2)));

constexpr int DM = 2048, NB = 8, SEQ = 4096, MTOK = NB * SEQ, NMEM = 256, MMEM = NB * NMEM;
constexpr int GW = 1536, ZA_W = 3584, ZB_W = 1024, QW = 2304, KVW = 768, DFF = 5632, DFF2 = 11264;
constexpr float EPS = 1e-6f;
constexpr float LOG2E = 1.4426950408889634f;
constexpr float SC_MEM = 0.08838834764831845f * LOG2E;
constexpr float SC_MLA = 0.07216878364870323f * LOG2E;

constexpr size_t MiB = 1u << 20;
constexpr size_t WS_RS = 1 * MiB;
constexpr size_t WS_CS = 2 * MiB;
constexpr size_t WS_MEMB = 10 * MiB;
constexpr size_t WS_MEMK = 18 * MiB;
constexpr size_t WS_MEMVT = 26 * MiB;
constexpr size_t WS_W = 34 * MiB;
constexpr size_t WS_XB = 396 * MiB;
constexpr size_t WS_KVB = 524 * MiB;
constexpr size_t WS_KN = 572 * MiB;
constexpr size_t WS_VT = 668 * MiB;
constexpr size_t WS_HALO = 764 * MiB;
constexpr size_t WS_R = 852 * MiB;
constexpr size_t WS_CAT = WS_R + 224 * MiB;
constexpr size_t WS_Q = WS_R + 64 * MiB;
constexpr size_t WS_END = 1204 * MiB;

typedef __bf16 bf16x2_t __attribute__((ext_vector_type(2)));
__device__ __forceinline__ unsigned cvt_pk_bf16(float lo, float hi) { const f32x2 v = {lo, hi}; const bf16x2_t b = __builtin_convertvector(v, bf16x2_t); return __builtin_bit_cast(unsigned, b); }
__device__ __forceinline__ float wave_sum(float v) {
#pragma unroll
  for (int o = 1; o < 64; o <<= 1) v += __shfl_xor(v, o);
  return v;
}
__device__ __forceinline__ f32x2 gelu_pk(f32x2 v) {
  const f32x2 av = __builtin_elementwise_abs(v), d = av * 0.2316418882f + 1.0f;
  f32x2 t; t.x = __builtin_amdgcn_rcpf(d.x); t.y = __builtin_amdgcn_rcpf(d.y);
  f32x2 q = t * 0.5307027145f + (-0.7265760135f); q = q * t + 0.7107068705f; q = q * t + (-0.142248368f); q = q * t + 0.127414796f; q = q * t;
  const f32x2 s = (v * v) * (-0.72134752044f);
  f32x2 e; e.x = __builtin_amdgcn_exp2f(s.x); e.y = __builtin_amdgcn_exp2f(s.y);
  const f32x2 m = v * (q * e), r = v - m;
  f32x2 o; o.x = v.x < 0.f ? m.x : r.x; o.y = v.y < 0.f ? m.y : r.y; return o;
}
__device__ __forceinline__ f32x4 gelu4(f32x4 v) { f32x2 a = gelu_pk((f32x2){v[0], v[1]}), b = gelu_pk((f32x2){v[2], v[3]}); return (f32x4){a.x, a.y, b.x, b.y}; }
__device__ __forceinline__ float silu1(float x) { return x * __builtin_amdgcn_rcpf(1.0f + __builtin_amdgcn_exp2f(-x * LOG2E)); }
__device__ __forceinline__ float ror1(float v) { return __builtin_bit_cast(float, __builtin_amdgcn_update_dpp(0, __builtin_bit_cast(int, v), 0x121, 0xf, 0xf, true)); }
__device__ __forceinline__ float ror2(float v) { return __builtin_bit_cast(float, __builtin_amdgcn_update_dpp(0, __builtin_bit_cast(int, v), 0x122, 0xf, 0xf, true)); }
__device__ __forceinline__ float shr1o(float old, float v) { return __builtin_bit_cast(float, __builtin_amdgcn_update_dpp(__builtin_bit_cast(int, old), __builtin_bit_cast(int, v), 0x111, 0xf, 0xf, false)); }
__device__ __forceinline__ float shr2o(float old, float v) { return __builtin_bit_cast(float, __builtin_amdgcn_update_dpp(__builtin_bit_cast(int, old), __builtin_bit_cast(int, v), 0x112, 0xf, 0xf, false)); }
__device__ __forceinline__ f32x4 shr1ov(f32x4 o, f32x4 v) { return (f32x4){shr1o(o[0], v[0]), shr1o(o[1], v[1]), shr1o(o[2], v[2]), shr1o(o[3], v[3])}; }
__device__ __forceinline__ f32x4 shr2ov(f32x4 o, f32x4 v) { return (f32x4){shr2o(o[0], v[0]), shr2o(o[1], v[1]), shr2o(o[2], v[2]), shr2o(o[3], v[3])}; }
__device__ __forceinline__ f32x4 ror1v(f32x4 v) { return (f32x4){ror1(v[0]), ror1(v[1]), ror1(v[2]), ror1(v[3])}; }
__device__ __forceinline__ f32x4 ror2v(f32x4 v) { return (f32x4){ror2(v[0]), ror2(v[1]), ror2(v[2]), ror2(v[3])}; }

namespace pg8 {
constexpr int BM = 256, BK = 64, HALF = 128, HTB = HALF * BK * 2, STAGE_BYTES = 8 * HTB, NXCD = 8, WGM = 8;
__device__ __forceinline__ int lds_byte(int r, int c) { const int st = (r >> 4) * 2 + (c >> 5), rr = r & 15, cc = c & 31, ob = rr * 64 + cc * 2; return st * 1024 + (ob ^ (((ob >> 9) & 1) << 5)); }
__device__ __forceinline__ void stage_rc(int b, int& R, int& C) { const int st = b / 1024, sb = b % 1024, swz = sb ^ (((sb >> 9) & 1) << 5); R = (st >> 1) * 16 + swz / 64; C = (st & 1) * 32 + (swz % 64) / 2; }
__device__ __forceinline__ int perm32(int rho) { const int n = rho >> 4, i = rho & 15; return 8 * (i >> 2) + 4 * n + (i & 3); }
struct Unit { int pm, pn; };
struct Gemm { const bf16_t* A; const bf16_t* Bt; int M, N, K, lda, ldb; };
struct StaticOrder {
  int nM, nN, nwg, G, c;
  __device__ void init(int M, int N, int G_, int c_) { nM = M / BM; nN = N / BM; nwg = nM * nN; G = G_; c = c_; }
  __device__ bool next(int i, Unit& u) const {
    const long L = (long)i * G + c; if (L >= nwg) return false;
    int wgid = (int)L; { const int q = nwg / NXCD, r = nwg % NXCD, xcd = wgid % NXCD, off = wgid / NXCD; wgid = (xcd < r ? xcd * (q + 1) : r * (q + 1) + (xcd - r) * q) + off; }
    const int nig = WGM * nN, gid = wgid / nig, fm = gid * WGM, gsz = (nM - fm) < WGM ? (nM - fm) : WGM;
    u.pm = fm + ((wgid % nig) % gsz); u.pn = (wgid % nig) / gsz; return true;
  }
};

#ifndef PG8_SP2
#define PG8_SP2 true
#endif
#ifndef PG8_ALIGN
#define PG8_ALIGN true
#endif
template <class Epi, bool SP2 = PG8_SP2, bool ALIGN_EPI = PG8_ALIGN>
__device__ __forceinline__ void gemm_phase(LAS unsigned char* lds, const Gemm g, const StaticOrder& S, const Epi& E) {
  int tid_o = threadIdx.x; asm volatile("" : "+v"(tid_o));
  const int tid = tid_o, wid = __builtin_amdgcn_readfirstlane(tid >> 6), lane = tid & 63, wr = wid >> 2, wc = wid & 3, fr = lane & 15, fq = lane >> 4;
  const int K = g.K, nt = K / BK;
  unsigned voffA[2], voffB[2];
#pragma unroll
  for (int i = 0; i < 2; ++i) { int R, C; stage_rc(tid * 16 + i * 8192, R, C); const int Rb = Epi::PERM ? ((R & ~31) + perm32(R & 31)) : R;
    voffA[i] = (unsigned)(R * g.lda + C) * 2u; voffB[i] = (unsigned)(Rb * g.ldb + C) * 2u; }
  const size_t kstep = (size_t)(BK * 2);
  const size_t hstepA = (size_t)HALF * g.lda * 2, hstepB = (size_t)HALF * g.ldb * 2;
  const size_t tstepA = 2 * hstepA, tstepB = 2 * hstepB;
  const unsigned ldsw = (unsigned)wid * 1024u;
  const int aoff = lds_byte(wr * 64 + fr, fq * 8), boff = lds_byte(wc * 32 + fr, fq * 8);
#define PG8_SA(b, h) (((b) * 2 + (h)) * HTB)
#define PG8_SB(b, h) ((4 + (b) * 2 + (h)) * HTB)
#define PG8_STAGE(bufoff, gbase, voff) do { _Pragma("unroll") for (int _i = 0; _i < 2; ++_i) \
    __builtin_amdgcn_global_load_lds((const unsigned*)((const char*)(gbase) + (voff)[_i]), (LAS unsigned*)(lds + (bufoff) + ldsw + _i * 8192), 16, 0, 0); } while (0)
#define PG8_LDA(dst, b, h) do { _Pragma("unroll") for (int m = 0; m < 4; ++m) _Pragma("unroll") for (int k = 0; k < 2; ++k) dst[m][k] = *(const LAS bf16x8*)(lds + PG8_SA(b, h) + aoff + m * 2048 + k * 1024); } while (0)
#define PG8_LDB(dst, b, h) do { _Pragma("unroll") for (int n = 0; n < 2; ++n) _Pragma("unroll") for (int k = 0; k < 2; ++k) dst[n][k] = *(const LAS bf16x8*)(lds + PG8_SB(b, h) + boff + n * 2048 + k * 1024); } while (0)
#define PG8_MMA(ai, bj, At, Bt) do { __builtin_amdgcn_s_setprio(1); _Pragma("unroll") for (int m = 0; m < 4; ++m) _Pragma("unroll") for (int n = 0; n < 2; ++n) _Pragma("unroll") for (int k = 0; k < 2; ++k) \
    acc[ai][bj][m][n] = __builtin_amdgcn_mfma_f32_16x16x32_bf16(Bt[n][k], At[m][k], acc[ai][bj][m][n], 0, 0, 0); __builtin_amdgcn_s_setprio(0); } while (0)
#define PG8_WAIT_V(n) asm volatile("s_waitcnt vmcnt(" #n ")" ::: "memory")
#define PG8_WAIT_L(n) asm volatile("s_waitcnt lgkmcnt(" #n ")" ::: "memory")
#define PG8_BAR __builtin_amdgcn_s_barrier()
#define PG8_SCHED __builtin_amdgcn_sched_barrier(0)
  Unit cur, nxt; int ui = 0;
  if (!S.next(0, cur)) return;
  f32x4 acc[2][2][4][2];
  if constexpr (Epi::INIT) E.init(acc, cur, wr, wc, fr, fq);
  else {
#pragma unroll
  for (int a = 0; a < 2; ++a)
#pragma unroll
    for (int b = 0; b < 2; ++b)
#pragma unroll
      for (int m = 0; m < 4; ++m)
#pragma unroll
        for (int n = 0; n < 2; ++n) acc[a][b][m][n] = (f32x4){0.f, 0.f, 0.f, 0.f};
  }
  bf16x8 At[4][2], B0[2][2], B1[2][2];
  const char* cA = (const char*)g.A + (size_t)cur.pm * tstepA; const char* cB = (const char*)g.Bt + (size_t)cur.pn * tstepB;
  if constexpr (SP2) {
    PG8_STAGE(PG8_SB(0, 0), cB, voffB); PG8_STAGE(PG8_SB(0, 1), cB + hstepB, voffB); PG8_STAGE(PG8_SA(0, 0), cA, voffA); PG8_STAGE(PG8_SA(0, 1), cA + hstepA, voffA);
    if (wr == 1) PG8_BAR;
    PG8_WAIT_V(2); PG8_BAR;
    PG8_STAGE(PG8_SB(1, 0), cB + kstep, voffB); PG8_STAGE(PG8_SA(1, 0), cA + kstep, voffA); PG8_STAGE(PG8_SB(1, 1), cB + hstepB + kstep, voffB);
    PG8_WAIT_V(6); PG8_BAR;
  } else {
  PG8_STAGE(PG8_SB(0, 0), cB, voffB); PG8_STAGE(PG8_SA(0, 0), cA, voffA); PG8_STAGE(PG8_SB(0, 1), cB + hstepB, voffB); PG8_STAGE(PG8_SA(0, 1), cA + hstepA, voffA);
  if (wr == 1) PG8_BAR;
  PG8_WAIT_V(4); PG8_BAR;
  PG8_STAGE(PG8_SB(1, 0), cB + kstep, voffB); PG8_STAGE(PG8_SA(1, 0), cA + kstep, voffA); PG8_STAGE(PG8_SB(1, 1), cB + hstepB + kstep, voffB);
  PG8_WAIT_V(6); PG8_BAR;
  }
  for (;;) {
    const bool has_next = S.next(ui + 1, nxt);
    const char* nA = has_next ? (const char*)g.A + (size_t)nxt.pm * tstepA : cA; const char* nB = has_next ? (const char*)g.Bt + (size_t)nxt.pn * tstepB : cB;
    for (int t = 0; t < nt; t += 2) {
      const bool last = (t == nt - 2);
      const char* a1 = cA + (size_t)(t + 1) * kstep;
      const char* a2 = last ? nA : cA + (size_t)(t + 2) * kstep; const char* b2 = last ? nB : cB + (size_t)(t + 2) * kstep;
      const char* a3 = a2 + kstep; const char* b3 = b2 + kstep;
      if constexpr (SP2) {
      PG8_LDB(B0, 0, 0); PG8_LDB(B1, 0, 1); PG8_SCHED; PG8_LDA(At, 0, 0); PG8_STAGE(PG8_SA(1, 1), a1 + hstepA, voffA);
      PG8_WAIT_V(8); PG8_WAIT_L(0); PG8_BAR; PG8_MMA(0, 0, At, B0); PG8_MMA(0, 1, At, B1); PG8_BAR; PG8_SCHED;
      PG8_LDA(At, 0, 1); PG8_STAGE(PG8_SB(0, 0), b2, voffB); PG8_STAGE(PG8_SB(0, 1), b2 + hstepB, voffB); PG8_STAGE(PG8_SA(0, 0), a2, voffA);
      PG8_WAIT_V(8); PG8_WAIT_L(0); PG8_BAR; PG8_MMA(1, 0, At, B0); PG8_MMA(1, 1, At, B1); PG8_BAR; PG8_SCHED;
      PG8_LDB(B0, 1, 0); PG8_LDB(B1, 1, 1); PG8_SCHED; PG8_LDA(At, 1, 0); PG8_STAGE(PG8_SA(0, 1), a2 + hstepA, voffA);
      PG8_WAIT_V(8); PG8_WAIT_L(0); PG8_BAR; PG8_MMA(0, 0, At, B0); PG8_MMA(0, 1, At, B1); PG8_BAR; PG8_SCHED;
      PG8_LDA(At, 1, 1); PG8_STAGE(PG8_SB(1, 0), b3, voffB); PG8_STAGE(PG8_SB(1, 1), b3 + hstepB, voffB); PG8_STAGE(PG8_SA(1, 0), a3, voffA);
      PG8_WAIT_V(8); PG8_WAIT_L(0); PG8_BAR; PG8_MMA(1, 0, At, B0); PG8_MMA(1, 1, At, B1); PG8_BAR; PG8_SCHED;
      } else {
      PG8_LDB(B0, 0, 0); PG8_SCHED; PG8_LDA(At, 0, 0); PG8_STAGE(PG8_SA(1, 1), a1 + hstepA, voffA);
      PG8_WAIT_L(8); PG8_BAR; PG8_WAIT_L(0); PG8_MMA(0, 0, At, B0); PG8_BAR; PG8_SCHED;
      PG8_LDB(B1, 0, 1); PG8_STAGE(PG8_SB(0, 0), b2, voffB);
      PG8_BAR; PG8_WAIT_L(0); PG8_MMA(0, 1, At, B1); PG8_BAR;
      PG8_LDA(At, 0, 1); PG8_STAGE(PG8_SA(0, 0), a2, voffA);
      PG8_BAR; PG8_WAIT_L(0); PG8_MMA(1, 0, At, B0); PG8_BAR; PG8_SCHED;
      PG8_STAGE(PG8_SB(0, 1), b2 + hstepB, voffB);
      PG8_WAIT_V(6); PG8_BAR; PG8_MMA(1, 1, At, B1); PG8_BAR;
      PG8_LDB(B0, 1, 0); PG8_SCHED; PG8_LDA(At, 1, 0); PG8_STAGE(PG8_SA(0, 1), a2 + hstepA, voffA);
      PG8_WAIT_L(8); PG8_BAR; PG8_WAIT_L(0); PG8_MMA(0, 0, At, B0); PG8_BAR; PG8_SCHED;
      PG8_LDB(B1, 1, 1); PG8_STAGE(PG8_SB(1, 0), b3, voffB);
      PG8_BAR; PG8_WAIT_L(0); PG8_MMA(0, 1, At, B1); PG8_BAR;
      PG8_LDA(At, 1, 1); PG8_STAGE(PG8_SA(1, 0), a3, voffA);
      PG8_BAR; PG8_WAIT_L(0); PG8_MMA(1, 0, At, B0); PG8_BAR; PG8_SCHED;
      PG8_STAGE(PG8_SB(1, 1), b3 + hstepB, voffB);
      PG8_WAIT_V(6); PG8_BAR; PG8_MMA(1, 1, At, B1); PG8_BAR;
      }
    }
    if constexpr (ALIGN_EPI) { if (wr == 0) PG8_BAR; }
    E(acc, cur, wr, wc, fr, fq);
    if (!has_next) break;
    if constexpr (Epi::INIT) E.init(acc, nxt, wr, wc, fr, fq);
    else {
#pragma unroll
    for (int a = 0; a < 2; ++a)
#pragma unroll
      for (int b = 0; b < 2; ++b)
#pragma unroll
        for (int m = 0; m < 4; ++m)
#pragma unroll
          for (int n = 0; n < 2; ++n) acc[a][b][m][n] = (f32x4){0.f, 0.f, 0.f, 0.f};
    }
    cur = nxt; cA = nA; cB = nB; ++ui;
    if constexpr (ALIGN_EPI) { if (wr == 1) PG8_BAR; }
  }
  PG8_WAIT_V(0);
  if constexpr (!ALIGN_EPI) { if (wr == 0) PG8_BAR; }
  PG8_BAR;
#undef PG8_SA
#undef PG8_SB
#undef PG8_STAGE
#undef PG8_LDA
#undef PG8_LDB
#undef PG8_MMA
#undef PG8_WAIT_V
#undef PG8_WAIT_L
#undef PG8_BAR
#undef PG8_SCHED
}
}
using pg8::Unit; using pg8::HALF;
typedef f32x4 Acc[2][2][4][2];

struct EpiG {
  static constexpr bool PERM = true, INIT = false;
  bf16_t* O; int ldc;
  const float* rss; float rinvD;
  const float* css; float cinvD;
  int gelu_hi;
  int ss_lo, ss_hi; float* ssacc;
  int rope_mode;
  const f32x2* cs;
  int sc_lo; float sc_val;
  __device__ __forceinline__ void operator()(Acc& acc, const Unit& u, int wr, int wc, int fr, int fq) const {
    const int ct = u.pn * 256;
    const bool do_gelu = ct < gelu_hi, do_ss = (ct >= ss_lo && ct < ss_hi), do_sc = ct >= sc_lo;
    float rsv[2][4];
#pragma unroll
    for (int ai = 0; ai < 2; ++ai)
#pragma unroll
      for (int m = 0; m < 4; ++m) rsv[ai][m] = rss ? rss[u.pm * 256 + ai * HALF + wr * 64 + m * 16 + fr] : 1.0f;
    f32x4 cq[2][2];
#pragma unroll
    for (int bj = 0; bj < 2; ++bj) { const int c0 = ct + bj * HALF + wc * 32 + 8 * fq;
      cq[bj][0] = css ? *(const f32x4*)(css + c0) : (f32x4){1.f, 1.f, 1.f, 1.f}; cq[bj][1] = css ? *(const f32x4*)(css + c0 + 4) : (f32x4){1.f, 1.f, 1.f, 1.f}; }
    if (rss) {
#pragma unroll
      for (int ai = 0; ai < 2; ++ai)
#pragma unroll
        for (int m = 0; m < 4; ++m) rsv[ai][m] = __builtin_amdgcn_rsqf(rsv[ai][m] * rinvD + EPS);
    }
    if (css) {
#pragma unroll
      for (int bj = 0; bj < 2; ++bj)
#pragma unroll
        for (int h = 0; h < 2; ++h)
#pragma unroll
          for (int j = 0; j < 4; ++j) cq[bj][h][j] = __builtin_amdgcn_rsqf(cq[bj][h][j] * cinvD + EPS);
    }
#pragma unroll
    for (int ai = 0; ai < 2; ++ai)
#pragma unroll
      for (int m = 0; m < 4; ++m) {
        const int row = u.pm * 256 + ai * HALF + wr * 64 + m * 16 + fr;
        const float rs = rsv[ai][m];
        float ss = 0.f;
#pragma unroll
        for (int bj = 0; bj < 2; ++bj) {
          const int c0 = ct + bj * HALF + wc * 32 + 8 * fq;
          f32x4 v0 = acc[ai][bj][m][0] * rs, v1 = acc[ai][bj][m][1] * rs;
          if (css) { v0 = v0 * cq[bj][0]; v1 = v1 * cq[bj][1]; }
          if (do_gelu) { v0 = gelu4(v0); v1 = gelu4(v1); }
          if (do_ss) ss += (v0[0] * v0[0] + v0[1] * v0[1]) + (v0[2] * v0[2] + v0[3] * v0[3]) + (v1[0] * v1[0] + v1[1] * v1[1]) + (v1[2] * v1[2] + v1[3] * v1[3]);
          int roff = -1;
          if (rope_mode == 1) { const int d = c0 % 192; if (d >= 128) roff = d - 128; }
          else if (rope_mode == 2) { if (c0 >= 512 && c0 < 576) roff = c0 - 512; }
          if (roff >= 0) {
            const f32x2* t = cs + (size_t)row * 32 + (roff >> 1);
            const f32x2 t0 = t[0], t1 = t[1], t2 = t[2], t3 = t[3];
            f32x4 w0, w1;
            w0[0] = v0[0] * t0.x - v0[1] * t0.y; w0[1] = v0[1] * t0.x + v0[0] * t0.y;
            w0[2] = v0[2] * t1.x - v0[3] * t1.y; w0[3] = v0[3] * t1.x + v0[2] * t1.y;
            w1[0] = v1[0] * t2.x - v1[1] * t2.y; w1[1] = v1[1] * t2.x + v1[0] * t2.y;
            w1[2] = v1[2] * t3.x - v1[3] * t3.y; w1[3] = v1[3] * t3.x + v1[2] * t3.y;
            v0 = w0; v1 = w1;
          }
          if (do_sc) { v0 = v0 * sc_val; v1 = v1 * sc_val; }
          u32x4 w; w.x = cvt_pk_bf16(v0[0], v0[1]); w.y = cvt_pk_bf16(v0[2], v0[3]); w.z = cvt_pk_bf16(v1[0], v1[1]); w.w = cvt_pk_bf16(v1[2], v1[3]);
          *(u32x4*)(O + (size_t)row * ldc + c0) = w;
        }
        if (do_ss) { ss += __shfl_xor(ss, 16); ss += __shfl_xor(ss, 32); if (fq == 0) atomicAdd(ssacc + row, ss); }
      }
  }
};

struct EpiRes {
  static constexpr bool PERM = false, INIT = true;
  const float* xold; float* xnew; bf16_t* xb; float* ssacc;
  __device__ __forceinline__ void init(Acc& acc, const Unit& u, int wr, int wc, int fr, int fq) const {
    const int col0 = u.pn * 256 + wc * 32 + 4 * fq;
#pragma unroll
    for (int ai = 0; ai < 2; ++ai)
#pragma unroll
      for (int bj = 0; bj < 2; ++bj)
#pragma unroll
        for (int m = 0; m < 4; ++m)
#pragma unroll
          for (int n = 0; n < 2; ++n) {
            const int row = u.pm * 256 + ai * HALF + wr * 64 + m * 16 + fr;
            acc[ai][bj][m][n] = *(const f32x4*)(xold + (size_t)row * DM + col0 + bj * HALF + n * 16);
          }
  }
  __device__ __forceinline__ void operator()(Acc& acc, const Unit& u, int wr, int wc, int fr, int fq) const {
    const int col0 = u.pn * 256 + wc * 32 + 4 * fq;
#pragma unroll
    for (int ai = 0; ai < 2; ++ai)
#pragma unroll
      for (int m = 0; m < 4; ++m) {
        const int row = u.pm * 256 + ai * HALF + wr * 64 + m * 16 + fr;
        float ss = 0.f;
#pragma unroll
        for (int bj = 0; bj < 2; ++bj)
#pragma unroll
          for (int n = 0; n < 2; ++n) {
            const size_t off = (size_t)row * DM + col0 + bj * HALF + n * 16;
            const f32x4 v = acc[ai][bj][m][n];
            *(f32x4*)(xnew + off) = v;
            u32x2 w; w.x = cvt_pk_bf16(v[0], v[1]); w.y = cvt_pk_bf16(v[2], v[3]);
            *(u32x2*)(xb + off) = w;
            ss += (v[0] * v[0] + v[1] * v[1]) + (v[2] * v[2] + v[3] * v[3]);
          }
        ss += __shfl_xor(ss, 16); ss += __shfl_xor(ss, 32);
        if (fq == 0) atomicAdd(ssacc + row, ss);
      }
  }
};

struct EpiUp {
  static constexpr bool PERM = true, INIT = false;
  bf16_t* g; float* halo; const float* rss; const float* cw; const float* cb; LAS unsigned char* epl;
  __device__ __forceinline__ void operator()(Acc& acc, const Unit& u, int wr, int wc, int fr, int fq) const {
    const int rowb = u.pm * 256 + wr * 64;
    const int c0 = u.pn * 128 + wc * 32 + 8 * fq;
    float rr[2][4];
#pragma unroll
    for (int ai = 0; ai < 2; ++ai)
#pragma unroll
      for (int m = 0; m < 4; ++m) rr[ai][m] = rss[rowb + ai * HALF + m * 16 + fr];
    LAS unsigned char* wl = epl + (wr * 4 + wc) * 1024;
    { const int lane = fq * 16 + fr, arr = lane >> 3, part = lane & 7, col = u.pn * 128 + wc * 32 + 4 * part;
      const float* sp = ((arr & 3) == 3 ? cb : cw + (size_t)(arr & 3) * DFF2) + (arr >> 2) * DFF + col;
      const f32x4 wv = *(const f32x4*)sp;
      *(LAS f32x4*)(wl + lane * 16) = wv; }
#pragma unroll
    for (int ai = 0; ai < 2; ++ai)
#pragma unroll
      for (int m = 0; m < 4; ++m) {
        const float r = __builtin_amdgcn_rsqf(rr[ai][m] * (1.0f / DM) + EPS);
#pragma unroll
        for (int bj = 0; bj < 2; ++bj)
#pragma unroll
          for (int n = 0; n < 2; ++n) acc[ai][bj][m][n] = acc[ai][bj][m][n] * r;
      }
    asm volatile("s_waitcnt lgkmcnt(0)" ::: "memory");
#pragma unroll
    for (int n = 0; n < 2; ++n) {
      const int cc = c0 + 4 * n;
      const LAS unsigned char* wp = wl + (8 * fq + 4 * n) * 4;
      const f32x4 wg0 = *(const LAS f32x4*)(wp), wg1 = *(const LAS f32x4*)(wp + 128), wg2 = *(const LAS f32x4*)(wp + 256), bg = *(const LAS f32x4*)(wp + 384);
      const f32x4 wv0 = *(const LAS f32x4*)(wp + 512), wv1 = *(const LAS f32x4*)(wp + 640), wv2 = *(const LAS f32x4*)(wp + 768), bv = *(const LAS f32x4*)(wp + 896);
#pragma unroll
      for (int ai = 0; ai < 2; ++ai) {
        f32x4 g1p = (f32x4){0.f, 0.f, 0.f, 0.f}, g2p = g1p, v1p = g1p, v2p = g1p;
#pragma unroll
        for (int m = 0; m < 4; ++m) {
          const f32x4 G = acc[ai][0][m][n], V = acc[ai][1][m][n];
          const f32x4 pg1 = shr1ov(g1p, G), pg2 = shr2ov(g2p, G), pv1 = shr1ov(v1p, V), pv2 = shr2ov(v2p, V);
          const f32x4 cgt = wg2 * G + wg1 * pg1 + wg0 * pg2 + bg;
          const f32x4 cvl = wv2 * V + wv1 * pv1 + wv0 * pv2 + bv;
          if (m < 3) { g1p = ror1v(G); g2p = ror2v(G); v1p = ror1v(V); v2p = ror2v(V); }
          const int row = rowb + ai * HALF + m * 16 + fr;
          if (m > 0 || fr >= 2) {
            u32x2 w; w.x = cvt_pk_bf16(silu1(cgt[0]) * cvl[0], silu1(cgt[1]) * cvl[1]); w.y = cvt_pk_bf16(silu1(cgt[2]) * cvl[2], silu1(cgt[3]) * cvl[3]);
            *(u32x2*)(g + (size_t)row * DFF + cc) = w;
          }
          int slot = -1;
          if (m == 0 && fr < 2) slot = fr;
          if (m == 3 && fr >= 14) slot = fr - 12;
          if (slot >= 0) {
            float* hp = halo + ((size_t)(row >> 6) * 4 + slot) * DFF2 + cc;
            *(f32x4*)hp = G; *(f32x4*)(hp + DFF) = V;
          }
        }
      }
    }
  }
};

constexpr int ATT_KBUF = 64 * 400, ATT_VROWB = 136, ATT_VBUF = 128 * ATT_VROWB, ATT_BUF = ATT_KBUF + ATT_VBUF;
template <int DQK, bool CAUSAL>
__device__ __forceinline__ void attn_unit(LAS unsigned char* lds, const bf16_t* Q, int ldq, const bf16_t* K1, int ldk1, const bf16_t* K2, int ldk2,
                                          const bf16_t* VT, int ldv, int ntiles, int q0, bf16_t* O, int ldo) {
  constexpr int KROWB = (DQK + 8) * 2, NKS = DQK / 16, CPR = DQK / 8, NKCH = 64 * CPR / 512;
  int tid_o = threadIdx.x; asm volatile("" : "+v"(tid_o));
  const int tid = tid_o, wid = __builtin_amdgcn_readfirstlane(tid >> 6), lane = tid & 63, r32 = lane & 31, hi = lane >> 5;
  bf16x8 qf[NKS];
  { const bf16_t* qp = Q + (size_t)(wid * 32 + r32) * ldq + hi * 8;
#pragma unroll
    for (int ks = 0; ks < NKS; ++ks) qf[ks] = *(const bf16x8*)(qp + ks * 16); }
  u32x4 kreg[NKCH], vreg[2];
#define ATT_GLOAD(t_) do { const int k0_ = (t_) * 64; \
    _Pragma("unroll") for (int i = 0; i < NKCH; ++i) { const int ch = tid + i * 512, kr = ch / CPR, kc = ch - kr * CPR; \
      const bf16_t* src = (DQK == 128 || kc < 16) ? K1 + (size_t)(k0_ + kr) * ldk1 + kc * 8 : K2 + (size_t)(k0_ + kr) * ldk2 + (kc - 16) * 8; \
      kreg[i] = *(const u32x4*)src; } \
    _Pragma("unroll") for (int i = 0; i < 2; ++i) { const int ch = tid + i * 512, d = ch >> 3, cc = ch & 7; vreg[i] = *(const u32x4*)(VT + (size_t)d * ldv + k0_ + cc * 8); } } while (0)
#define ATT_LWRITE(buf_) do { LAS unsigned char* kb_ = lds + (buf_) * ATT_BUF; \
    _Pragma("unroll") for (int i = 0; i < NKCH; ++i) { const int ch = tid + i * 512, kr = ch / CPR, kc = ch - kr * CPR; *(LAS u32x4*)(kb_ + kr * KROWB + kc * 16) = kreg[i]; } \
    _Pragma("unroll") for (int i = 0; i < 2; ++i) { const int ch = tid + i * 512, d = ch >> 3, cc = ch & 7; LAS unsigned char* p = kb_ + ATT_KBUF + d * ATT_VROWB + cc * 16; \
      *(LAS u32x2*)p = (u32x2){vreg[i].x, vreg[i].y}; *(LAS u32x2*)(p + 8) = (u32x2){vreg[i].z, vreg[i].w}; } } while (0)
  f32x16 o[4];
#pragma unroll
  for (int d = 0; d < 4; ++d)
#pragma unroll
    for (int i = 0; i < 16; ++i) o[d][i] = 0.f;
  float mrow = 0.f, lsum = 0.f;
  const int qabs = q0 + wid * 32 + r32, qlo = q0 + wid * 32;
  ATT_GLOAD(0); ATT_LWRITE(0); __syncthreads();
  for (int t = 0; t < ntiles; ++t) {
    const int buf = t & 1;
    if (t + 1 < ntiles) ATT_GLOAD(t + 1);
    const int k0 = t * 64;
    if (!CAUSAL || k0 <= qlo + 31) {
      const LAS unsigned char* kb = lds + buf * ATT_BUF;
      const bool first = (t == 0);
      const float nm = first ? 0.f : -mrow;
      f32x16 s0, s1;
#pragma unroll
      for (int i = 0; i < 16; ++i) { s0[i] = nm; s1[i] = nm; }
#pragma unroll
      for (int ks = 0; ks < NKS; ++ks) {
        const bf16x8 ka = *(const LAS bf16x8*)(kb + r32 * KROWB + ks * 32 + hi * 16);
        const bf16x8 kc = *(const LAS bf16x8*)(kb + (32 + r32) * KROWB + ks * 32 + hi * 16);
        s0 = __builtin_amdgcn_mfma_f32_32x32x16_bf16(ka, qf[ks], s0, 0, 0, 0);
        s1 = __builtin_amdgcn_mfma_f32_32x32x16_bf16(kc, qf[ks], s1, 0, 0, 0);
      }
      if (CAUSAL && k0 + 63 > qlo) {
#pragma unroll
        for (int i = 0; i < 16; ++i) { const int kv = k0 + (i & 3) + 8 * (i >> 2) + 4 * hi;
          if (kv > qabs) s0[i] = -INFINITY; if (kv + 32 > qabs) s1[i] = -INFINITY; }
      }
      float mx = s0[0];
#pragma unroll
      for (int i = 1; i < 16; ++i) mx = fmaxf(mx, s0[i]);
#pragma unroll
      for (int i = 0; i < 16; ++i) mx = fmaxf(mx, s1[i]);
      mx = fmaxf(mx, __shfl_xor(mx, 32));
      const bool need = first || (mx > 8.0f);
      if (__ballot(need) != 0ull) {
        const float d = need ? mx : 0.f;
        const float alpha = first ? 0.f : __builtin_amdgcn_exp2f(-d);
        mrow = first ? mx : mrow + d;
        lsum *= alpha;
#pragma unroll
        for (int dd = 0; dd < 4; ++dd)
#pragma unroll
          for (int i = 0; i < 16; ++i) o[dd][i] *= alpha;
#pragma unroll
        for (int i = 0; i < 16; ++i) { s0[i] -= d; s1[i] -= d; }
      }
      float ps = 0.f;
#pragma unroll
      for (int i = 0; i < 16; ++i) { s0[i] = __builtin_amdgcn_exp2f(s0[i]); s1[i] = __builtin_amdgcn_exp2f(s1[i]); ps += s0[i] + s1[i]; }
      lsum += ps;
      bf16x8 pa[4];
#pragma unroll
      for (int s = 0; s < 4; ++s) {
        u32x4 w;
        if (s < 2) { w.x = cvt_pk_bf16(s0[8 * s + 0], s0[8 * s + 1]); w.y = cvt_pk_bf16(s0[8 * s + 2], s0[8 * s + 3]); w.z = cvt_pk_bf16(s0[8 * s + 4], s0[8 * s + 5]); w.w = cvt_pk_bf16(s0[8 * s + 6], s0[8 * s + 7]); }
        else { const int b = 8 * (s - 2); w.x = cvt_pk_bf16(s1[b + 0], s1[b + 1]); w.y = cvt_pk_bf16(s1[b + 2], s1[b + 3]); w.z = cvt_pk_bf16(s1[b + 4], s1[b + 5]); w.w = cvt_pk_bf16(s1[b + 6], s1[b + 7]); }
        pa[s] = __builtin_bit_cast(bf16x8, w);
      }
      const LAS unsigned char* vb = kb + ATT_KBUF;
#pragma unroll
      for (int d = 0; d < 4; ++d)
#pragma unroll
        for (int s = 0; s < 4; ++s) {
          const LAS unsigned char* p = vb + (32 * d + r32) * ATT_VROWB + (16 * s + 4 * hi) * 2;
          const u32x2 lo = *(const LAS u32x2*)p, hh = *(const LAS u32x2*)(p + 16);
          const bf16x8 vf = __builtin_bit_cast(bf16x8, (u32x4){lo.x, lo.y, hh.x, hh.y});
          o[d] = __builtin_amdgcn_mfma_f32_32x32x16_bf16(vf, pa[s], o[d], 0, 0, 0);
        }
    }
    if (t + 1 < ntiles) ATT_LWRITE(buf ^ 1);
    __syncthreads();
  }
#undef ATT_GLOAD
#undef ATT_LWRITE
  const float inv = 1.0f / (lsum + __shfl_xor(lsum, 32));
  bf16_t* op = O + (size_t)(wid * 32 + r32) * ldo + 4 * hi;
#pragma unroll
  for (int d = 0; d < 4; ++d)
#pragma unroll
    for (int ig = 0; ig < 4; ++ig) {
      u32x2 w; w.x = cvt_pk_bf16(o[d][4 * ig] * inv, o[d][4 * ig + 1] * inv); w.y = cvt_pk_bf16(o[d][4 * ig + 2] * inv, o[d][4 * ig + 3] * inv);
      *(u32x2*)(op + 32 * d + 8 * ig) = w;
    }
}


#define XB_TMO      128
#define XB_XCNT(j)  (256  + 64 * (j))
#define XB_XSUB(j)  (1280 + 64 * (j))
#define XB_XGEN(j)  (2304 + 64 * (j))
#define XB_TOP      3328
#define XB_TOPGEN   3392
#define XCD_BAR_WORDS 3456
#define XB_SPIN_CAP (1u << 18)
__device__ __forceinline__ unsigned xb_ld(unsigned* p)              { return __hip_atomic_load(p, __ATOMIC_RELAXED, __HIP_MEMORY_SCOPE_AGENT); }
__device__ __forceinline__ unsigned xb_add(unsigned* p, unsigned v) { return __hip_atomic_fetch_add(p, v, __ATOMIC_RELAXED, __HIP_MEMORY_SCOPE_AGENT); }
__device__ __forceinline__ unsigned xb_xcc_id() { return (unsigned)__builtin_amdgcn_s_getreg((3 << 11) | 20) & 0xFu; }
#define XB_SPIN(cond, bar) do { unsigned _sp = 0; while (cond) { __builtin_amdgcn_s_sleep(1); \
    if ((++_sp & 255u) == 0u) { if (xb_ld(&(bar)[XB_TMO])) break; if (_sp > XB_SPIN_CAP) { atomicAdd(&(bar)[XB_TMO], 1u); break; } } } } while (0)
struct XcdBarrier { unsigned* bar; unsigned x; volatile LAS unsigned* st; };
__device__ __forceinline__ XcdBarrier xcd_barrier_post(unsigned* bar, volatile LAS unsigned* st) {
  XcdBarrier b; b.bar = bar; b.x = xb_xcc_id(); b.st = st;
  if (threadIdx.x == 0) (void)xb_add(&bar[XB_XCNT(b.x)], 1u);
  return b;
}
__device__ __forceinline__ void xcd_barrier_complete(unsigned* bar, unsigned x, unsigned& nloc, unsigned& nx) {
  const unsigned G = gridDim.x * gridDim.y * gridDim.z;
  unsigned sum, cnt, mine, sp = 0u;
  for (;;) {
    sum = 0u; cnt = 0u; mine = 0u;
#pragma unroll
    for (unsigned j = 0; j < 16; ++j) { const unsigned c = xb_ld(&bar[XB_XCNT(j)]); sum += c; cnt += (c > 0u) ? 1u : 0u; mine = (j == x) ? c : mine; }
    if (sum == G) break;
    __builtin_amdgcn_s_sleep(1);
    if ((++sp & 255u) == 0u) { if (xb_ld(&bar[XB_TMO])) break; if (sp > XB_SPIN_CAP) { atomicAdd(&bar[XB_TMO], 1u); break; } }
  }
  nloc = mine > 0u ? mine : 1u; nx = cnt > 0u ? cnt : 1u;
}
__device__ __forceinline__ void xcd_barrier(const XcdBarrier& b) {
  asm volatile("s_waitcnt vmcnt(0)" ::: "memory");
  __syncthreads();
  if (threadIdx.x == 0) {
    unsigned* bar = b.bar;
    __builtin_amdgcn_s_waitcnt(0);
    unsigned nloc = b.st[0], nx = b.st[1];
    if (nloc == 0u) { xcd_barrier_complete(bar, b.x, nloc, nx); b.st[0] = nloc; b.st[1] = nx; }
    const unsigned old = xb_add(&bar[XB_XSUB(b.x)], 1u);
    const unsigned gen = old / nloc;
    if (old + 1u == (gen + 1u) * nloc) {
      __builtin_amdgcn_fence(__ATOMIC_RELEASE, "agent");
      asm volatile("s_waitcnt vmcnt(0)" ::: "memory");
      const unsigned og = xb_add(&bar[XB_TOP], 1u);
      const unsigned tg = og / nx;
      if (og + 1u == (tg + 1u) * nx) xb_add(&bar[XB_TOPGEN], 1u);
      else XB_SPIN(xb_ld(&bar[XB_TOPGEN]) == tg, bar);
      __builtin_amdgcn_fence(__ATOMIC_ACQUIRE, "agent");
      xb_add(&bar[XB_XGEN(b.x)], 1u);
      asm volatile("s_waitcnt vmcnt(0)" ::: "memory");
    } else {
      XB_SPIN(xb_ld(&bar[XB_XGEN(b.x)]) == gen, bar);
      __builtin_amdgcn_fence(__ATOMIC_ACQUIRE, "agent");
      asm volatile("s_waitcnt vmcnt(0)" ::: "memory");
    }
  }
  __syncthreads();
}

constexpr int NWD = 27;
struct WDesc { const float* src; const float* scale; bf16_t* dst; int K, Ns, Nd, kind, item0, pad; };
struct Args { const float* in[25]; float* out; unsigned char* ws; WDesc wd[NWD]; int nitems; int pad; };

__device__ __forceinline__ int srccol(int kind, int n) {
  if (kind == 0) return n;
  if (kind == 1) { if (n < 512) return n; if (n < 576) { const int r = n - 512; return 512 + ((r & 1) ? 32 : 0) + (r >> 1); } return -1; }
  if (kind == 2) { const int h = n / 192, d = n - h * 192; if (d < 128) return n; const int r = d - 128; return h * 192 + 128 + ((r & 1) ? 32 : 0) + (r >> 1); }
  { const int t = n >> 8, w = n & 255; return (w >> 7) * DFF + 128 * t + (w & 127); }
}

constexpr int LDS_BYTES = 140 * 1024;
#ifndef ONLY
#define ONLY 0
#endif
#define EN(k) (ONLY == 0 || ONLY == (k))
typedef __attribute__((address_space(4))) const Args CArgs;
#define DERIVE_PTRS(ap) \
  unsigned char* ws = (ap)->ws; \
  float* rsA = (float*)(ws + WS_RS); float* rsB = rsA + MTOK; float* rsV = rsB + MTOK; float* rsQ = rsV + MTOK; float* rsKV = rsQ + MTOK; float* rsM = rsKV + MTOK; \
  f32x2* cs = (f32x2*)(ws + WS_CS); \
  bf16_t* memb = (bf16_t*)(ws + WS_MEMB); bf16_t* memk = (bf16_t*)(ws + WS_MEMK); bf16_t* memvt = (bf16_t*)(ws + WS_MEMVT); \
  bf16_t* xb = (bf16_t*)(ws + WS_XB); bf16_t* kvb = (bf16_t*)(ws + WS_KVB); bf16_t* kn = (bf16_t*)(ws + WS_KN); bf16_t* vT = (bf16_t*)(ws + WS_VT); \
  float* halo = (float*)(ws + WS_HALO); \
  bf16_t* gbuf = (bf16_t*)(ws + WS_R); bf16_t* zbuf = (bf16_t*)(ws + WS_R); bf16_t* cat = (bf16_t*)(ws + WS_CAT); bf16_t* qbuf = (bf16_t*)(ws + WS_Q); \
  const float* x_in = (ap)->in[0]; float* xo = (ap)->out; \
  (void)rsA; (void)rsB; (void)rsV; (void)rsQ; (void)rsKV; (void)rsM; (void)cs; (void)memb; (void)memk; (void)memvt; (void)xb; (void)kvb; (void)kn; (void)vT; (void)halo; (void)gbuf; (void)zbuf; (void)cat; (void)qbuf; (void)x_in; (void)xo;
__global__ void __launch_bounds__(512, 2) yoco_fwd(Args a) {
  extern __shared__ __attribute__((aligned(16))) unsigned char lds_raw[];
  LAS unsigned char* lds = (LAS unsigned char*)lds_raw;
  cg::grid_group grid = cg::this_grid();
  volatile LAS unsigned* xst = (volatile LAS unsigned*)(lds + 131072 + 64);
  if (threadIdx.x < 4) xst[threadIdx.x] = 0u;
  __syncthreads();
#define DERIVE_IDS \
  int tid_o = threadIdx.x; asm volatile("" : "+v"(tid_o)); \
  const int tid = tid_o, lane = tid & 63, wave = __builtin_amdgcn_readfirstlane(tid >> 6); \
  const int G = gridDim.x, bx = blockIdx.x; \
  const int vcu = (G % 8 == 0) ? (bx % 8) * (G / 8) + bx / 8 : bx; \
  const int gw = vcu * 8 + wave, NGW = G * 8; \
  const size_t gtid = (size_t)bx * 512 + tid, NGT = (size_t)G * 512; \
  (void)lane; (void)wave; (void)vcu; (void)gw; (void)NGW; (void)gtid; (void)NGT;
  {
    const Args* ap = &a; DERIVE_PTRS(ap)
    DERIVE_IDS
    LAS float* scr = (LAS float*)(lds + wave * 8448);
    for (int it = gw; it < a.nitems; it += NGW) {
      int di = 0;
#pragma unroll 1
      for (int j = 1; j < NWD; ++j) if (it >= a.wd[j].item0) di = j;
      const float* src = a.wd[di].src; const float* scale = a.wd[di].scale; bf16_t* dst = a.wd[di].dst;
      const int K = a.wd[di].K, Ns = a.wd[di].Ns, Nd = a.wd[di].Nd, kind = a.wd[di].kind, item = it - a.wd[di].item0;
      const int nblk = Nd / 32, kb = item / nblk, nb = item - kb * nblk, k0 = 64 * kb, n0 = 32 * nb;
      const int sc = srccol(kind, n0 + (lane & 31));
      float wv[32];
      { const float* sp = src + (size_t)(k0 + (lane >> 5)) * Ns + (sc >= 0 ? sc : 0);
#pragma unroll
        for (int i = 0; i < 32; ++i) wv[i] = sp[(size_t)(2 * i) * Ns]; }
      if (scale) {
#pragma unroll
        for (int i = 0; i < 32; ++i) wv[i] *= scale[k0 + 2 * i + (lane >> 5)];
      }
#pragma unroll
      for (int i = 0; i < 32; ++i) scr[(2 * i + (lane >> 5)) * 33 + (lane & 31)] = (sc >= 0) ? wv[i] : 0.f;
      asm volatile("s_waitcnt lgkmcnt(0)" ::: "memory");
      const int c = lane & 7;
#pragma unroll
      for (int j = 0; j < 4; ++j) { const int n = (lane >> 3) + 8 * j; const LAS float* s = scr + (8 * c) * 33 + n;
        u32x4 o; o.x = cvt_pk_bf16(s[0 * 33], s[1 * 33]); o.y = cvt_pk_bf16(s[2 * 33], s[3 * 33]); o.z = cvt_pk_bf16(s[4 * 33], s[5 * 33]); o.w = cvt_pk_bf16(s[6 * 33], s[7 * 33]);
        *(u32x4*)(dst + (size_t)(n0 + n) * K + k0 + 8 * c) = o; }
      asm volatile("s_waitcnt lgkmcnt(0)" ::: "memory");
    }
    for (int r = gw; r < MTOK + MMEM; r += NGW) {
      const bool ism = r >= MTOK; const int rr = ism ? r - MTOK : r;
      const f32x4* xr = (const f32x4*)((ism ? a.in[1] : x_in) + (size_t)rr * DM) + lane;
      u32x2* o8 = (u32x2*)((ism ? memb : xb) + (size_t)rr * DM) + lane;
      float s = 0.f;
#pragma unroll
      for (int j = 0; j < 8; ++j) { const f32x4 v = xr[64 * j]; s += (v[0] * v[0] + v[1] * v[1]) + (v[2] * v[2] + v[3] * v[3]); u32x2 w; w.x = cvt_pk_bf16(v[0], v[1]); w.y = cvt_pk_bf16(v[2], v[3]); o8[64 * j] = w; }
      s = wave_sum(s);
      if (lane == 0) (ism ? rsM : rsA)[rr] = s;
    }
    const int* pos = (const int*)a.in[2];
    for (size_t i = gtid; i < (size_t)MTOK * 32; i += NGT) {
      const int row = (int)(i >> 5), j = (int)(i & 31);
      const float inv = 1.0f / powf(10000.0f, (float)(2 * j) / 64.0f);
      const float ang = (float)pos[row] * inv;
      const double rev = (double)ang * 0.15915494309189535;
      const float fr = (float)(rev - floor(rev));
      cs[i] = (f32x2){__builtin_amdgcn_cosf(fr), __builtin_amdgcn_sinf(fr)};
    }
    for (size_t i = gtid; i < (size_t)MTOK * 4; i += NGT) rsB[i] = 0.f;
    if (bx == 0) for (int i = tid; i < XCD_BAR_WORDS; i += 512) ((unsigned*)ws)[i] = 0u;
  }
  grid.sync();
  const XcdBarrier xbar = xcd_barrier_post((unsigned*)a.ws, xst);

  pg8::StaticOrder S;
#pragma unroll 1
  for (int l = -1; l < 4; ++l) {
    const bool isA = l < 2; const int j = l - 2;
#pragma unroll 1
    for (int s = 0; s < 10; ++s) {
      CArgs* ap = (CArgs*)__builtin_amdgcn_kernarg_segment_ptr(); asm volatile("" : "+s"(ap));
      DERIVE_PTRS(ap)
      DERIVE_IDS
      int type = 0; bool sync = false;
      pg8::Gemm g{nullptr, nullptr, 0, 0, 0, 0, 0}; int corder = bx;
      EpiG eg{nullptr, 0, nullptr, 0.f, nullptr, 0.f, 0, 0, 0, nullptr, 0, nullptr, 1 << 30, 1.f};
      EpiRes er{nullptr, nullptr, xb, nullptr};
      if (l < 0) {
        if (s < 8) {
          const int ml = s >> 1; const bf16_t* wt = ap->wd[9 + ml].dst;
          type = 1; corder = (bx + 16 * s) % G; sync = (s == 7);
          if (!(s & 1)) { g = pg8::Gemm{memb, wt, MMEM, 512, DM, DM, DM}; eg.O = memk + (size_t)ml * MMEM * 512; eg.ldc = 512; eg.rss = rsM; eg.rinvD = 1.0f / DM; }
          else { g = pg8::Gemm{wt + (size_t)512 * DM, memb, 512, MMEM, DM, DM, DM}; eg.O = memvt + (size_t)ml * 512 * MMEM; eg.ldc = MMEM; eg.css = rsM; eg.cinvD = 1.0f / DM; }
        }
      } else {
        switch (s) {
          case 0: if (l == 2) { type = 1; sync = true;
              g = pg8::Gemm{xb, ap->wd[4].dst, MTOK, KVW, DM, DM, DM};
              eg.O = kvb; eg.ldc = KVW; eg.rss = rsA; eg.rinvD = 1.0f / DM; eg.ss_lo = 0; eg.ss_hi = 512; eg.ssacc = rsKV; eg.rope_mode = 2; eg.cs = cs; } break;
          case 1: type = 1; eg.O = zbuf; eg.rss = rsA; eg.rinvD = 1.0f / DM; eg.sc_val = SC_MEM;
            if (isA) { sync = true; g = pg8::Gemm{xb, ap->wd[l].dst, MTOK, ZA_W, DM, DM, DM}; eg.ldc = ZA_W; eg.gelu_hi = 2 * GW; eg.ss_lo = GW; eg.ss_hi = 2 * GW; eg.ssacc = rsV; eg.sc_lo = 2 * GW; }
            else { g = pg8::Gemm{xb, ap->wd[2 + j].dst, MTOK, ZB_W, DM, DM, DM}; eg.ldc = ZB_W; eg.ss_lo = 0; eg.ss_hi = 512; eg.ssacc = rsQ; eg.sc_lo = 512; }
            break;
          case 2: if (!isA) { type = 1; g = pg8::Gemm{kvb, ap->wd[5 + j].dst, MTOK, GW, 512, KVW, 512}; eg.O = kn; eg.ldc = GW; eg.rss = rsKV; eg.rinvD = 1.0f / 512; } break;
          case 3: if (!isA) { type = 1; sync = true; g = pg8::Gemm{ap->wd[7 + j].dst, kvb, GW, MTOK, 512, 512, KVW}; eg.O = vT; eg.ldc = MTOK; eg.css = rsKV; eg.cinvD = 1.0f / 512; } break;
          case 4: if (!isA) { type = 1; sync = true; g = pg8::Gemm{zbuf, ap->wd[13 + j].dst, MTOK, QW, 512, ZB_W, 512};
              eg.O = qbuf; eg.ldc = QW; eg.rss = rsQ; eg.rinvD = 1.0f / 512; eg.rope_mode = 1; eg.cs = cs; eg.sc_lo = 0; eg.sc_val = SC_MLA; } break;
          case 5: type = 4; sync = true; break;
          case 6: type = 2; sync = true; g = pg8::Gemm{cat, ap->wd[15 + l].dst, MTOK, DM, DM, DM, DM}; er.xold = (l == 0) ? x_in : xo; er.xnew = xo; er.ssacc = rsB; break;
          case 7: type = 3; sync = true; g = pg8::Gemm{xb, ap->wd[19 + l].dst, MTOK, DFF2, DM, DM, DM}; break;
          case 8: type = 5; sync = true; break;
          case 9: type = 2; sync = true; g = pg8::Gemm{gbuf, ap->wd[23 + l].dst, MTOK, DM, DFF, DFF, DFF}; er.xold = xo; er.xnew = xo; er.ssacc = rsA; break;
        }
      }
      if (type == 1 && EN(1)) { S.init(g.M, g.N, G, corder); pg8::gemm_phase<EpiG>(lds, g, S, eg); }
      else if (type == 2 && EN(2)) {
        S.init(g.M, g.N, G, corder); pg8::gemm_phase<EpiRes>(lds, g, S, er);
        if (s == 6) for (size_t i = gtid; i < (size_t)MTOK; i += NGT) { rsA[i] = 0.f; rsV[i] = 0.f; rsQ[i] = 0.f; }
      }
      else if (type == 3 && EN(3)) {
        S.init(g.M, g.N, G, corder);
        EpiUp E{gbuf, halo, rsB, ap->in[22] + (size_t)l * 3 * DFF2, ap->in[23] + (size_t)l * DFF2, lds + 131072 + 1024};
        pg8::gemm_phase<EpiUp>(lds, g, S, E);
      }
      else if (type == 4 && (EN(4) || EN(6) || EN(7))) {
        if (isA && EN(4)) {
          const float* wsp = ap->in[8] + (size_t)l * 12 * 128 * 128; const float* bsp = ap->in[9] + (size_t)l * 12 * 128; const float* gv = ap->in[7] + (size_t)l * GW;
          LAS unsigned char* Wl = lds; LAS unsigned char* Vt = lds + 128 * 272;
          const int r32 = lane & 31, hi = lane >> 5, tb = wave & 3, chh = wave >> 2;
          for (int uidx = vcu; uidx < NB * 32 * 12; uidx += G) {
            const int gi = uidx % 12, bn = uidx / 12, tok0 = bn * 128;
#pragma unroll
            for (int i = 0; i < 8; ++i) { const int idx = tid + i * 512, t = idx >> 5, s4 = (idx & 31) * 4;
              f32x4 w = *(const f32x4*)(wsp + ((size_t)gi * 128 + t) * 128 + s4);
              const f32x4 q = *(const f32x4*)(rsV + tok0 + s4);
#pragma unroll
              for (int e = 0; e < 4; ++e) w[e] = (s4 + e <= t) ? w[e] * __builtin_amdgcn_rsqf(q[e] * (1.0f / GW) + EPS) : 0.f;
              *(LAS u32x2*)(Wl + t * 272 + s4 * 2) = (u32x2){cvt_pk_bf16(w[0], w[1]), cvt_pk_bf16(w[2], w[3])}; }
#pragma unroll
            for (int i = 0; i < 4; ++i) { const int idx = tid + i * 512, sr = idx >> 4, c8 = (idx & 15) * 8;
              const u32x4 v = *(const u32x4*)(zbuf + (size_t)(tok0 + sr) * ZA_W + GW + gi * 128 + c8);
              const unsigned vv[4] = {v.x, v.y, v.z, v.w};
#pragma unroll
              for (int e = 0; e < 4; ++e) { *(LAS unsigned short*)(Vt + (c8 + 2 * e) * 272 + sr * 2) = (unsigned short)(vv[e] & 0xffffu); *(LAS unsigned short*)(Vt + (c8 + 2 * e + 1) * 272 + sr * 2) = (unsigned short)(vv[e] >> 16); } }
            __syncthreads();
            f32x16 acc2[2];
#pragma unroll
            for (int cb = 0; cb < 2; ++cb)
#pragma unroll
              for (int i = 0; i < 16; ++i) acc2[cb][i] = 0.f;
            const int nks = 2 * (tb + 1);
            for (int ks = 0; ks < nks; ++ks) {
              const bf16x8 wf = *(const LAS bf16x8*)(Wl + (32 * tb + r32) * 272 + ks * 32 + hi * 16);
#pragma unroll
              for (int cb = 0; cb < 2; ++cb) {
                const bf16x8 vf = *(const LAS bf16x8*)(Vt + (64 * chh + 32 * cb + r32) * 272 + ks * 32 + hi * 16);
                acc2[cb] = __builtin_amdgcn_mfma_f32_32x32x16_bf16(vf, wf, acc2[cb], 0, 0, 0);
              }
            }
            const int t = 32 * tb + r32; const float bt = bsp[gi * 128 + t];
            const size_t rowoff = (size_t)(tok0 + t);
#pragma unroll
            for (int cb = 0; cb < 2; ++cb)
#pragma unroll
              for (int ig = 0; ig < 4; ++ig) {
                const int c = gi * 128 + 64 * chh + 32 * cb + 8 * ig + 4 * hi;
                const f32x4 gg = *(const f32x4*)(gv + c);
                const u32x2 uu = *(const u32x2*)(zbuf + rowoff * ZA_W + c);
                const float u0 = __uint_as_float(uu.x << 16), u1 = __uint_as_float(uu.x & 0xffff0000u), u2 = __uint_as_float(uu.y << 16), u3 = __uint_as_float(uu.y & 0xffff0000u);
                const float o0 = u0 * (acc2[cb][4 * ig] * gg[0] + bt), o1 = u1 * (acc2[cb][4 * ig + 1] * gg[1] + bt), o2 = u2 * (acc2[cb][4 * ig + 2] * gg[2] + bt), o3 = u3 * (acc2[cb][4 * ig + 3] * gg[3] + bt);
                *(u32x2*)(cat + rowoff * DM + c) = (u32x2){cvt_pk_bf16(o0, o1), cvt_pk_bf16(o2, o3)};
              }
            __syncthreads();
          }
        } else if (!isA && EN(6)) {
          for (int p = 6 * vcu; p < 1536; p += 6 * G)
#pragma unroll 1
            for (int uu = p; uu < p + 6 && uu < 1536; ++uu) {
              const int pp = uu >> 1, half = uu & 1, bh = pp >> 3, i8 = pp & 7, b = bh / 12, h = bh - b * 12;
              const int qblk = half ? i8 : 15 - i8; const size_t row0 = (size_t)b * SEQ + qblk * 256;
              attn_unit<192, true>(lds, qbuf + row0 * QW + h * 192, QW, kn + (size_t)b * SEQ * GW + h * 128, GW, kvb + (size_t)b * SEQ * KVW + 512, KVW,
                                   vT + (size_t)(h * 128) * MTOK + (size_t)b * SEQ, MTOK, (qblk + 1) * 4, qblk * 256, cat + row0 * DM + h * 128, DM);
            }
        }
        if (EN(7)) {
          const bf16_t* qm = zbuf + (isA ? 2 * GW : 512); const int ldq = isA ? ZA_W : ZB_W;
#pragma unroll 1
          for (int uidx = vcu; uidx < NB * 4 * 16; uidx += G) {
            const int qblk = uidx & 15, bh = uidx >> 4, b = bh >> 2, h = bh & 3; const size_t row0 = (size_t)b * SEQ + qblk * 256;
            attn_unit<128, false>(lds, qm + row0 * ldq + h * 128, ldq, memk + (size_t)l * MMEM * 512 + (size_t)b * NMEM * 512 + h * 128, 512, nullptr, 0,
                                  memvt + (size_t)l * 512 * MMEM + (size_t)(h * 128) * MMEM + b * NMEM, MMEM, 4, 0, cat + row0 * DM + GW + h * 128, DM);
          }
        }
        for (size_t i = gtid; i < (size_t)MTOK; i += NGT) rsB[i] = 0.f;
      }
      else if (type == 5 && EN(5)) {
        const float* cw = ap->in[22] + (size_t)l * 3 * DFF2; const float* cb = ap->in[23] + (size_t)l * DFF2;
        for (size_t idx = gtid; idx < (size_t)1024 * (DFF / 4); idx += NGT) {
          const int rowi = (int)(idx / (DFF / 4)), c4 = (int)(idx % (DFF / 4)) * 4, blk = rowi >> 1, rr = rowi & 1;
          const bool hp = (blk & 63) != 0;
          const float* H0 = halo + (size_t)blk * 4 * DFF2; const float* Hp = H0 - (size_t)4 * DFF2;
          f32x4 cv[2];
#pragma unroll
          for (int part = 0; part < 2; ++part) {
            const int off = part * DFF + c4; const f32x4 z4 = (f32x4){0.f, 0.f, 0.f, 0.f};
            const f32x4 a0 = *(const f32x4*)(H0 + (size_t)rr * DFF2 + off);
            const f32x4 p3 = hp ? *(const f32x4*)(Hp + (size_t)3 * DFF2 + off) : z4;
            const f32x4 a1 = rr ? *(const f32x4*)(H0 + off) : p3;
            const f32x4 a2 = rr ? p3 : (hp ? *(const f32x4*)(Hp + (size_t)2 * DFF2 + off) : z4);
            cv[part] = *(const f32x4*)(cw + 2 * DFF2 + off) * a0 + *(const f32x4*)(cw + DFF2 + off) * a1 + *(const f32x4*)(cw + off) * a2 + *(const f32x4*)(cb + off);
          }
          u32x2 w; w.x = cvt_pk_bf16(silu1(cv[0][0]) * cv[1][0], silu1(cv[0][1]) * cv[1][1]); w.y = cvt_pk_bf16(silu1(cv[0][2]) * cv[1][2], silu1(cv[0][3]) * cv[1][3]);
          *(u32x2*)(gbuf + (size_t)(blk * 64 + rr) * DFF + c4) = w;
        }
      }
      if (sync) xcd_barrier(xbar);
    }
  }
  {
    const Args* ap = &a; DERIVE_PTRS(ap)
    DERIVE_IDS
    const float* gf = a.in[5];
    for (size_t i = gtid; i < (size_t)MTOK * (DM / 4); i += NGT) {
      const int row = (int)(i / (DM / 4)), c4 = (int)(i % (DM / 4)) * 4;
      const float r = __builtin_amdgcn_rsqf(rsA[row] * (1.0f / DM) + EPS);
      f32x4* p = (f32x4*)(xo + (size_t)row * DM + c4);
      *p = *p * r * *(const f32x4*)(gf + c4);
    }
  }
}

extern "C" void kernel_launch(void* const* d_in, const int* in_sizes, int n_in, void* d_out, int out_size, void* d_ws, size_t ws_size, hipStream_t stream) {
  static int grid_blocks = 0;
  if (!grid_blocks) {
    int dev = 0, cus = 0, per_cu = 0;
    (void)hipGetDevice(&dev);
    (void)hipDeviceGetAttribute(&cus, hipDeviceAttributeMultiprocessorCount, dev);
    (void)hipFuncSetAttribute((const void*)yoco_fwd, hipFuncAttributeMaxDynamicSharedMemorySize, LDS_BYTES);
    (void)hipOccupancyMaxActiveBlocksPerMultiprocessor(&per_cu, (const void*)yoco_fwd, 512, LDS_BYTES);
    if (per_cu < 1) per_cu = 1;
    grid_blocks = cus * per_cu;
    if (ws_size < WS_END) fprintf(stderr, "kernel_launch: workspace too small: %zu < %zu\n", ws_size, (size_t)WS_END);
  }
  Args a; memset(&a, 0, sizeof(a));
  for (int i = 0; i < 25; ++i) a.in[i] = (const float*)d_in[i];
  a.out = (float*)d_out; a.ws = (unsigned char*)d_ws;
  const float* const* in = a.in;
  bf16_t* wp = (bf16_t*)((unsigned char*)d_ws + WS_W);
  int nd = 0, items = 0;
  auto add = [&](const float* src, const float* scale, int K, int Ns, int Nd, int kind) {
    WDesc& d = a.wd[nd++]; d.src = src; d.scale = scale; d.dst = wp; d.K = K; d.Ns = Ns; d.Nd = Nd; d.kind = kind; d.item0 = items; d.pad = 0;
    items += (K / 64) * (Nd / 32); wp += (size_t)K * Nd;
  };
  for (int l = 0; l < 2; ++l) add(in[6] + (size_t)l * DM * ZA_W, in[3] + (size_t)l * DM, DM, ZA_W, ZA_W, 0);
  for (int j = 0; j < 2; ++j) add(in[13] + (size_t)j * DM * ZB_W, in[3] + (size_t)(2 + j) * DM, DM, ZB_W, ZB_W, 0);
  add(in[11], in[10], DM, 576, KVW, 1);
  for (int j = 0; j < 2; ++j) add(in[16] + (size_t)j * 512 * GW, in[12], 512, GW, GW, 0);
  for (int j = 0; j < 2; ++j) add(in[17] + (size_t)j * 512 * GW, in[12], 512, GW, GW, 0);
  for (int l = 0; l < 4; ++l) add(in[19] + (size_t)l * DM * 1024, in[18] + (size_t)l * DM, DM, 1024, 1024, 0);
  for (int j = 0; j < 2; ++j) add(in[15] + (size_t)j * 512 * QW, in[14] + (size_t)j * 512, 512, QW, QW, 2);
  for (int l = 0; l < 4; ++l) add(in[20] + (size_t)l * DM * DM, nullptr, DM, DM, DM, 0);
  for (int l = 0; l < 4; ++l) add(in[21] + (size_t)l * DM * DFF2, in[4] + (size_t)l * DM, DM, DFF2, DFF2, 3);
  for (int l = 0; l < 4; ++l) add(in[24] + (size_t)l * DFF * DM, nullptr, DFF, DM, DM, 0);
  a.nitems = items;
  void* args[] = {&a};
  hipError_t e = hipLaunchCooperativeKernel((const void*)yoco_fwd, dim3(grid_blocks), dim3(512), args, LDS_BYTES, stream);
  if (e != hipSuccess) fprintf(stderr, "cooperative launch failed: %s (grid %d)\n", hipGetErrorString(e), grid_blocks);
}
```

```cpp
#include <hip/hip_runtime.h>
#include <hip/hip_cooperative_groups.h>
#include <cstdio>
#include <cstring>
namespace cg = cooperative_groups;

#define LAS __attribute__((address_space(3)))
typedef unsigned short bf16_t;
typedef short bf16x8 __attribute__((ext_vector_type(8)));
typedef short s16x4 __attribute__((ext_vector_type(4)));
typedef float f32x4 __attribute__((ext_vector_type(4)));
typedef float f32x2 __attribute__((ext_vector_type(2)));
typedef float f32x16 __attribute__((ext_vector_type(16)));
typedef unsigned u32x4 __attribute__((ext_vector_type(4)));
typedef unsigned u32x2 __attribute__((ext_vector_type(2)));

constexpr int DM = 2048, NB = 8, SEQ = 4096, MTOK = NB * SEQ, NMEM = 256, MMEM = NB * NMEM;
constexpr int GW = 1536, ZA_W = 3584, ZB_W = 1024, QW = 2304, KVW = 768, DFF = 5632, DFF2 = 11264;
constexpr float EPS = 1e-6f;
constexpr float LOG2E = 1.4426950408889634f;
constexpr float SC_MEM = 0.08838834764831845f * LOG2E;
constexpr float SC_MLA = 0.07216878364870323f * LOG2E;

constexpr size_t MiB = 1u << 20;
constexpr size_t WS_RS = 1 * MiB;
constexpr size_t WS_CS = 2 * MiB;
constexpr size_t WS_MEMB = 10 * MiB;
constexpr size_t WS_MEMK = 18 * MiB;
constexpr size_t WS_MEMVT = 26 * MiB;
constexpr size_t WS_W = 34 * MiB;
constexpr size_t WS_XB = 396 * MiB;
constexpr size_t WS_KVB = 524 * MiB;
constexpr size_t WS_KN = 572 * MiB;
constexpr size_t WS_VT = 668 * MiB;
constexpr size_t WS_HALO = 764 * MiB;
constexpr size_t WS_R = 852 * MiB;
constexpr size_t WS_CAT = WS_R + 224 * MiB;
constexpr size_t WS_Q = WS_R + 64 * MiB;
constexpr size_t WS_END = 1204 * MiB;

typedef __bf16 bf16x2_t __attribute__((ext_vector_type(2)));
__device__ __forceinline__ unsigned cvt_pk_bf16(float lo, float hi) { const f32x2 v = {lo, hi}; const bf16x2_t b = __builtin_convertvector(v, bf16x2_t); return __builtin_bit_cast(unsigned, b); }
__device__ __forceinline__ float wave_sum(float v) {
#pragma unroll
  for (int o = 1; o < 64; o <<= 1) v += __shfl_xor(v, o);
  return v;
}
__device__ __forceinline__ f32x2 gelu_pk(f32x2 v) {
  const f32x2 av = __builtin_elementwise_abs(v), d = av * 0.2316418882f + 1.0f;
  f32x2 t; t.x = __builtin_amdgcn_rcpf(d.x); t.y = __builtin_amdgcn_rcpf(d.y);
  f32x2 q = t * 0.5307027145f + (-0.7265760135f); q = q * t + 0.7107068705f; q = q * t + (-0.142248368f); q = q * t + 0.127414796f; q = q * t;
  const f32x2 s = (v * v) * (-0.72134752044f);
  f32x2 e; e.x = __builtin_amdgcn_exp2f(s.x); e.y = __builtin_amdgcn_exp2f(s.y);
  const f32x2 m = v * (q * e), r = v - m;
  f32x2 o; o.x = v.x < 0.f ? m.x : r.x; o.y = v.y < 0.f ? m.y : r.y; return o;
}
__device__ __forceinline__ f32x4 gelu4(f32x4 v) { f32x2 a = gelu_pk((f32x2){v[0], v[1]}), b = gelu_pk((f32x2){v[2], v[3]}); return (f32x4){a.x, a.y, b.x, b.y}; }
__device__ __forceinline__ float silu1(float x) { return x * __builtin_amdgcn_rcpf(1.0f + __builtin_amdgcn_exp2f(-x * LOG2E)); }
__device__ __forceinline__ float ror1(float v) { return __builtin_bit_cast(float, __builtin_amdgcn_update_dpp(0, __builtin_bit_cast(int, v), 0x121, 0xf, 0xf, true)); }
__device__ __forceinline__ float ror2(float v) { return __builtin_bit_cast(float, __builtin_amdgcn_update_dpp(0, __builtin_bit_cast(int, v), 0x122, 0xf, 0xf, true)); }
__device__ __forceinline__ float shr1o(float old, float v) { return __builtin_bit_cast(float, __builtin_amdgcn_update_dpp(__builtin_bit_cast(int, old), __builtin_bit_cast(int, v), 0x111, 0xf, 0xf, false)); }
__device__ __forceinline__ float shr2o(float old, float v) { return __builtin_bit_cast(float, __builtin_amdgcn_update_dpp(__builtin_bit_cast(int, old), __builtin_bit_cast(int, v), 0x112, 0xf, 0xf, false)); }
__device__ __forceinline__ f32x4 shr1ov(f32x4 o, f32x4 v) { return (f32x4){shr1o(o[0], v[0]), shr1o(o[1], v[1]), shr1o(o[2], v[2]), shr1o(o[3], v[3])}; }
__device__ __forceinline__ f32x4 shr2ov(f32x4 o, f32x4 v) { return (f32x4){shr2o(o[0], v[0]), shr2o(o[1], v[1]), shr2o(o[2], v[2]), shr2o(o[3], v[3])}; }
__device__ __forceinline__ f32x4 ror1v(f32x4 v) { return (f32x4){ror1(v[0]), ror1(v[1]), ror1(v[2]), ror1(v[3])}; }
__device__ __forceinline__ f32x4 ror2v(f32x4 v) { return (f32x4){ror2(v[0]), ror2(v[1]), ror2(v[2]), ror2(v[3])}; }

namespace pg8 {
constexpr int BM = 256, BK = 64, HALF = 128, HTB = HALF * BK * 2, STAGE_BYTES = 8 * HTB, NXCD = 8, WGM = 8;
__device__ __forceinline__ int lds_byte(int r, int c) { const int st = (r >> 4) * 2 + (c >> 5), rr = r & 15, cc = c & 31, ob = rr * 64 + cc * 2; return st * 1024 + (ob ^ (((ob >> 9) & 1) << 5)); }
__device__ __forceinline__ void stage_rc(int b, int& R, int& C) { const int st = b / 1024, sb = b % 1024, swz = sb ^ (((sb >> 9) & 1) << 5); R = (st >> 1) * 16 + swz / 64; C = (st & 1) * 32 + (swz % 64) / 2; }
__device__ __forceinline__ int perm32(int rho) { const int n = rho >> 4, i = rho & 15; return 8 * (i >> 2) + 4 * n + (i & 3); }
struct Unit { int pm, pn; };
struct Gemm { const bf16_t* A; const bf16_t* Bt; int M, N, K, lda, ldb; };
struct StaticOrder {
  int nM, nN, nwg, G, c;
  __device__ void init(int M, int N, int G_, int c_) { nM = M / BM; nN = N / BM; nwg = nM * nN; G = G_; c = c_; }
  __device__ bool next(int i, Unit& u) const {
    const long L = (long)i * G + c; if (L >= nwg) return false;
    int wgid = (int)L; { const int q = nwg / NXCD, r = nwg % NXCD, xcd = wgid % NXCD, off = wgid / NXCD; wgid = (xcd < r ? xcd * (q + 1) : r * (q + 1) + (xcd - r) * q) + off; }
    const int nig = WGM * nN, gid = wgid / nig, fm = gid * WGM, gsz = (nM - fm) < WGM ? (nM - fm) : WGM;
    u.pm = fm + ((wgid % nig) % gsz); u.pn = (wgid % nig) / gsz; return true;
  }
};

#ifndef PG8_SP2
#define PG8_SP2 true
#endif
#ifndef PG8_ALIGN
#define PG8_ALIGN true
#endif
template <class Epi, bool SP2 = PG8_SP2, bool ALIGN_EPI = PG8_ALIGN>
__device__ __forceinline__ void gemm_phase(LAS unsigned char* lds, const Gemm g, const StaticOrder& S, const Epi& E) {
  int tid_o = threadIdx.x; asm volatile("" : "+v"(tid_o));
  const int tid = tid_o, wid = __builtin_amdgcn_readfirstlane(tid >> 6), lane = tid & 63, wr = wid >> 2, wc = wid & 3, fr = lane & 15, fq = lane >> 4;
  const int K = g.K, nt = K / BK;
  unsigned voffA[2], voffB[2];
#pragma unroll
  for (int i = 0; i < 2; ++i) { int R, C; stage_rc(tid * 16 + i * 8192, R, C); const int Rb = Epi::PERM ? ((R & ~31) + perm32(R & 31)) : R;
    voffA[i] = (unsigned)(R * g.lda + C) * 2u; voffB[i] = (unsigned)(Rb * g.ldb + C) * 2u; }
  const size_t kstep = (size_t)(BK * 2);
  const size_t hstepA = (size_t)HALF * g.lda * 2, hstepB = (size_t)HALF * g.ldb * 2;
  const size_t tstepA = 2 * hstepA, tstepB = 2 * hstepB;
  const unsigned ldsw = (unsigned)wid * 1024u;
  const int aoff = lds_byte(wr * 64 + fr, fq * 8), boff = lds_byte(wc * 32 + fr, fq * 8);
#define PG8_SA(b, h) (((b) * 2 + (h)) * HTB)
#define PG8_SB(b, h) ((4 + (b) * 2 + (h)) * HTB)
#define PG8_STAGE(bufoff, gbase, voff) do { _Pragma("unroll") for (int _i = 0; _i < 2; ++_i) \
    __builtin_amdgcn_global_load_lds((const unsigned*)((const char*)(gbase) + (voff)[_i]), (LAS unsigned*)(lds + (bufoff) + ldsw + _i * 8192), 16, 0, 0); } while (0)
#define PG8_LDA(dst, b, h) do { _Pragma("unroll") for (int m = 0; m < 4; ++m) _Pragma("unroll") for (int k = 0; k < 2; ++k) dst[m][k] = *(const LAS bf16x8*)(lds + PG8_SA(b, h) + aoff + m * 2048 + k * 1024); } while (0)
#define PG8_LDB(dst, b, h) do { _Pragma("unroll") for (int n = 0; n < 2; ++n) _Pragma("unroll") for (int k = 0; k < 2; ++k) dst[n][k] = *(const LAS bf16x8*)(lds + PG8_SB(b, h) + boff + n * 2048 + k * 1024); } while (0)
#define PG8_MMA(ai, bj, At, Bt) do { __builtin_amdgcn_s_setprio(1); _Pragma("unroll") for (int m = 0; m < 4; ++m) _Pragma("unroll") for (int n = 0; n < 2; ++n) _Pragma("unroll") for (int k = 0; k < 2; ++k) \
    acc[ai][bj][m][n] = __builtin_amdgcn_mfma_f32_16x16x32_bf16(Bt[n][k], At[m][k], acc[ai][bj][m][n], 0, 0, 0); __builtin_amdgcn_s_setprio(0); } while (0)
#define PG8_WAIT_V(n) asm volatile("s_waitcnt vmcnt(" #n ")" ::: "memory")
#define PG8_WAIT_L(n) asm volatile("s_waitcnt lgkmcnt(" #n ")" ::: "memory")
#define PG8_BAR __builtin_amdgcn_s_barrier()
#define PG8_SCHED __builtin_amdgcn_sched_barrier(0)
  Unit cur, nxt; int ui = 0;
  if (!S.next(0, cur)) return;
  f32x4 acc[2][2][4][2];
  if constexpr (Epi::INIT) E.init(acc, cur, wr, wc, fr, fq);
  else {
#pragma unroll
  for (int a = 0; a < 2; ++a)
#pragma unroll
    for (int b = 0; b < 2; ++b)
#pragma unroll
      for (int m = 0; m < 4; ++m)
#pragma unroll
        for (int n = 0; n < 2; ++n) acc[a][b][m][n] = (f32x4){0.f, 0.f, 0.f, 0.f};
  }
  bf16x8 At[4][2], B0[2][2], B1[2][2];
  const char* cA = (const char*)g.A + (size_t)cur.pm * tstepA; const char* cB = (const char*)g.Bt + (size_t)cur.pn * tstepB;
  if constexpr (SP2) {
    PG8_STAGE(PG8_SB(0, 0), cB, voffB); PG8_STAGE(PG8_SB(0, 1), cB + hstepB, voffB); PG8_STAGE(PG8_SA(0, 0), cA, voffA); PG8_STAGE(PG8_SA(0, 1), cA + hstepA, voffA);
    if (wr == 1) PG8_BAR;
    PG8_WAIT_V(2); PG8_BAR;
    PG8_STAGE(PG8_SB(1, 0), cB + kstep, voffB); PG8_STAGE(PG8_SA(1, 0), cA + kstep, voffA); PG8_STAGE(PG8_SB(1, 1), cB + hstepB + kstep, voffB);
    PG8_WAIT_V(6); PG8_BAR;
  } else {
  PG8_STAGE(PG8_SB(0, 0), cB, voffB); PG8_STAGE(PG8_SA(0, 0), cA, voffA); PG8_STAGE(PG8_SB(0, 1), cB + hstepB, voffB); PG8_STAGE(PG8_SA(0, 1), cA + hstepA, voffA);
  if (wr == 1) PG8_BAR;
  PG8_WAIT_V(4); PG8_BAR;
  PG8_STAGE(PG8_SB(1, 0), cB + kstep, voffB); PG8_STAGE(PG8_SA(1, 0), cA + kstep, voffA); PG8_STAGE(PG8_SB(1, 1), cB + hstepB + kstep, voffB);
  PG8_WAIT_V(6); PG8_BAR;
  }
  for (;;) {
    const bool has_next = S.next(ui + 1, nxt);
    const char* nA = has_next ? (const char*)g.A + (size_t)nxt.pm * tstepA : cA; const char* nB = has_next ? (const char*)g.Bt + (size_t)nxt.pn * tstepB : cB;
    for (int t = 0; t < nt; t += 2) {
      const bool last = (t == nt - 2);
      const char* a1 = cA + (size_t)(t + 1) * kstep;
      const char* a2 = last ? nA : cA + (size_t)(t + 2) * kstep; const char* b2 = last ? nB : cB + (size_t)(t + 2) * kstep;
      const char* a3 = a2 + kstep; const char* b3 = b2 + kstep;
      if constexpr (SP2) {
      PG8_LDB(B0, 0, 0); PG8_LDB(B1, 0, 1); PG8_SCHED; PG8_LDA(At, 0, 0); PG8_STAGE(PG8_SA(1, 1), a1 + hstepA, voffA);
      PG8_WAIT_V(8); PG8_WAIT_L(0); PG8_BAR; PG8_MMA(0, 0, At, B0); PG8_MMA(0, 1, At, B1); PG8_BAR; PG8_SCHED;
      PG8_LDA(At, 0, 1); PG8_STAGE(PG8_SB(0, 0), b2, voffB); PG8_STAGE(PG8_SB(0, 1), b2 + hstepB, voffB); PG8_STAGE(PG8_SA(0, 0), a2, voffA);
      PG8_WAIT_V(8); PG8_WAIT_L(0); PG8_BAR; PG8_MMA(1, 0, At, B0); PG8_MMA(1, 1, At, B1); PG8_BAR; PG8_SCHED;
      PG8_LDB(B0, 1, 0); PG8_LDB(B1, 1, 1); PG8_SCHED; PG8_LDA(At, 1, 0); PG8_STAGE(PG8_SA(0, 1), a2 + hstepA, voffA);
      PG8_WAIT_V(8); PG8_WAIT_L(0); PG8_BAR; PG8_MMA(0, 0, At, B0); PG8_MMA(0, 1, At, B1); PG8_BAR; PG8_SCHED;
      PG8_LDA(At, 1, 1); PG8_STAGE(PG8_SB(1, 0), b3, voffB); PG8_STAGE(PG8_SB(1, 1), b3 + hstepB, voffB); PG8_STAGE(PG8_SA(1, 0), a3, voffA);
      PG8_WAIT_V(8); PG8_WAIT_L(0); PG8_BAR; PG8_MMA(1, 0, At, B0); PG8_MMA(1, 1, At, B1); PG8_BAR; PG8_SCHED;
      } else {
      PG8_LDB(B0, 0, 0); PG8_SCHED; PG8_LDA(At, 0, 0); PG8_STAGE(PG8_SA(1, 1), a1 + hstepA, voffA);
      PG8_WAIT_L(8); PG8_BAR; PG8_WAIT_L(0); PG8_MMA(0, 0, At, B0); PG8_BAR; PG8_SCHED;
      PG8_LDB(B1, 0, 1); PG8_STAGE(PG8_SB(0, 0), b2, voffB);
      PG8_BAR; PG8_WAIT_L(0); PG8_MMA(0, 1, At, B1); PG8_BAR;
      PG8_LDA(At, 0, 1); PG8_STAGE(PG8_SA(0, 0), a2, voffA);
      PG8_BAR; PG8_WAIT_L(0); PG8_MMA(1, 0, At, B0); PG8_BAR; PG8_SCHED;
      PG8_STAGE(PG8_SB(0, 1), b2 + hstepB, voffB);
      PG8_WAIT_V(6); PG8_BAR; PG8_MMA(1, 1, At, B1); PG8_BAR;
      PG8_LDB(B0, 1, 0); PG8_SCHED; PG8_LDA(At, 1, 0); PG8_STAGE(PG8_SA(0, 1), a2 + hstepA, voffA);
      PG8_WAIT_L(8); PG8_BAR; PG8_WAIT_L(0); PG8_MMA(0, 0, At, B0); PG8_BAR; PG8_SCHED;
      PG8_LDB(B1, 1, 1); PG8_STAGE(PG8_SB(1, 0), b3, voffB);
      PG8_BAR; PG8_WAIT_L(0); PG8_MMA(0, 1, At, B1); PG8_BAR;
      PG8_LDA(At, 1, 1); PG8_STAGE(PG8_SA(1, 0), a3, voffA);
      PG8_BAR; PG8_WAIT_L(0); PG8_MMA(1, 0, At, B0); PG8_BAR; PG8_SCHED;
      PG8_STAGE(PG8_SB(1, 1), b3 + hstepB, voffB);
      PG8_WAIT_V(6); PG8_BAR; PG8_MMA(1, 1, At, B1); PG8_BAR;
      }
    }
    if constexpr (ALIGN_EPI) { if (wr == 0) PG8_BAR; }
    E(acc, cur, wr, wc, fr, fq);
    if (!has_next) break;
    if constexpr (Epi::INIT) E.init(acc, nxt, wr, wc, fr, fq);
    else {
#pragma unroll
    for (int a = 0; a < 2; ++a)
#pragma unroll
      for (int b = 0; b < 2; ++b)
#pragma unroll
        for (int m = 0; m < 4; ++m)
#pragma unroll
          for (int n = 0; n < 2; ++n) acc[a][b][m][n] = (f32x4){0.f, 0.f, 0.f, 0.f};
    }
    cur = nxt; cA = nA; cB = nB; ++ui;
    if constexpr (ALIGN_EPI) { if (wr == 1) PG8_BAR; }
  }
  PG8_WAIT_V(0);
  if constexpr (!ALIGN_EPI) { if (wr == 0) PG8_BAR; }
  PG8_BAR;
#undef PG8_SA
#undef PG8_SB
#undef PG8_STAGE
#undef PG8_LDA
#undef PG8_LDB
#undef PG8_MMA
#undef PG8_WAIT_V
#undef PG8_WAIT_L
#undef PG8_BAR
#undef PG8_SCHED
}
}
using pg8::Unit; using pg8::HALF;
typedef f32x4 Acc[2][2][4][2];

struct EpiG {
  static constexpr bool PERM = true, INIT = false;
  bf16_t* O; int ldc;
  const float* rss; float rinvD;
  const float* css; float cinvD;
  int gelu_hi;
  int ss_lo, ss_hi; float* ssacc;
  int rope_mode;
  const f32x2* cs;
  int sc_lo; float sc_val;
  __device__ __forceinline__ void operator()(Acc& acc, const Unit& u, int wr, int wc, int fr, int fq) const {
    const int ct = u.pn * 256;
    const bool do_gelu = ct < gelu_hi, do_ss = (ct >= ss_lo && ct < ss_hi), do_sc = ct >= sc_lo;
    float rsv[2][4];
#pragma unroll
    for (int ai = 0; ai < 2; ++ai)
#pragma unroll
      for (int m = 0; m < 4; ++m) rsv[ai][m] = rss ? rss[u.pm * 256 + ai * HALF + wr * 64 + m * 16 + fr] : 1.0f;
    f32x4 cq[2][2];
#pragma unroll
    for (int bj = 0; bj < 2; ++bj) { const int c0 = ct + bj * HALF + wc * 32 + 8 * fq;
      cq[bj][0] = css ? *(const f32x4*)(css + c0) : (f32x4){1.f, 1.f, 1.f, 1.f}; cq[bj][1] = css ? *(const f32x4*)(css + c0 + 4) : (f32x4){1.f, 1.f, 1.f, 1.f}; }
    if (rss) {
#pragma unroll
      for (int ai = 0; ai < 2; ++ai)
#pragma unroll
        for (int m = 0; m < 4; ++m) rsv[ai][m] = __builtin_amdgcn_rsqf(rsv[ai][m] * rinvD + EPS);
    }
    if (css) {
#pragma unroll
      for (int bj = 0; bj < 2; ++bj)
#pragma unroll
        for (int h = 0; h < 2; ++h)
#pragma unroll
          for (int j = 0; j < 4; ++j) cq[bj][h][j] = __builtin_amdgcn_rsqf(cq[bj][h][j] * cinvD + EPS);
    }
#pragma unroll
    for (int ai = 0; ai < 2; ++ai)
#pragma unroll
      for (int m = 0; m < 4; ++m) {
        const int row = u.pm * 256 + ai * HALF + wr * 64 + m * 16 + fr;
        const float rs = rsv[ai][m];
        float ss = 0.f;
#pragma unroll
        for (int bj = 0; bj < 2; ++bj) {
          const int c0 = ct + bj * HALF + wc * 32 + 8 * fq;
          f32x4 v0 = acc[ai][bj][m][0] * rs, v1 = acc[ai][bj][m][1] * rs;
          if (css) { v0 = v0 * cq[bj][0]; v1 = v1 * cq[bj][1]; }
          if (do_gelu) { v0 = gelu4(v0); v1 = gelu4(v1); }
          if (do_ss) ss += (v0[0] * v0[0] + v0[1] * v0[1]) + (v0[2] * v0[2] + v0[3] * v0[3]) + (v1[0] * v1[0] + v1[1] * v1[1]) + (v1[2] * v1[2] + v1[3] * v1[3]);
          int roff = -1;
          if (rope_mode == 1) { const int d = c0 % 192; if (d >= 128) roff = d - 128; }
          else if (rope_mode == 2) { if (c0 >= 512 && c0 < 576) roff = c0 - 512; }
          if (roff >= 0) {
            const f32x2* t = cs + (size_t)row * 32 + (roff >> 1);
            const f32x2 t0 = t[0], t1 = t[1], t2 = t[2], t3 = t[3];
            f32x4 w0, w1;
            w0[0] = v0[0] * t0.x - v0[1] * t0.y; w0[1] = v0[1] * t0.x + v0[0] * t0.y;
            w0[2] = v0[2] * t1.x - v0[3] * t1.y; w0[3] = v0[3] * t1.x + v0[2] * t1.y;
            w1[0] = v1[0] * t2.x - v1[1] * t2.y; w1[1] = v1[1] * t2.x + v1[0] * t2.y;
            w1[2] = v1[2] * t3.x - v1[3] * t3.y; w1[3] = v1[3] * t3.x + v1[2] * t3.y;
            v0 = w0; v1 = w1;
          }
          if (do_sc) { v0 = v0 * sc_val; v1 = v1 * sc_val; }
          u32x4 w; w.x = cvt_pk_bf16(v0[0], v0[1]); w.y = cvt_pk_bf16(v0[2], v0[3]); w.z = cvt_pk_bf16(v1[0], v1[1]); w.w = cvt_pk_bf16(v1[2], v1[3]);
          *(u32x4*)(O + (size_t)row * ldc + c0) = w;
        }
        if (do_ss) { ss += __shfl_xor(ss, 16); ss += __shfl_xor(ss, 32); if (fq == 0) atomicAdd(ssacc + row, ss); }
      }
  }
};

struct EpiRes {
  static constexpr bool PERM = false, INIT = true;
  const float* xold; float* xnew; bf16_t* xb; float* ssacc;
  __device__ __forceinline__ void init(Acc& acc, const Unit& u, int wr, int wc, int fr, int fq) const {
    const int col0 = u.pn * 256 + wc * 32 + 4 * fq;
#pragma unroll
    for (int ai = 0; ai < 2; ++ai)
#pragma unroll
      for (int bj = 0; bj < 2; ++bj)
#pragma unroll
        for (int m = 0; m < 4; ++m)
#pragma unroll
          for (int n = 0; n < 2; ++n) {
            const int row = u.pm * 256 + ai * HALF + wr * 64 + m * 16 + fr;
            acc[ai][bj][m][n] = *(const f32x4*)(xold + (size_t)row * DM + col0 + bj * HALF + n * 16);
          }
  }
  __device__ __forceinline__ void operator()(Acc& acc, const Unit& u, int wr, int wc, int fr, int fq) const {
    const int col0 = u.pn * 256 + wc * 32 + 4 * fq;
#pragma unroll
    for (int ai = 0; ai < 2; ++ai)
#pragma unroll
      for (int m = 0; m < 4; ++m) {
        const int row = u.pm * 256 + ai * HALF + wr * 64 + m * 16 + fr;
        float ss = 0.f;
#pragma unroll
        for (int bj = 0; bj < 2; ++bj)
#pragma unroll
          for (int n = 0; n < 2; ++n) {
            const size_t off = (size_t)row * DM + col0 + bj * HALF + n * 16;
            const f32x4 v = acc[ai][bj][m][n];
            *(f32x4*)(xnew + off) = v;
            u32x2 w; w.x = cvt_pk_bf16(v[0], v[1]); w.y = cvt_pk_bf16(v[2], v[3]);
            *(u32x2*)(xb + off) = w;
            ss += (v[0] * v[0] + v[1] * v[1]) + (v[2] * v[2] + v[3] * v[3]);
          }
        ss += __shfl_xor(ss, 16); ss += __shfl_xor(ss, 32);
        if (fq == 0) atomicAdd(ssacc + row, ss);
      }
  }
};

struct EpiUp {
  static constexpr bool PERM = true, INIT = false;
  bf16_t* g; float* halo; const float* rss; const float* cw; const float* cb; LAS unsigned char* epl;
  __device__ __forceinline__ void operator()(Acc& acc, const Unit& u, int wr, int wc, int fr, int fq) const {
    const int rowb = u.pm * 256 + wr * 64;
    const int c0 = u.pn * 128 + wc * 32 + 8 * fq;
    float rr[2][4];
#pragma unroll
    for (int ai = 0; ai < 2; ++ai)
#pragma unroll
      for (int m = 0; m < 4; ++m) rr[ai][m] = rss[rowb + ai * HALF + m * 16 + fr];
    LAS unsigned char* wl = epl + (wr * 4 + wc) * 1024;
    { const int lane = fq * 16 + fr, arr = lane >> 3, part = lane & 7, col = u.pn * 128 + wc * 32 + 4 * part;
      const float* sp = ((arr & 3) == 3 ? cb : cw + (size_t)(arr & 3) * DFF2) + (arr >> 2) * DFF + col;
      const f32x4 wv = *(const f32x4*)sp;
      *(LAS f32x4*)(wl + lane * 16) = wv; }
#pragma unroll
    for (int ai = 0; ai < 2; ++ai)
#pragma unroll
      for (int m = 0; m < 4; ++m) {
        const float r = __builtin_amdgcn_rsqf(rr[ai][m] * (1.0f / DM) + EPS);
#pragma unroll
        for (int bj = 0; bj < 2; ++bj)
#pragma unroll
          for (int n = 0; n < 2; ++n) acc[ai][bj][m][n] = acc[ai][bj][m][n] * r;
      }
    asm volatile("s_waitcnt lgkmcnt(0)" ::: "memory");
#pragma unroll
    for (int n = 0; n < 2; ++n) {
      const int cc = c0 + 4 * n;
      const LAS unsigned char* wp = wl + (8 * fq + 4 * n) * 4;
      const f32x4 wg0 = *(const LAS f32x4*)(wp), wg1 = *(const LAS f32x4*)(wp + 128), wg2 = *(const LAS f32x4*)(wp + 256), bg = *(const LAS f32x4*)(wp + 384);
      const f32x4 wv0 = *(const LAS f32x4*)(wp + 512), wv1 = *(const LAS f32x4*)(wp + 640), wv2 = *(const LAS f32x4*)(wp + 768), bv = *(const LAS f32x4*)(wp + 896);
#pragma unroll
      for (int ai = 0; ai < 2; ++ai) {
        f32x4 g1p = (f32x4){0.f, 0.f, 0.f, 0.f}, g2p = g1p, v1p = g1p, v2p = g1p;
#pragma unroll
        for (int m = 0; m < 4; ++m) {
          const f32x4 G = acc[ai][0][m][n], V = acc[ai][1][m][n];
          const f32x4 pg1 = shr1ov(g1p, G), pg2 = shr2ov(g2p, G), pv1 = shr1ov(v1p, V), pv2 = shr2ov(v2p, V);
          const f32x4 cgt = wg2 * G + wg1 * pg1 + wg0 * pg2 + bg;
          const f32x4 cvl = wv2 * V + wv1 * pv1 + wv0 * pv2 + bv;
          if (m < 3) { g1p = ror1v(G); g2p = ror2v(G); v1p = ror1v(V); v2p = ror2v(V); }
          const int row = rowb + ai * HALF + m * 16 + fr;
          if (m > 0 || fr >= 2) {
            u32x2 w; w.x = cvt_pk_bf16(silu1(cgt[0]) * cvl[0], silu1(cgt[1]) * cvl[1]); w.y = cvt_pk_bf16(silu1(cgt[2]) * cvl[2], silu1(cgt[3]) * cvl[3]);
            *(u32x2*)(g + (size_t)row * DFF + cc) = w;
          }
          int slot = -1;
          if (m == 0 && fr < 2) slot = fr;
          if (m == 3 && fr >= 14) slot = fr - 12;
          if (slot >= 0) {
            float* hp = halo + ((size_t)(row >> 6) * 4 + slot) * DFF2 + cc;
            *(f32x4*)hp = G; *(f32x4*)(hp + DFF) = V;
          }
        }
      }
    }
  }
};

constexpr int ATT_KBUF = 64 * 400, ATT_VROWB = 136, ATT_VBUF = 128 * ATT_VROWB, ATT_BUF = ATT_KBUF + ATT_VBUF;
template <int DQK, bool CAUSAL>
__device__ __forceinline__ void attn_unit(LAS unsigned char* lds, const bf16_t* Q, int ldq, const bf16_t* K1, int ldk1, const bf16_t* K2, int ldk2,
                                          const bf16_t* VT, int ldv, int ntiles, int q0, bf16_t* O, int ldo) {
  constexpr int KROWB = (DQK + 8) * 2, NKS = DQK / 16, CPR = DQK / 8, NKCH = 64 * CPR / 512;
  int tid_o = threadIdx.x; asm volatile("" : "+v"(tid_o));
  const int tid = tid_o, wid = __builtin_amdgcn_readfirstlane(tid >> 6), lane = tid & 63, r32 = lane & 31, hi = lane >> 5;
  bf16x8 qf[NKS];
  { const bf16_t* qp = Q + (size_t)(wid * 32 + r32) * ldq + hi * 8;
#pragma unroll
    for (int ks = 0; ks < NKS; ++ks) qf[ks] = *(const bf16x8*)(qp + ks * 16); }
  u32x4 kreg[NKCH], vreg[2];
#define ATT_GLOAD(t_) do { const int k0_ = (t_) * 64; \
    _Pragma("unroll") for (int i = 0; i < NKCH; ++i) { const int ch = tid + i * 512, kr = ch / CPR, kc = ch - kr * CPR; \
      const bf16_t* src = (DQK == 128 || kc < 16) ? K1 + (size_t)(k0_ + kr) * ldk1 + kc * 8 : K2 + (size_t)(k0_ + kr) * ldk2 + (kc - 16) * 8; \
      kreg[i] = *(const u32x4*)src; } \
    _Pragma("unroll") for (int i = 0; i < 2; ++i) { const int ch = tid + i * 512, d = ch >> 3, cc = ch & 7; vreg[i] = *(const u32x4*)(VT + (size_t)d * ldv + k0_ + cc * 8); } } while (0)
#define ATT_LWRITE(buf_) do { LAS unsigned char* kb_ = lds + (buf_) * ATT_BUF; \
    _Pragma("unroll") for (int i = 0; i < NKCH; ++i) { const int ch = tid + i * 512, kr = ch / CPR, kc = ch - kr * CPR; *(LAS u32x4*)(kb_ + kr * KROWB + kc * 16) = kreg[i]; } \
    _Pragma("unroll") for (int i = 0; i < 2; ++i) { const int ch = tid + i * 512, d = ch >> 3, cc = ch & 7; LAS unsigned char* p = kb_ + ATT_KBUF + d * ATT_VROWB + cc * 16; \
      *(LAS u32x2*)p = (u32x2){vreg[i].x, vreg[i].y}; *(LAS u32x2*)(p + 8) = (u32x2){vreg[i].z, vreg[i].w}; } } while (0)
  f32x16 o[4];
#pragma unroll
  for (int d = 0; d < 4; ++d)
#pragma unroll
    for (int i = 0; i < 16; ++i) o[d][i] = 0.f;
  float mrow = 0.f, lsum = 0.f;
  const int qabs = q0 + wid * 32 + r32, qlo = q0 + wid * 32;
  ATT_GLOAD(0); ATT_LWRITE(0); __syncthreads();
  for (int t = 0; t < ntiles; ++t) {
    const int buf = t & 1;
    if (t + 1 < ntiles) ATT_GLOAD(t + 1);
    const int k0 = t * 64;
    if (!CAUSAL || k0 <= qlo + 31) {
      const LAS unsigned char* kb = lds + buf * ATT_BUF;
      const bool first = (t == 0);
      const float nm = first ? 0.f : -mrow;
      f32x16 s0, s1;
#pragma unroll
      for (int i = 0; i < 16; ++i) { s0[i] = nm; s1[i] = nm; }
#pragma unroll
      for (int ks = 0; ks < NKS; ++ks) {
        const bf16x8 ka = *(const LAS bf16x8*)(kb + r32 * KROWB + ks * 32 + hi * 16);
        const bf16x8 kc = *(const LAS bf16x8*)(kb + (32 + r32) * KROWB + ks * 32 + hi * 16);
        s0 = __builtin_amdgcn_mfma_f32_32x32x16_bf16(ka, qf[ks], s0, 0, 0, 0);
        s1 = __builtin_amdgcn_mfma_f32_32x32x16_bf16(kc, qf[ks], s1, 0, 0, 0);
      }
      if (CAUSAL && k0 + 63 > qlo) {
#pragma unroll
        for (int i = 0; i < 16; ++i) { const int kv = k0 + (i & 3) + 8 * (i >> 2) + 4 * hi;
          if (kv > qabs) s0[i] = -INFINITY; if (kv + 32 > qabs) s1[i] = -INFINITY; }
      }
      float mx = s0[0];
#pragma unroll
      for (int i = 1; i < 16; ++i) mx = fmaxf(mx, s0[i]);
#pragma unroll
      for (int i = 0; i < 16; ++i) mx = fmaxf(mx, s1[i]);
      mx = fmaxf(mx, __shfl_xor(mx, 32));
      const bool need = first || (mx > 8.0f);
      if (__ballot(need) != 0ull) {
        const float d = need ? mx : 0.f;
        const float alpha = first ? 0.f : __builtin_amdgcn_exp2f(-d);
        mrow = first ? mx : mrow + d;
        lsum *= alpha;
#pragma unroll
        for (int dd = 0; dd < 4; ++dd)
#pragma unroll
          for (int i = 0; i < 16; ++i) o[dd][i] *= alpha;
#pragma unroll
        for (int i = 0; i < 16; ++i) { s0[i] -= d; s1[i] -= d; }
      }
      float ps = 0.f;
#pragma unroll
      for (int i = 0; i < 16; ++i) { s0[i] = __builtin_amdgcn_exp2f(s0[i]); s1[i] = __builtin_amdgcn_exp2f(s1[i]); ps += s0[i] + s1[i]; }
      lsum += ps;
      bf16x8 pa[4];
#pragma unroll
      for (int s = 0; s < 4; ++s) {
        u32x4 w;
        if (s < 2) { w.x = cvt_pk_bf16(s0[8 * s + 0], s0[8 * s + 1]); w.y = cvt_pk_bf16(s0[8 * s + 2], s0[8 * s + 3]); w.z = cvt_pk_bf16(s0[8 * s + 4], s0[8 * s + 5]); w.w = cvt_pk_bf16(s0[8 * s + 6], s0[8 * s + 7]); }
        else { const int b = 8 * (s - 2); w.x = cvt_pk_bf16(s1[b + 0], s1[b + 1]); w.y = cvt_pk_bf16(s1[b + 2], s1[b + 3]); w.z = cvt_pk_bf16(s1[b + 4], s1[b + 5]); w.w = cvt_pk_bf16(s1[b + 6], s1[b + 7]); }
        pa[s] = __builtin_bit_cast(bf16x8, w);
      }
      const LAS unsigned char* vb = kb + ATT_KBUF;
#pragma unroll
      for (int d = 0; d < 4; ++d)
#pragma unroll
        for (int s = 0; s < 4; ++s) {
          const LAS unsigned char* p = vb + (32 * d + r32) * ATT_VROWB + (16 * s + 4 * hi) * 2;
          const u32x2 lo = *(const LAS u32x2*)p, hh = *(const LAS u32x2*)(p + 16);
          const bf16x8 vf = __builtin_bit_cast(bf16x8, (u32x4){lo.x, lo.y, hh.x, hh.y});
          o[d] = __builtin_amdgcn_mfma_f32_32x32x16_bf16(vf, pa[s], o[d], 0, 0, 0);
        }
    }
    if (t + 1 < ntiles) ATT_LWRITE(buf ^ 1);
    __syncthreads();
  }
#undef ATT_GLOAD
#undef ATT_LWRITE
  const float inv = 1.0f / (lsum + __shfl_xor(lsum, 32));
  bf16_t* op = O + (size_t)(wid * 32 + r32) * ldo + 4 * hi;
#pragma unroll
  for (int d = 0; d < 4; ++d)
#pragma unroll
    for (int ig = 0; ig < 4; ++ig) {
      u32x2 w; w.x = cvt_pk_bf16(o[d][4 * ig] * inv, o[d][4 * ig + 1] * inv); w.y = cvt_pk_bf16(o[d][4 * ig + 2] * inv, o[d][4 * ig + 3] * inv);
      *(u32x2*)(op + 32 * d + 8 * ig) = w;
    }
}


#define XB_TMO      128
#define XB_XCNT(j)  (256  + 64 * (j))
#define XB_XSUB(j)  (1280 + 64 * (j))
#define XB_XGEN(j)  (2304 + 64 * (j))
#define XB_TOP      3328
#define XB_TOPGEN   3392
#define XCD_BAR_WORDS 3456
#define XB_SPIN_CAP (1u << 18)
__device__ __forceinline__ unsigned xb_ld(unsigned* p)              { return __hip_atomic_load(p, __ATOMIC_RELAXED, __HIP_MEMORY_SCOPE_AGENT); }
__device__ __forceinline__ unsigned xb_add(unsigned* p, unsigned v) { return __hip_atomic_fetch_add(p, v, __ATOMIC_RELAXED, __HIP_MEMORY_SCOPE_AGENT); }
__device__ __forceinline__ unsigned xb_xcc_id() { return (unsigned)__builtin_amdgcn_s_getreg((3 << 11) | 20) & 0xFu; }
#define XB_SPIN(cond, bar) do { unsigned _sp = 0; while (cond) { __builtin_amdgcn_s_sleep(1); \
    if ((++_sp & 255u) == 0u) { if (xb_ld(&(bar)[XB_TMO])) break; if (_sp > XB_SPIN_CAP) { atomicAdd(&(bar)[XB_TMO], 1u); break; } } } } while (0)
struct XcdBarrier { unsigned* bar; unsigned x; volatile LAS unsigned* st; };
__device__ __forceinline__ XcdBarrier xcd_barrier_post(unsigned* bar, volatile LAS unsigned* st) {
  XcdBarrier b; b.bar = bar; b.x = xb_xcc_id(); b.st = st;
  if (threadIdx.x == 0) (void)xb_add(&bar[XB_XCNT(b.x)], 1u);
  return b;
}
__device__ __forceinline__ void xcd_barrier_complete(unsigned* bar, unsigned x, unsigned& nloc, unsigned& nx) {
  const unsigned G = gridDim.x * gridDim.y * gridDim.z;
  unsigned sum, cnt, mine, sp = 0u;
  for (;;) {
    sum = 0u; cnt = 0u; mine = 0u;
#pragma unroll
    for (unsigned j = 0; j < 16; ++j) { const unsigned c = xb_ld(&bar[XB_XCNT(j)]); sum += c; cnt += (c > 0u) ? 1u : 0u; mine = (j == x) ? c : mine; }
    if (sum == G) break;
    __builtin_amdgcn_s_sleep(1);
    if ((++sp & 255u) == 0u) { if (xb_ld(&bar[XB_TMO])) break; if (sp > XB_SPIN_CAP) { atomicAdd(&bar[XB_TMO], 1u); break; } }
  }
  nloc = mine > 0u ? mine : 1u; nx = cnt > 0u ? cnt : 1u;
}
__device__ __forceinline__ void xcd_barrier(const XcdBarrier& b) {
  asm volatile("s_waitcnt vmcnt(0)" ::: "memory");
  __syncthreads();
  if (threadIdx.x == 0) {
    unsigned* bar = b.bar;
    __builtin_amdgcn_s_waitcnt(0);
    unsigned nloc = b.st[0], nx = b.st[1];
    if (nloc == 0u) { xcd_barrier_complete(bar, b.x, nloc, nx); b.st[0] = nloc; b.st[1] = nx; }
    const unsigned old = xb_add(&bar[XB_XSUB(b.x)], 1u);
    const unsigned gen = old / nloc;
    if (old + 1u == (gen + 1u) * nloc) {
      __builtin_amdgcn_fence(__ATOMIC_RELEASE, "agent");
      asm volatile("s_waitcnt vmcnt(0)" ::: "memory");
      const unsigned og = xb_add(&bar[XB_TOP], 1u);
      const unsigned tg = og / nx;
      if (og + 1u == (tg + 1u) * nx) xb_add(&bar[XB_TOPGEN], 1u);
      else XB_SPIN(xb_ld(&bar[XB_TOPGEN]) == tg, bar);
      __builtin_amdgcn_fence(__ATOMIC_ACQUIRE, "agent");
      xb_add(&bar[XB_XGEN(b.x)], 1u);
      asm volatile("s_waitcnt vmcnt(0)" ::: "memory");
    } else {
      XB_SPIN(xb_ld(&bar[XB_XGEN(b.x)]) == gen, bar);
      __builtin_amdgcn_fence(__ATOMIC_ACQUIRE, "agent");
      asm volatile("s_waitcnt vmcnt(0)" ::: "memory");
    }
  }
  __syncthreads();
}

constexpr int NWD = 27;
struct WDesc { const float* src; const float* scale; bf16_t* dst; int K, Ns, Nd, kind, item0, pad; };
struct Args { const float* in[25]; float* out; unsigned char* ws; WDesc wd[NWD]; int nitems; int pad; };

__device__ __forceinline__ int srccol(int kind, int n) {
  if (kind == 0) return n;
  if (kind == 1) { if (n < 512) return n; if (n < 576) { const int r = n - 512; return 512 + ((r & 1) ? 32 : 0) + (r >> 1); } return -1; }
  if (kind == 2) { const int h = n / 192, d = n - h * 192; if (d < 128) return n; const int r = d - 128; return h * 192 + 128 + ((r & 1) ? 32 : 0) + (r >> 1); }
  { const int t = n >> 8, w = n & 255; return (w >> 7) * DFF + 128 * t + (w & 127); }
}

constexpr int LDS_BYTES = 140 * 1024;
#ifndef ONLY
#define ONLY 0
#endif
#define EN(k) (ONLY == 0 || ONLY == (k))
typedef __attribute__((address_space(4))) const Args CArgs;
#define DERIVE_PTRS(ap) \
  unsigned char* ws = (ap)->ws; \
  float* rsA = (float*)(ws + WS_RS); float* rsB = rsA + MTOK; float* rsV = rsB + MTOK; float* rsQ = rsV + MTOK; float* rsKV = rsQ + MTOK; float* rsM = rsKV + MTOK; \
  f32x2* cs = (f32x2*)(ws + WS_CS); \
  bf16_t* memb = (bf16_t*)(ws + WS_MEMB); bf16_t* memk = (bf16_t*)(ws + WS_MEMK); bf16_t* memvt = (bf16_t*)(ws + WS_MEMVT); \
  bf16_t* xb = (bf16_t*)(ws + WS_XB); bf16_t* kvb = (bf16_t*)(ws + WS_KVB); bf16_t* kn = (bf16_t*)(ws + WS_KN); bf16_t* vT = (bf16_t*)(ws + WS_VT); \
  float* halo = (float*)(ws + WS_HALO); \
  bf16_t* gbuf = (bf16_t*)(ws + WS_R); bf16_t* zbuf = (bf16_t*)(ws + WS_R); bf16_t* cat = (bf16_t*)(ws + WS_CAT); bf16_t* qbuf = (bf16_t*)(ws + WS_Q); \
  const float* x_in = (ap)->in[0]; float* xo = (ap)->out; \
  (void)rsA; (void)rsB; (void)rsV; (void)rsQ; (void)rsKV; (void)rsM; (void)cs; (void)memb; (void)memk; (void)memvt; (void)xb; (void)kvb; (void)kn; (void)vT; (void)halo; (void)gbuf; (void)zbuf; (void)cat; (void)qbuf; (void)x_in; (void)xo;
__global__ void __launch_bounds__(512, 2) yoco_fwd(Args a) {
  extern __shared__ __attribute__((aligned(16))) unsigned char lds_raw[];
  LAS unsigned char* lds = (LAS unsigned char*)lds_raw;
  cg::grid_group grid = cg::this_grid();
  volatile LAS unsigned* xst = (volatile LAS unsigned*)(lds + 131072 + 64);
  if (threadIdx.x < 4) xst[threadIdx.x] = 0u;
  __syncthreads();
#define DERIVE_IDS \
  int tid_o = threadIdx.x; asm volatile("" : "+v"(tid_o)); \
  const int tid = tid_o, lane = tid & 63, wave = __builtin_amdgcn_readfirstlane(tid >> 6); \
  const int G = gridDim.x, bx = blockIdx.x; \
  const int vcu = (G % 8 == 0) ? (bx % 8) * (G / 8) + bx / 8 : bx; \
  const int gw = vcu * 8 + wave, NGW = G * 8; \
  const size_t gtid = (size_t)bx * 512 + tid, NGT = (size_t)G * 512; \
  (void)lane; (void)wave; (void)vcu; (void)gw; (void)NGW; (void)gtid; (void)NGT;
  {
    const Args* ap = &a; DERIVE_PTRS(ap)
    DERIVE_IDS
    LAS float* scr = (LAS float*)(lds + wave * 8448);
    for (int it = gw; it < a.nitems; it += NGW) {
      int di = 0;
#pragma unroll 1
      for (int j = 1; j < NWD; ++j) if (it >= a.wd[j].item0) di = j;
      const float* src = a.wd[di].src; const float* scale = a.wd[di].scale; bf16_t* dst = a.wd[di].dst;
      const int K = a.wd[di].K, Ns = a.wd[di].Ns, Nd = a.wd[di].Nd, kind = a.wd[di].kind, item = it - a.wd[di].item0;
      const int nblk = Nd / 32, kb = item / nblk, nb = item - kb * nblk, k0 = 64 * kb, n0 = 32 * nb;
      const int sc = srccol(kind, n0 + (lane & 31));
      float wv[32];
      { const float* sp = src + (size_t)(k0 + (lane >> 5)) * Ns + (sc >= 0 ? sc : 0);
#pragma unroll
        for (int i = 0; i < 32; ++i) wv[i] = sp[(size_t)(2 * i) * Ns]; }
      if (scale) {
#pragma unroll
        for (int i = 0; i < 32; ++i) wv[i] *= scale[k0 + 2 * i + (lane >> 5)];
      }
#pragma unroll
      for (int i = 0; i < 32; ++i) scr[(2 * i + (lane >> 5)) * 33 + (lane & 31)] = (sc >= 0) ? wv[i] : 0.f;
      asm volatile("s_waitcnt lgkmcnt(0)" ::: "memory");
      const int c = lane & 7;
#pragma unroll
      for (int j = 0; j < 4; ++j) { const int n = (lane >> 3) + 8 * j; const LAS float* s = scr + (8 * c) * 33 + n;
        u32x4 o; o.x = cvt_pk_bf16(s[0 * 33], s[1 * 33]); o.y = cvt_pk_bf16(s[2 * 33], s[3 * 33]); o.z = cvt_pk_bf16(s[4 * 33], s[5 * 33]); o.w = cvt_pk_bf16(s[6 * 33], s[7 * 33]);
        *(u32x4*)(dst + (size_t)(n0 + n) * K + k0 + 8 * c) = o; }
      asm volatile("s_waitcnt lgkmcnt(0)" ::: "memory");
    }
    for (int r = gw; r < MTOK + MMEM; r += NGW) {
      const bool ism = r >= MTOK; const int rr = ism ? r - MTOK : r;
      const f32x4* xr = (const f32x4*)((ism ? a.in[1] : x_in) + (size_t)rr * DM) + lane;
      u32x2* o8 = (u32x2*)((ism ? memb : xb) + (size_t)rr * DM) + lane;
      float s = 0.f;
#pragma unroll
      for (int j = 0; j < 8; ++j) { const f32x4 v = xr[64 * j]; s += (v[0] * v[0] + v[1] * v[1]) + (v[2] * v[2] + v[3] * v[3]); u32x2 w; w.x = cvt_pk_bf16(v[0], v[1]); w.y = cvt_pk_bf16(v[2], v[3]); o8[64 * j] = w; }
      s = wave_sum(s);
      if (lane == 0) (ism ? rsM : rsA)[rr] = s;
    }
    const int* pos = (const int*)a.in[2];
    for (size_t i = gtid; i < (size_t)MTOK * 32; i += NGT) {
      const int row = (int)(i >> 5), j = (int)(i & 31);
      const float inv = 1.0f / powf(10000.0f, (float)(2 * j) / 64.0f);
      const float ang = (float)pos[row] * inv;
      const double rev = (double)ang * 0.15915494309189535;
      const float fr = (float)(rev - floor(rev));
      cs[i] = (f32x2){__builtin_amdgcn_cosf(fr), __builtin_amdgcn_sinf(fr)};
    }
    for (size_t i = gtid; i < (size_t)MTOK * 4; i += NGT) rsB[i] = 0.f;
    if (bx == 0) for (int i = tid; i < XCD_BAR_WORDS; i += 512) ((unsigned*)ws)[i] = 0u;
  }
  grid.sync();
  const XcdBarrier xbar = xcd_barrier_post((unsigned*)a.ws, xst);

  pg8::StaticOrder S;
#pragma unroll 1
  for (int l = -1; l < 4; ++l) {
    const bool isA = l < 2; const int j = l - 2;
#pragma unroll 1
    for (int s = 0; s < 10; ++s) {
      CArgs* ap = (CArgs*)__builtin_amdgcn_kernarg_segment_ptr(); asm volatile("" : "+s"(ap));
      DERIVE_PTRS(ap)
      DERIVE_IDS
      int type = 0; bool sync = false;
      pg8::Gemm g{nullptr, nullptr, 0, 0, 0, 0, 0}; int corder = bx;
      EpiG eg{nullptr, 0, nullptr, 0.f, nullptr, 0.f, 0, 0, 0, nullptr, 0, nullptr, 1 << 30, 1.f};
      EpiRes er{nullptr, nullptr, xb, nullptr};
      if (l < 0) {
        if (s < 8) {
          const int ml = s >> 1; const bf16_t* wt = ap->wd[9 + ml].dst;
          type = 1; corder = (bx + 16 * s) % G; sync = (s == 7);
          if (!(s & 1)) { g = pg8::Gemm{memb, wt, MMEM, 512, DM, DM, DM}; eg.O = memk + (size_t)ml * MMEM * 512; eg.ldc = 512; eg.rss = rsM; eg.rinvD = 1.0f / DM; }
          else { g = pg8::Gemm{wt + (size_t)512 * DM, memb, 512, MMEM, DM, DM, DM}; eg.O = memvt + (size_t)ml * 512 * MMEM; eg.ldc = MMEM; eg.css = rsM; eg.cinvD = 1.0f / DM; }
        }
      } else {
        switch (s) {
          case 0: if (l == 2) { type = 1; sync = true;
              g = pg8::Gemm{xb, ap->wd[4].dst, MTOK, KVW, DM, DM, DM};
              eg.O = kvb; eg.ldc = KVW; eg.rss = rsA; eg.rinvD = 1.0f / DM; eg.ss_lo = 0; eg.ss_hi = 512; eg.ssacc = rsKV; eg.rope_mode = 2; eg.cs = cs; } break;
          case 1: type = 1; eg.O = zbuf; eg.rss = rsA; eg.rinvD = 1.0f / DM; eg.sc_val = SC_MEM;
            if (isA) { sync = true; g = pg8::Gemm{xb, ap->wd[l].dst, MTOK, ZA_W, DM, DM, DM}; eg.ldc = ZA_W; eg.gelu_hi = 2 * GW; eg.ss_lo = GW; eg.ss_hi = 2 * GW; eg.ssacc = rsV; eg.sc_lo = 2 * GW; }
            else { g = pg8::Gemm{xb, ap->wd[2 + j].dst, MTOK, ZB_W, DM, DM, DM}; eg.ldc = ZB_W; eg.ss_lo = 0; eg.ss_hi = 512; eg.ssacc = rsQ; eg.sc_lo = 512; }
            break;
          case 2: if (!isA) { type = 1; g = pg8::Gemm{kvb, ap->wd[5 + j].dst, MTOK, GW, 512, KVW, 512}; eg.O = kn; eg.ldc = GW; eg.rss = rsKV; eg.rinvD = 1.0f / 512; } break;
          case 3: if (!isA) { type = 1; sync = true; g = pg8::Gemm{ap->wd[7 + j].dst, kvb, GW, MTOK, 512, 512, KVW}; eg.O = vT; eg.ldc = MTOK; eg.css = rsKV; eg.cinvD = 1.0f / 512; } break;
          case 4: if (!isA) { type = 1; sync = true; g = pg8::Gemm{zbuf, ap->wd[13 + j].dst, MTOK, QW, 512, ZB_W, 512};
              eg.O = qbuf; eg.ldc = QW; eg.rss = rsQ; eg.rinvD = 1.0f / 512; eg.rope_mode = 1; eg.cs = cs; eg.sc_lo = 0; eg.sc_val = SC_MLA; } break;
          case 5: type = 4; sync = true; break;
          case 6: type = 2; sync = true; g = pg8::Gemm{cat, ap->wd[15 + l].dst, MTOK, DM, DM, DM, DM}; er.xold = (l == 0) ? x_in : xo; er.xnew = xo; er.ssacc = rsB; break;
          case 7: type = 3; sync = true; g = pg8::Gemm{xb, ap->wd[19 + l].dst, MTOK, DFF2, DM, DM, DM}; break;
          case 8: type = 5; sync = true; break;
          case 9: type = 2; sync = true; g = pg8::Gemm{gbuf, ap->wd[23 + l].dst, MTOK, DM, DFF, DFF, DFF}; er.xold = xo; er.xnew = xo; er.ssacc = rsA; break;
        }
      }
      if (type == 1 && EN(1)) { S.init(g.M, g.N, G, corder); pg8::gemm_phase<EpiG>(lds, g, S, eg); }
      else if (type == 2 && EN(2)) {
        S.init(g.M, g.N, G, corder); pg8::gemm_phase<EpiRes>(lds, g, S, er);
        if (s == 6) for (size_t i = gtid; i < (size_t)MTOK; i += NGT) { rsA[i] = 0.f; rsV[i] = 0.f; rsQ[i] = 0.f; }
      }
      else if (type == 3 && EN(3)) {
        S.init(g.M, g.N, G, corder);
        EpiUp E{gbuf, halo, rsB, ap->in[22] + (size_t)l * 3 * DFF2, ap->in[23] + (size_t)l * DFF2, lds + 131072 + 1024};
        pg8::gemm_phase<EpiUp>(lds, g, S, E);
      }
      else if (type == 4 && (EN(4) || EN(6) || EN(7))) {
        if (isA && EN(4)) {
          const float* wsp = ap->in[8] + (size_t)l * 12 * 128 * 128; const float* bsp = ap->in[9] + (size_t)l * 12 * 128; const float* gv = ap->in[7] + (size_t)l * GW;
          LAS unsigned char* Wl = lds; LAS unsigned char* Vt = lds + 128 * 272;
          const int r32 = lane & 31, hi = lane >> 5, tb = wave & 3, chh = wave >> 2;
          f32x4 wreg[8], qreg = (f32x4){0.f, 0.f, 0.f, 0.f}; u32x4 vreg[4];
#pragma unroll
          for (int i = 0; i < 8; ++i) wreg[i] = (f32x4){0.f, 0.f, 0.f, 0.f};
#pragma unroll
          for (int i = 0; i < 4; ++i) vreg[i] = (u32x4){0u, 0u, 0u, 0u};
          if (vcu < NB * 32 * 12) { const int gi_ = (vcu) % 12, tok0_ = ((vcu) / 12) * 128;
#pragma unroll
              for (int i = 0; i < 8; ++i) { const int idx = tid + i * 512, t = idx >> 5, s4 = (idx & 31) * 4; wreg[i] = *(const f32x4*)(wsp + ((size_t)gi_ * 128 + t) * 128 + s4); }
              qreg = *(const f32x4*)(rsV + tok0_ + (tid & 31) * 4);
#pragma unroll
              for (int i = 0; i < 4; ++i) { const int idx = tid + i * 512, sr = (idx >> 8) * 16 + (idx & 15), c8 = ((idx >> 4) & 15) * 8;
                vreg[i] = *(const u32x4*)(zbuf + (size_t)(tok0_ + sr) * ZA_W + GW + gi_ * 128 + c8); } }
          for (int uidx = vcu; uidx < NB * 32 * 12; uidx += G) {
            const int gi = uidx % 12, bn = uidx / 12, tok0 = bn * 128;
            { f32x4 rq;
#pragma unroll
              for (int e = 0; e < 4; ++e) rq[e] = __builtin_amdgcn_rsqf(qreg[e] * (1.0f / GW) + EPS);
#pragma unroll
              for (int i = 0; i < 8; ++i) { const int idx = tid + i * 512, t = idx >> 5, s4 = (idx & 31) * 4;
                f32x4 w = wreg[i];
#pragma unroll
                for (int e = 0; e < 4; ++e) w[e] = (s4 + e <= t) ? w[e] * rq[e] : 0.f;
                *(LAS u32x2*)(Wl + t * 272 + s4 * 2) = (u32x2){cvt_pk_bf16(w[0], w[1]), cvt_pk_bf16(w[2], w[3])}; } }
#pragma unroll
            for (int i = 0; i < 4; ++i) { const int idx = tid + i * 512, sr = (idx >> 8) * 16 + (idx & 15), c8 = ((idx >> 4) & 15) * 8;
              const unsigned vv[4] = {vreg[i].x, vreg[i].y, vreg[i].z, vreg[i].w};
#pragma unroll
              for (int e = 0; e < 4; ++e) { *(LAS unsigned short*)(Vt + (c8 + 2 * e) * 272 + sr * 2) = (unsigned short)(vv[e] & 0xffffu); *(LAS unsigned short*)(Vt + (c8 + 2 * e + 1) * 272 + sr * 2) = (unsigned short)(vv[e] >> 16); } }
            __syncthreads();
            if (uidx + G < NB * 32 * 12) { const int gi_ = (uidx + G) % 12, tok0_ = ((uidx + G) / 12) * 128;
#pragma unroll
              for (int i = 0; i < 8; ++i) { const int idx = tid + i * 512, t = idx >> 5, s4 = (idx & 31) * 4; wreg[i] = *(const f32x4*)(wsp + ((size_t)gi_ * 128 + t) * 128 + s4); }
              qreg = *(const f32x4*)(rsV + tok0_ + (tid & 31) * 4);
#pragma unroll
              for (int i = 0; i < 4; ++i) { const int idx = tid + i * 512, sr = (idx >> 8) * 16 + (idx & 15), c8 = ((idx >> 4) & 15) * 8;
                vreg[i] = *(const u32x4*)(zbuf + (size_t)(tok0_ + sr) * ZA_W + GW + gi_ * 128 + c8); } }
            f32x16 acc2[2];
#pragma unroll
            for (int cb = 0; cb < 2; ++cb)
#pragma unroll
              for (int i = 0; i < 16; ++i) acc2[cb][i] = 0.f;
            const int nks = 2 * (tb + 1);
            for (int ks = 0; ks < nks; ++ks) {
              const bf16x8 wf = *(const LAS bf16x8*)(Wl + (32 * tb + r32) * 272 + ks * 32 + hi * 16);
#pragma unroll
              for (int cb = 0; cb < 2; ++cb) {
                const bf16x8 vf = *(const LAS bf16x8*)(Vt + (64 * chh + 32 * cb + r32) * 272 + ks * 32 + hi * 16);
                acc2[cb] = __builtin_amdgcn_mfma_f32_32x32x16_bf16(vf, wf, acc2[cb], 0, 0, 0);
              }
            }
            const int t = 32 * tb + r32; const float bt = bsp[gi * 128 + t];
            const size_t rowoff = (size_t)(tok0 + t);
#pragma unroll
            for (int cb = 0; cb < 2; ++cb)
#pragma unroll
              for (int ig = 0; ig < 4; ++ig) {
                const int c = gi * 128 + 64 * chh + 32 * cb + 8 * ig + 4 * hi;
                const f32x4 gg = *(const f32x4*)(gv + c);
                const u32x2 uu = *(const u32x2*)(zbuf + rowoff * ZA_W + c);
                const float u0 = __uint_as_float(uu.x << 16), u1 = __uint_as_float(uu.x & 0xffff0000u), u2 = __uint_as_float(uu.y << 16), u3 = __uint_as_float(uu.y & 0xffff0000u);
                const float o0 = u0 * (acc2[cb][4 * ig] * gg[0] + bt), o1 = u1 * (acc2[cb][4 * ig + 1] * gg[1] + bt), o2 = u2 * (acc2[cb][4 * ig + 2] * gg[2] + bt), o3 = u3 * (acc2[cb][4 * ig + 3] * gg[3] + bt);
                *(u32x2*)(cat + rowoff * DM + c) = (u32x2){cvt_pk_bf16(o0, o1), cvt_pk_bf16(o2, o3)};
              }
            __syncthreads();
          }
        } else if (!isA && EN(6)) {
          for (int p = 6 * vcu; p < 1536; p += 6 * G)
#pragma unroll 1
            for (int uu = p; uu < p + 6 && uu < 1536; ++uu) {
              const int pp = uu >> 1, half = uu & 1, bh = pp >> 3, i8 = pp & 7, b = bh / 12, h = bh - b * 12;
              const int qblk = half ? i8 : 15 - i8; const size_t row0 = (size_t)b * SEQ + qblk * 256;
              attn_unit<192, true>(lds, qbuf + row0 * QW + h * 192, QW, kn + (size_t)b * SEQ * GW + h * 128, GW, kvb + (size_t)b * SEQ * KVW + 512, KVW,
                                   vT + (size_t)(h * 128) * MTOK + (size_t)b * SEQ, MTOK, (qblk + 1) * 4, qblk * 256, cat + row0 * DM + h * 128, DM);
            }
        }
        if (EN(7)) {
          const bf16_t* qm = zbuf + (isA ? 2 * GW : 512); const int ldq = isA ? ZA_W : ZB_W;
#pragma unroll 1
          for (int uidx = vcu; uidx < NB * 4 * 16; uidx += G) {
            const int qblk = uidx & 15, bh = uidx >> 4, b = bh >> 2, h = bh & 3; const size_t row0 = (size_t)b * SEQ + qblk * 256;
            attn_unit<128, false>(lds, qm + row0 * ldq + h * 128, ldq, memk + (size_t)l * MMEM * 512 + (size_t)b * NMEM * 512 + h * 128, 512, nullptr, 0,
                                  memvt + (size_t)l * 512 * MMEM + (size_t)(h * 128) * MMEM + b * NMEM, MMEM, 4, 0, cat + row0 * DM + GW + h * 128, DM);
          }
        }
        for (size_t i = gtid; i < (size_t)MTOK; i += NGT) rsB[i] = 0.f;
      }
      else if (type == 5 && EN(5)) {
        const float* cw = ap->in[22] + (size_t)l * 3 * DFF2; const float* cb = ap->in[23] + (size_t)l * DFF2;
        for (size_t idx = gtid; idx < (size_t)1024 * (DFF / 4); idx += NGT) {
          const int rowi = (int)(idx / (DFF / 4)), c4 = (int)(idx % (DFF / 4)) * 4, blk = rowi >> 1, rr = rowi & 1;
          const bool hp = (blk & 63) != 0;
          const float* H0 = halo + (size_t)blk * 4 * DFF2; const float* Hp = H0 - (size_t)4 * DFF2;
          f32x4 cv[2];
#pragma unroll
          for (int part = 0; part < 2; ++part) {
            const int off = part * DFF + c4; const f32x4 z4 = (f32x4){0.f, 0.f, 0.f, 0.f};
            const f32x4 a0 = *(const f32x4*)(H0 + (size_t)rr * DFF2 + off);
            const f32x4 p3 = hp ? *(const f32x4*)(Hp + (size_t)3 * DFF2 + off) : z4;
            const f32x4 a1 = rr ? *(const f32x4*)(H0 + off) : p3;
            const f32x4 a2 = rr ? p3 : (hp ? *(const f32x4*)(Hp + (size_t)2 * DFF2 + off) : z4);
            cv[part] = *(const f32x4*)(cw + 2 * DFF2 + off) * a0 + *(const f32x4*)(cw + DFF2 + off) * a1 + *(const f32x4*)(cw + off) * a2 + *(const f32x4*)(cb + off);
          }
          u32x2 w; w.x = cvt_pk_bf16(silu1(cv[0][0]) * cv[1][0], silu1(cv[0][1]) * cv[1][1]); w.y = cvt_pk_bf16(silu1(cv[0][2]) * cv[1][2], silu1(cv[0][3]) * cv[1][3]);
          *(u32x2*)(gbuf + (size_t)(blk * 64 + rr) * DFF + c4) = w;
        }
      }
      if (sync) xcd_barrier(xbar);
    }
  }
  {
    const Args* ap = &a; DERIVE_PTRS(ap)
    DERIVE_IDS
    const float* gf = a.in[5];
    for (size_t i = gtid; i < (size_t)MTOK * (DM / 4); i += NGT) {
      const int row = (int)(i / (DM / 4)), c4 = (int)(i % (DM / 4)) * 4;
      const float r = __builtin_amdgcn_rsqf(rsA[row] * (1.0f / DM) + EPS);
      f32x4* p = (f32x4*)(xo + (size_t)row * DM + c4);
      *p = *p * r * *(const f32x4*)(gf + c4);
    }
  }
}

extern "C" void kernel_launch(void* const* d_in, const int* in_sizes, int n_in, void* d_out, int out_size, void* d_ws, size_t ws_size, hipStream_t stream) {
  static int grid_blocks = 0;
  if (!grid_blocks) {
    int dev = 0, cus = 0, per_cu = 0;
    (void)hipGetDevice(&dev);
    (void)hipDeviceGetAttribute(&cus, hipDeviceAttributeMultiprocessorCount, dev);
    (void)hipFuncSetAttribute((const void*)yoco_fwd, hipFuncAttributeMaxDynamicSharedMemorySize, LDS_BYTES);
    (void)hipOccupancyMaxActiveBlocksPerMultiprocessor(&per_cu, (const void*)yoco_fwd, 512, LDS_BYTES);
    if (per_cu < 1) per_cu = 1;
    grid_blocks = cus * per_cu;
    if (ws_size < WS_END) fprintf(stderr, "kernel_launch: workspace too small: %zu < %zu\n", ws_size, (size_t)WS_END);
  }
  Args a; memset(&a, 0, sizeof(a));
  for (int i = 0; i < 25; ++i) a.in[i] = (const float*)d_in[i];
  a.out = (float*)d_out; a.ws = (unsigned char*)d_ws;
  const float* const* in = a.in;
  bf16_t* wp = (bf16_t*)((unsigned char*)d_ws + WS_W);
  int nd = 0, items = 0;
  auto add = [&](const float* src, const float* scale, int K, int Ns, int Nd, int kind) {
    WDesc& d = a.wd[nd++]; d.src = src; d.scale = scale; d.dst = wp; d.K = K; d.Ns = Ns; d.Nd = Nd; d.kind = kind; d.item0 = items; d.pad = 0;
    items += (K / 64) * (Nd / 32); wp += (size_t)K * Nd;
  };
  for (int l = 0; l < 2; ++l) add(in[6] + (size_t)l * DM * ZA_W, in[3] + (size_t)l * DM, DM, ZA_W, ZA_W, 0);
  for (int j = 0; j < 2; ++j) add(in[13] + (size_t)j * DM * ZB_W, in[3] + (size_t)(2 + j) * DM, DM, ZB_W, ZB_W, 0);
  add(in[11], in[10], DM, 576, KVW, 1);
  for (int j = 0; j < 2; ++j) add(in[16] + (size_t)j * 512 * GW, in[12], 512, GW, GW, 0);
  for (int j = 0; j < 2; ++j) add(in[17] + (size_t)j * 512 * GW, in[12], 512, GW, GW, 0);
  for (int l = 0; l < 4; ++l) add(in[19] + (size_t)l * DM * 1024, in[18] + (size_t)l * DM, DM, 1024, 1024, 0);
  for (int j = 0; j < 2; ++j) add(in[15] + (size_t)j * 512 * QW, in[14] + (size_t)j * 512, 512, QW, QW, 2);
  for (int l = 0; l < 4; ++l) add(in[20] + (size_t)l * DM * DM, nullptr, DM, DM, DM, 0);
  for (int l = 0; l < 4; ++l) add(in[21] + (size_t)l * DM * DFF2, in[4] + (size_t)l * DM, DM, DFF2, DFF2, 3);
  for (int l = 0; l < 4; ++l) add(in[24] + (size_t)l * DFF * DM, nullptr, DFF, DM, DM, 0);
  a.nitems = items;
  void* args[] = {&a};
  hipError_t e = hipLaunchCooperativeKernel((const void*)yoco_fwd, dim3(grid_blocks), dim3(512), args, LDS_BYTES, stream);
  if (e != hipSuccess) fprintf(stderr, "cooperative launch failed: %s (grid %d)\n", hipGetErrorString(e), grid_blocks);
}
```

```cpp
#include <hip/hip_runtime.h>
#include <hip/hip_cooperative_groups.h>
#include <cstdio>
#include <cstring>
namespace cg = cooperative_groups;

#define LAS __attribute__((address_space(3)))
typedef unsigned short bf16_t;
typedef short bf16x8 __attribute__((ext_vector_type(8)));
typedef short s16x4 __attribute__((ext_vector_type(4)));
typedef float f32x4 __attribute__((ext_vector_type(4)));
typedef float f32x2 __attribute__((ext_vector_type(2)));
typedef float f32x16 __attribute__((ext_vector_type(16)));
typedef unsigned u32x4 __attribute__((ext_vector_type(4)));
typedef unsigned u32x2 __attribute__((ext_vector_type(2)));

constexpr int DM = 2048, NB = 8, SEQ = 4096, MTOK = NB * SEQ, NMEM = 256, MMEM = NB * NMEM;
constexpr int GW = 1536, ZA_W = 3584, ZB_W = 1024, QW = 2304, KVW = 768, DFF = 5632, DFF2 = 11264;
constexpr float EPS = 1e-6f;
constexpr float LOG2E = 1.4426950408889634f;
constexpr float SC_MEM = 0.08838834764831845f * LOG2E;
constexpr float SC_MLA = 0.07216878364870323f * LOG2E;

constexpr size_t MiB = 1u << 20;
constexpr size_t WS_RS = 1 * MiB;
constexpr size_t WS_CS = 2 * MiB;
constexpr size_t WS_MEMB = 10 * MiB;
constexpr size_t WS_MEMK = 18 * MiB;
constexpr size_t WS_MEMVT = 26 * MiB;
constexpr size_t WS_W = 34 * MiB;
constexpr size_t WS_XB = 396 * MiB;
constexpr size_t WS_KVB = 524 * MiB;
constexpr size_t WS_KN = 572 * MiB;
constexpr size_t WS_VT = 668 * MiB;
constexpr size_t WS_HALO = 764 * MiB;
constexpr size_t WS_R = 852 * MiB;
constexpr size_t WS_CAT = WS_R + 224 * MiB;
constexpr size_t WS_Q = WS_R + 64 * MiB;
constexpr size_t WS_END = 1204 * MiB;

typedef __bf16 bf16x2_t __attribute__((ext_vector_type(2)));
__device__ __forceinline__ unsigned cvt_pk_bf16(float lo, float hi) { const f32x2 v = {lo, hi}; const bf16x2_t b = __builtin_convertvector(v, bf16x2_t); return __builtin_bit_cast(unsigned, b); }
__device__ __forceinline__ float wave_sum(float v) {
#pragma unroll
  for (int o = 1; o < 64; o <<= 1) v += __shfl_xor(v, o);
  return v;
}
__device__ __forceinline__ f32x2 gelu_pk(f32x2 v) {
  const f32x2 av = __builtin_elementwise_abs(v), d = av * 0.2316418882f + 1.0f;
  f32x2 t; t.x = __builtin_amdgcn_rcpf(d.x); t.y = __builtin_amdgcn_rcpf(d.y);
  f32x2 q = t * 0.5307027145f + (-0.7265760135f); q = q * t + 0.7107068705f; q = q * t + (-0.142248368f); q = q * t + 0.127414796f; q = q * t;
  const f32x2 s = (v * v) * (-0.72134752044f);
  f32x2 e; e.x = __builtin_amdgcn_exp2f(s.x); e.y = __builtin_amdgcn_exp2f(s.y);
  const f32x2 m = v * (q * e), r = v - m;
  f32x2 o; o.x = v.x < 0.f ? m.x : r.x; o.y = v.y < 0.f ? m.y : r.y; return o;
}
__device__ __forceinline__ f32x4 gelu4(f32x4 v) { f32x2 a = gelu_pk((f32x2){v[0], v[1]}), b = gelu_pk((f32x2){v[2], v[3]}); return (f32x4){a.x, a.y, b.x, b.y}; }
__device__ __forceinline__ float silu1(float x) { return x * __builtin_amdgcn_rcpf(1.0f + __builtin_amdgcn_exp2f(-x * LOG2E)); }
__device__ __forceinline__ float ror1(float v) { return __builtin_bit_cast(float, __builtin_amdgcn_update_dpp(0, __builtin_bit_cast(int, v), 0x121, 0xf, 0xf, true)); }
__device__ __forceinline__ float ror2(float v) { return __builtin_bit_cast(float, __builtin_amdgcn_update_dpp(0, __builtin_bit_cast(int, v), 0x122, 0xf, 0xf, true)); }
__device__ __forceinline__ float shr1o(float old, float v) { return __builtin_bit_cast(float, __builtin_amdgcn_update_dpp(__builtin_bit_cast(int, old), __builtin_bit_cast(int, v), 0x111, 0xf, 0xf, false)); }
__device__ __forceinline__ float shr2o(float old, float v) { return __builtin_bit_cast(float, __builtin_amdgcn_update_dpp(__builtin_bit_cast(int, old), __builtin_bit_cast(int, v), 0x112, 0xf, 0xf, false)); }
__device__ __forceinline__ f32x4 shr1ov(f32x4 o, f32x4 v) { return (f32x4){shr1o(o[0], v[0]), shr1o(o[1], v[1]), shr1o(o[2], v[2]), shr1o(o[3], v[3])}; }
__device__ __forceinline__ f32x4 shr2ov(f32x4 o, f32x4 v) { return (f32x4){shr2o(o[0], v[0]), shr2o(o[1], v[1]), shr2o(o[2], v[2]), shr2o(o[3], v[3])}; }
__device__ __forceinline__ f32x4 ror1v(f32x4 v) { return (f32x4){ror1(v[0]), ror1(v[1]), ror1(v[2]), ror1(v[3])}; }
__device__ __forceinline__ f32x4 ror2v(f32x4 v) { return (f32x4){ror2(v[0]), ror2(v[1]), ror2(v[2]), ror2(v[3])}; }

namespace pg8 {
constexpr int BM = 256, BK = 64, HALF = 128, HTB = HALF * BK * 2, STAGE_BYTES = 8 * HTB, NXCD = 8, WGM = 8;
__device__ __forceinline__ int lds_byte(int r, int c) { const int st = (r >> 4) * 2 + (c >> 5), rr = r & 15, cc = c & 31, ob = rr * 64 + cc * 2; return st * 1024 + (ob ^ (((ob >> 9) & 1) << 5)); }
__device__ __forceinline__ void stage_rc(int b, int& R, int& C) { const int st = b / 1024, sb = b % 1024, swz = sb ^ (((sb >> 9) & 1) << 5); R = (st >> 1) * 16 + swz / 64; C = (st & 1) * 32 + (swz % 64) / 2; }
__device__ __forceinline__ int perm32(int rho) { const int n = rho >> 4, i = rho & 15; return 8 * (i >> 2) + 4 * n + (i & 3); }
struct Unit { int pm, pn; };
struct Gemm { const bf16_t* A; const bf16_t* Bt; int M, N, K, lda, ldb; };
struct StaticOrder {
  int nM, nN, nwg, G, c;
  __device__ void init(int M, int N, int G_, int c_) { nM = M / BM; nN = N / BM; nwg = nM * nN; G = G_; c = c_; }
  __device__ bool next(int i, Unit& u) const {
    const long L = (long)i * G + c; if (L >= nwg) return false;
    int wgid = (int)L; { const int q = nwg / NXCD, r = nwg % NXCD, xcd = wgid % NXCD, off = wgid / NXCD; wgid = (xcd < r ? xcd * (q + 1) : r * (q + 1) + (xcd - r) * q) + off; }
    const int nig = WGM * nN, gid = wgid / nig, fm = gid * WGM, gsz = (nM - fm) < WGM ? (nM - fm) : WGM;
    u.pm = fm + ((wgid % nig) % gsz); u.pn = (wgid % nig) / gsz; return true;
  }
};

#ifndef PG8_SP2
#define PG8_SP2 true
#endif
#ifndef PG8_ALIGN
#define PG8_ALIGN true
#endif
template <class Epi, bool SP2 = PG8_SP2, bool ALIGN_EPI = PG8_ALIGN>
__device__ __forceinline__ void gemm_phase(LAS unsigned char* lds, const Gemm g, const StaticOrder& S, const Epi& E) {
  int tid_o = threadIdx.x; asm volatile("" : "+v"(tid_o));
  const int tid = tid_o, wid = __builtin_amdgcn_readfirstlane(tid >> 6), lane = tid & 63, wr = wid >> 2, wc = wid & 3, fr = lane & 15, fq = lane >> 4;
  const int K = g.K, nt = K / BK;
  unsigned voffA[2], voffB[2];
#pragma unroll
  for (int i = 0; i < 2; ++i) { int R, C; stage_rc(tid * 16 + i * 8192, R, C); const int Rb = Epi::PERM ? ((R & ~31) + perm32(R & 31)) : R;
    voffA[i] = (unsigned)(R * g.lda + C) * 2u; voffB[i] = (unsigned)(Rb * g.ldb + C) * 2u; }
  const size_t kstep = (size_t)(BK * 2);
  const size_t hstepA = (size_t)HALF * g.lda * 2, hstepB = (size_t)HALF * g.ldb * 2;
  const size_t tstepA = 2 * hstepA, tstepB = 2 * hstepB;
  const unsigned ldsw = (unsigned)wid * 1024u;
  const int aoff = lds_byte(wr * 64 + fr, fq * 8), boff = lds_byte(wc * 32 + fr, fq * 8);
#define PG8_SA(b, h) (((b) * 2 + (h)) * HTB)
#define PG8_SB(b, h) ((4 + (b) * 2 + (h)) * HTB)
#define PG8_STAGE(bufoff, gbase, voff) do { _Pragma("unroll") for (int _i = 0; _i < 2; ++_i) \
    __builtin_amdgcn_global_load_lds((const unsigned*)((const char*)(gbase) + (voff)[_i]), (LAS unsigned*)(lds + (bufoff) + ldsw + _i * 8192), 16, 0, 0); } while (0)
#define PG8_LDA(dst, b, h) do { _Pragma("unroll") for (int m = 0; m < 4; ++m) _Pragma("unroll") for (int k = 0; k < 2; ++k) dst[m][k] = *(const LAS bf16x8*)(lds + PG8_SA(b, h) + aoff + m * 2048 + k * 1024); } while (0)
#define PG8_LDB(dst, b, h) do { _Pragma("unroll") for (int n = 0; n < 2; ++n) _Pragma("unroll") for (int k = 0; k < 2; ++k) dst[n][k] = *(const LAS bf16x8*)(lds + PG8_SB(b, h) + boff + n * 2048 + k * 1024); } while (0)
#define PG8_MMA(ai, bj, At, Bt) do { __builtin_amdgcn_s_setprio(1); _Pragma("unroll") for (int m = 0; m < 4; ++m) _Pragma("unroll") for (int n = 0; n < 2; ++n) _Pragma("unroll") for (int k = 0; k < 2; ++k) \
    acc[ai][bj][m][n] = __builtin_amdgcn_mfma_f32_16x16x32_bf16(Bt[n][k], At[m][k], acc[ai][bj][m][n], 0, 0, 0); __builtin_amdgcn_s_setprio(0); } while (0)
#define PG8_WAIT_V(n) asm volatile("s_waitcnt vmcnt(" #n ")" ::: "memory")
#define PG8_WAIT_L(n) asm volatile("s_waitcnt lgkmcnt(" #n ")" ::: "memory")
#define PG8_BAR __builtin_amdgcn_s_barrier()
#define PG8_SCHED __builtin_amdgcn_sched_barrier(0)
  Unit cur, nxt; int ui = 0;
  if (!S.next(0, cur)) return;
  f32x4 acc[2][2][4][2];
  if constexpr (Epi::INIT) E.init(acc, cur, wr, wc, fr, fq);
  else {
#pragma unroll
  for (int a = 0; a < 2; ++a)
#pragma unroll
    for (int b = 0; b < 2; ++b)
#pragma unroll
      for (int m = 0; m < 4; ++m)
#pragma unroll
        for (int n = 0; n < 2; ++n) acc[a][b][m][n] = (f32x4){0.f, 0.f, 0.f, 0.f};
  }
  bf16x8 At[4][2], B0[2][2], B1[2][2];
  const char* cA = (const char*)g.A + (size_t)cur.pm * tstepA; const char* cB = (const char*)g.Bt + (size_t)cur.pn * tstepB;
  if constexpr (SP2) {
    PG8_STAGE(PG8_SB(0, 0), cB, voffB); PG8_STAGE(PG8_SB(0, 1), cB + hstepB, voffB); PG8_STAGE(PG8_SA(0, 0), cA, voffA); PG8_STAGE(PG8_SA(0, 1), cA + hstepA, voffA);
    if (wr == 1) PG8_BAR;
    PG8_WAIT_V(2); PG8_BAR;
    PG8_STAGE(PG8_SB(1, 0), cB + kstep, voffB); PG8_STAGE(PG8_SA(1, 0), cA + kstep, voffA); PG8_STAGE(PG8_SB(1, 1), cB + hstepB + kstep, voffB);
    PG8_WAIT_V(6); PG8_BAR;
  } else {
  PG8_STAGE(PG8_SB(0, 0), cB, voffB); PG8_STAGE(PG8_SA(0, 0), cA, voffA); PG8_STAGE(PG8_SB(0, 1), cB + hstepB, voffB); PG8_STAGE(PG8_SA(0, 1), cA + hstepA, voffA);
  if (wr == 1) PG8_BAR;
  PG8_WAIT_V(4); PG8_BAR;
  PG8_STAGE(PG8_SB(1, 0), cB + kstep, voffB); PG8_STAGE(PG8_SA(1, 0), cA + kstep, voffA); PG8_STAGE(PG8_SB(1, 1), cB + hstepB + kstep, voffB);
  PG8_WAIT_V(6); PG8_BAR;
  }
  for (;;) {
    const bool has_next = S.next(ui + 1, nxt);
    const char* nA = has_next ? (const char*)g.A + (size_t)nxt.pm * tstepA : cA; const char* nB = has_next ? (const char*)g.Bt + (size_t)nxt.pn * tstepB : cB;
    for (int t = 0; t < nt; t += 2) {
      const bool last = (t == nt - 2);
      const char* a1 = cA + (size_t)(t + 1) * kstep;
      const char* a2 = last ? nA : cA + (size_t)(t + 2) * kstep; const char* b2 = last ? nB : cB + (size_t)(t + 2) * kstep;
      const char* a3 = a2 + kstep; const char* b3 = b2 + kstep;
      if constexpr (SP2) {
      PG8_LDB(B0, 0, 0); PG8_LDB(B1, 0, 1); PG8_SCHED; PG8_LDA(At, 0, 0); PG8_STAGE(PG8_SA(1, 1), a1 + hstepA, voffA);
      PG8_WAIT_V(8); PG8_WAIT_L(0); PG8_BAR; PG8_MMA(0, 0, At, B0); PG8_MMA(0, 1, At, B1); PG8_BAR; PG8_SCHED;
      PG8_LDA(At, 0, 1); PG8_STAGE(PG8_SB(0, 0), b2, voffB); PG8_STAGE(PG8_SB(0, 1), b2 + hstepB, voffB); PG8_STAGE(PG8_SA(0, 0), a2, voffA);
      PG8_WAIT_V(8); PG8_WAIT_L(0); PG8_BAR; PG8_MMA(1, 0, At, B0); PG8_MMA(1, 1, At, B1); PG8_BAR; PG8_SCHED;
      PG8_LDB(B0, 1, 0); PG8_LDB(B1, 1, 1); PG8_SCHED; PG8_LDA(At, 1, 0); PG8_STAGE(PG8_SA(0, 1), a2 + hstepA, voffA);
      PG8_WAIT_V(8); PG8_WAIT_L(0); PG8_BAR; PG8_MMA(0, 0, At, B0); PG8_MMA(0, 1, At, B1); PG8_BAR; PG8_SCHED;
      PG8_LDA(At, 1, 1); PG8_STAGE(PG8_SB(1, 0), b3, voffB); PG8_STAGE(PG8_SB(1, 1), b3 + hstepB, voffB); PG8_STAGE(PG8_SA(1, 0), a3, voffA);
      PG8_WAIT_V(8); PG8_WAIT_L(0); PG8_BAR; PG8_MMA(1, 0, At, B0); PG8_MMA(1, 1, At, B1); PG8_BAR; PG8_SCHED;
      } else {
      PG8_LDB(B0, 0, 0); PG8_SCHED; PG8_LDA(At, 0, 0); PG8_STAGE(PG8_SA(1, 1), a1 + hstepA, voffA);
      PG8_WAIT_L(8); PG8_BAR; PG8_WAIT_L(0); PG8_MMA(0, 0, At, B0); PG8_BAR; PG8_SCHED;
      PG8_LDB(B1, 0, 1); PG8_STAGE(PG8_SB(0, 0), b2, voffB);
      PG8_BAR; PG8_WAIT_L(0); PG8_MMA(0, 1, At, B1); PG8_BAR;
      PG8_LDA(At, 0, 1); PG8_STAGE(PG8_SA(0, 0), a2, voffA);
      PG8_BAR; PG8_WAIT_L(0); PG8_MMA(1, 0, At, B0); PG8_BAR; PG8_SCHED;
      PG8_STAGE(PG8_SB(0, 1), b2 + hstepB, voffB);
      PG8_WAIT_V(6); PG8_BAR; PG8_MMA(1, 1, At, B1); PG8_BAR;
      PG8_LDB(B0, 1, 0); PG8_SCHED; PG8_LDA(At, 1, 0); PG8_STAGE(PG8_SA(0, 1), a2 + hstepA, voffA);
      PG8_WAIT_L(8); PG8_BAR; PG8_WAIT_L(0); PG8_MMA(0, 0, At, B0); PG8_BAR; PG8_SCHED;
      PG8_LDB(B1, 1, 1); PG8_STAGE(PG8_SB(1, 0), b3, voffB);
      PG8_BAR; PG8_WAIT_L(0); PG8_MMA(0, 1, At, B1); PG8_BAR;
      PG8_LDA(At, 1, 1); PG8_STAGE(PG8_SA(1, 0), a3, voffA);
      PG8_BAR; PG8_WAIT_L(0); PG8_MMA(1, 0, At, B0); PG8_BAR; PG8_SCHED;
      PG8_STAGE(PG8_SB(1, 1), b3 + hstepB, voffB);
      PG8_WAIT_V(6); PG8_BAR; PG8_MMA(1, 1, At, B1); PG8_BAR;
      }
    }
    if constexpr (ALIGN_EPI) { if (wr == 0) PG8_BAR; }
    E(acc, cur, wr, wc, fr, fq);
    if (!has_next) break;
    if constexpr (Epi::INIT) E.init(acc, nxt, wr, wc, fr, fq);
    else {
#pragma unroll
    for (int a = 0; a < 2; ++a)
#pragma unroll
      for (int b = 0; b < 2; ++b)
#pragma unroll
        for (int m = 0; m < 4; ++m)
#pragma unroll
          for (int n = 0; n < 2; ++n) acc[a][b][m][n] = (f32x4){0.f, 0.f, 0.f, 0.f};
    }
    cur = nxt; cA = nA; cB = nB; ++ui;
    if constexpr (ALIGN_EPI) { if (wr == 1) PG8_BAR; }
  }
  PG8_WAIT_V(0);
  if constexpr (!ALIGN_EPI) { if (wr == 0) PG8_BAR; }
  PG8_BAR;
#undef PG8_SA
#undef PG8_SB
#undef PG8_STAGE
#undef PG8_LDA
#undef PG8_LDB
#undef PG8_MMA
#undef PG8_WAIT_V
#undef PG8_WAIT_L
#undef PG8_BAR
#undef PG8_SCHED
}
}
using pg8::Unit; using pg8::HALF;
typedef f32x4 Acc[2][2][4][2];

struct EpiG {
  static constexpr bool PERM = true, INIT = false;
  bf16_t* O; int ldc;
  const float* rss; float rinvD;
  const float* css; float cinvD;
  int gelu_hi;
  int ss_lo, ss_hi; float* ssacc;
  int rope_mode;
  const f32x2* cs;
  int sc_lo; float sc_val;
  __device__ __forceinline__ void operator()(Acc& acc, const Unit& u, int wr, int wc, int fr, int fq) const {
    const int ct = u.pn * 256;
    const bool do_gelu = ct < gelu_hi, do_ss = (ct >= ss_lo && ct < ss_hi), do_sc = ct >= sc_lo;
    float rsv[2][4];
#pragma unroll
    for (int ai = 0; ai < 2; ++ai)
#pragma unroll
      for (int m = 0; m < 4; ++m) rsv[ai][m] = rss ? rss[u.pm * 256 + ai * HALF + wr * 64 + m * 16 + fr] : 1.0f;
    f32x4 cq[2][2];
#pragma unroll
    for (int bj = 0; bj < 2; ++bj) { const int c0 = ct + bj * HALF + wc * 32 + 8 * fq;
      cq[bj][0] = css ? *(const f32x4*)(css + c0) : (f32x4){1.f, 1.f, 1.f, 1.f}; cq[bj][1] = css ? *(const f32x4*)(css + c0 + 4) : (f32x4){1.f, 1.f, 1.f, 1.f}; }
    if (rss) {
#pragma unroll
      for (int ai = 0; ai < 2; ++ai)
#pragma unroll
        for (int m = 0; m < 4; ++m) rsv[ai][m] = __builtin_amdgcn_rsqf(rsv[ai][m] * rinvD + EPS);
    }
    if (css) {
#pragma unroll
      for (int bj = 0; bj < 2; ++bj)
#pragma unroll
        for (int h = 0; h < 2; ++h)
#pragma unroll
          for (int j = 0; j < 4; ++j) cq[bj][h][j] = __builtin_amdgcn_rsqf(cq[bj][h][j] * cinvD + EPS);
    }
#pragma unroll
    for (int ai = 0; ai < 2; ++ai)
#pragma unroll
      for (int m = 0; m < 4; ++m) {
        const int row = u.pm * 256 + ai * HALF + wr * 64 + m * 16 + fr;
        const float rs = rsv[ai][m];
        float ss = 0.f;
#pragma unroll
        for (int bj = 0; bj < 2; ++bj) {
          const int c0 = ct + bj * HALF + wc * 32 + 8 * fq;
          f32x4 v0 = acc[ai][bj][m][0] * rs, v1 = acc[ai][bj][m][1] * rs;
          if (css) { v0 = v0 * cq[bj][0]; v1 = v1 * cq[bj][1]; }
          if (do_gelu) { v0 = gelu4(v0); v1 = gelu4(v1); }
          if (do_ss) ss += (v0[0] * v0[0] + v0[1] * v0[1]) + (v0[2] * v0[2] + v0[3] * v0[3]) + (v1[0] * v1[0] + v1[1] * v1[1]) + (v1[2] * v1[2] + v1[3] * v1[3]);
          int roff = -1;
          if (rope_mode == 1) { const int d = c0 % 192; if (d >= 128) roff = d - 128; }
          else if (rope_mode == 2) { if (c0 >= 512 && c0 < 576) roff = c0 - 512; }
          if (roff >= 0) {
            const f32x2* t = cs + (size_t)row * 32 + (roff >> 1);
            const f32x2 t0 = t[0], t1 = t[1], t2 = t[2], t3 = t[3];
            f32x4 w0, w1;
            w0[0] = v0[0] * t0.x - v0[1] * t0.y; w0[1] = v0[1] * t0.x + v0[0] * t0.y;
            w0[2] = v0[2] * t1.x - v0[3] * t1.y; w0[3] = v0[3] * t1.x + v0[2] * t1.y;
            w1[0] = v1[0] * t2.x - v1[1] * t2.y; w1[1] = v1[1] * t2.x + v1[0] * t2.y;
            w1[2] = v1[2] * t3.x - v1[3] * t3.y; w1[3] = v1[3] * t3.x + v1[2] * t3.y;
            v0 = w0; v1 = w1;
          }
          if (do_sc) { v0 = v0 * sc_val; v1 = v1 * sc_val; }
          u32x4 w; w.x = cvt_pk_bf16(v0[0], v0[1]); w.y = cvt_pk_bf16(v0[2], v0[3]); w.z = cvt_pk_bf16(v1[0], v1[1]); w.w = cvt_pk_bf16(v1[2], v1[3]);
          *(u32x4*)(O + (size_t)row * ldc + c0) = w;
        }
        if (do_ss) { ss += __shfl_xor(ss, 16); ss += __shfl_xor(ss, 32); if (fq == 0) atomicAdd(ssacc + row, ss); }
      }
  }
};

struct EpiRes {
  static constexpr bool PERM = false, INIT = true;
  const float* xold; float* xnew; bf16_t* xb; float* ssacc;
  __device__ __forceinline__ void init(Acc& acc, const Unit& u, int wr, int wc, int fr, int fq) const {
    const int col0 = u.pn * 256 + wc * 32 + 4 * fq;
#pragma unroll
    for (int ai = 0; ai < 2; ++ai)
#pragma unroll
      for (int bj = 0; bj < 2; ++bj)
#pragma unroll
        for (int m = 0; m < 4; ++m)
#pragma unroll
          for (int n = 0; n < 2; ++n) {
            const int row = u.pm * 256 + ai * HALF + wr * 64 + m * 16 + fr;
            acc[ai][bj][m][n] = *(const f32x4*)(xold + (size_t)row * DM + col0 + bj * HALF + n * 16);
          }
  }
  __device__ __forceinline__ void operator()(Acc& acc, const Unit& u, int wr, int wc, int fr, int fq) const {
    const int col0 = u.pn * 256 + wc * 32 + 4 * fq;
#pragma unroll
    for (int ai = 0; ai < 2; ++ai)
#pragma unroll
      for (int m = 0; m < 4; ++m) {
        const int row = u.pm * 256 + ai * HALF + wr * 64 + m * 16 + fr;
        float ss = 0.f;
#pragma unroll
        for (int bj = 0; bj < 2; ++bj)
#pragma unroll
          for (int n = 0; n < 2; ++n) {
            const size_t off = (size_t)row * DM + col0 + bj * HALF + n * 16;
            const f32x4 v = acc[ai][bj][m][n];
            *(f32x4*)(xnew + off) = v;
            u32x2 w; w.x = cvt_pk_bf16(v[0], v[1]); w.y = cvt_pk_bf16(v[2], v[3]);
            *(u32x2*)(xb + off) = w;
            ss += (v[0] * v[0] + v[1] * v[1]) + (v[2] * v[2] + v[3] * v[3]);
          }
        ss += __shfl_xor(ss, 16); ss += __shfl_xor(ss, 32);
        if (fq == 0) atomicAdd(ssacc + row, ss);
      }
  }
};

struct EpiUp {
  static constexpr bool PERM = true, INIT = false;
  bf16_t* g; float* halo; const float* rss; const float* cw; const float* cb; LAS unsigned char* epl;
  __device__ __forceinline__ void operator()(Acc& acc, const Unit& u, int wr, int wc, int fr, int fq) const {
    const int rowb = u.pm * 256 + wr * 64;
    const int c0 = u.pn * 128 + wc * 32 + 8 * fq;
    float rr[2][4];
#pragma unroll
    for (int ai = 0; ai < 2; ++ai)
#pragma unroll
      for (int m = 0; m < 4; ++m) rr[ai][m] = rss[rowb + ai * HALF + m * 16 + fr];
    LAS unsigned char* wl = epl + (wr * 4 + wc) * 1024;
    { const int lane = fq * 16 + fr, arr = lane >> 3, part = lane & 7, col = u.pn * 128 + wc * 32 + 4 * part;
      const float* sp = ((arr & 3) == 3 ? cb : cw + (size_t)(arr & 3) * DFF2) + (arr >> 2) * DFF + col;
      const f32x4 wv = *(const f32x4*)sp;
      *(LAS f32x4*)(wl + lane * 16) = wv; }
#pragma unroll
    for (int ai = 0; ai < 2; ++ai)
#pragma unroll
      for (int m = 0; m < 4; ++m) {
        const float r = __builtin_amdgcn_rsqf(rr[ai][m] * (1.0f / DM) + EPS);
#pragma unroll
        for (int bj = 0; bj < 2; ++bj)
#pragma unroll
          for (int n = 0; n < 2; ++n) acc[ai][bj][m][n] = acc[ai][bj][m][n] * r;
      }
    asm volatile("s_waitcnt lgkmcnt(0)" ::: "memory");
#pragma unroll
    for (int n = 0; n < 2; ++n) {
      const int cc = c0 + 4 * n;
      const LAS unsigned char* wp = wl + (8 * fq + 4 * n) * 4;
      const f32x4 wg0 = *(const LAS f32x4*)(wp), wg1 = *(const LAS f32x4*)(wp + 128), wg2 = *(const LAS f32x4*)(wp + 256), bg = *(const LAS f32x4*)(wp + 384);
      const f32x4 wv0 = *(const LAS f32x4*)(wp + 512), wv1 = *(const LAS f32x4*)(wp + 640), wv2 = *(const LAS f32x4*)(wp + 768), bv = *(const LAS f32x4*)(wp + 896);
#pragma unroll
      for (int ai = 0; ai < 2; ++ai) {
        f32x4 g1p = (f32x4){0.f, 0.f, 0.f, 0.f}, g2p = g1p, v1p = g1p, v2p = g1p;
#pragma unroll
        for (int m = 0; m < 4; ++m) {
          const f32x4 G = acc[ai][0][m][n], V = acc[ai][1][m][n];
          const f32x4 pg1 = shr1ov(g1p, G), pg2 = shr2ov(g2p, G), pv1 = shr1ov(v1p, V), pv2 = shr2ov(v2p, V);
          const f32x4 cgt = wg2 * G + wg1 * pg1 + wg0 * pg2 + bg;
          const f32x4 cvl = wv2 * V + wv1 * pv1 + wv0 * pv2 + bv;
          if (m < 3) { g1p = ror1v(G); g2p = ror2v(G); v1p = ror1v(V); v2p = ror2v(V); }
          const int row = rowb + ai * HALF + m * 16 + fr;
          if (m > 0 || fr >= 2) {
            u32x2 w; w.x = cvt_pk_bf16(silu1(cgt[0]) * cvl[0], silu1(cgt[1]) * cvl[1]); w.y = cvt_pk_bf16(silu1(cgt[2]) * cvl[2], silu1(cgt[3]) * cvl[3]);
            *(u32x2*)(g + (size_t)row * DFF + cc) = w;
          }
          int slot = -1;
          if (m == 0 && fr < 2) slot = fr;
          if (m == 3 && fr >= 14) slot = fr - 12;
          if (slot >= 0) {
            float* hp = halo + ((size_t)(row >> 6) * 4 + slot) * DFF2 + cc;
            *(f32x4*)hp = G; *(f32x4*)(hp + DFF) = V;
          }
        }
      }
    }
  }
};

constexpr int ATT_KBUF = 64 * 400, ATT_VROWB = 136, ATT_VBUF = 128 * ATT_VROWB, ATT_BUF = ATT_KBUF + ATT_VBUF;
template <int DQK, bool CAUSAL>
__device__ __forceinline__ void attn_unit(LAS unsigned char* lds, const bf16_t* Q, int ldq, const bf16_t* K1, int ldk1, const bf16_t* K2, int ldk2,
                                          const bf16_t* VT, int ldv, int ntiles, int q0, bf16_t* O, int ldo) {
  constexpr int KROWB = (DQK + 8) * 2, NKS = DQK / 16, CPR = DQK / 8, NKCH = 64 * CPR / 512;
  int tid_o = threadIdx.x; asm volatile("" : "+v"(tid_o));
  const int tid = tid_o, wid = __builtin_amdgcn_readfirstlane(tid >> 6), lane = tid & 63, r32 = lane & 31, hi = lane >> 5;
  bf16x8 qf[NKS];
  { const bf16_t* qp = Q + (size_t)(wid * 32 + r32) * ldq + hi * 8;
#pragma unroll
    for (int ks = 0; ks < NKS; ++ks) qf[ks] = *(const bf16x8*)(qp + ks * 16); }
  u32x4 kreg[NKCH], vreg[2];
#define ATT_GLOAD(t_) do { const int k0_ = (t_) * 64; \
    _Pragma("unroll") for (int i = 0; i < NKCH; ++i) { const int ch = tid + i * 512, kr = ch / CPR, kc = ch - kr * CPR; \
      const bf16_t* src = (DQK == 128 || kc < 16) ? K1 + (size_t)(k0_ + kr) * ldk1 + kc * 8 : K2 + (size_t)(k0_ + kr) * ldk2 + (kc - 16) * 8; \
      kreg[i] = *(const u32x4*)src; } \
    _Pragma("unroll") for (int i = 0; i < 2; ++i) { const int ch = tid + i * 512, d = ch >> 3, cc = ch & 7; vreg[i] = *(const u32x4*)(VT + (size_t)d * ldv + k0_ + cc * 8); } } while (0)
#define ATT_LWRITE(buf_) do { LAS unsigned char* kb_ = lds + (buf_) * ATT_BUF; \
    _Pragma("unroll") for (int i = 0; i < NKCH; ++i) { const int ch = tid + i * 512, kr = ch / CPR, kc = ch - kr * CPR; *(LAS u32x4*)(kb_ + kr * KROWB + kc * 16) = kreg[i]; } \
    _Pragma("unroll") for (int i = 0; i < 2; ++i) { const int ch = tid + i * 512, d = ch >> 3, cc = ch & 7; LAS unsigned char* p = kb_ + ATT_KBUF + d * ATT_VROWB + cc * 16; \
      *(LAS u32x2*)p = (u32x2){vreg[i].x, vreg[i].y}; *(LAS u32x2*)(p + 8) = (u32x2){vreg[i].z, vreg[i].w}; } } while (0)
  f32x16 o[4];
#pragma unroll
  for (int d = 0; d < 4; ++d)
#pragma unroll
    for (int i = 0; i < 16; ++i) o[d][i] = 0.f;
  float mrow = 0.f, lsum = 0.f;
  const int qabs = q0 + wid * 32 + r32, qlo = q0 + wid * 32;
  ATT_GLOAD(0); ATT_LWRITE(0); __syncthreads();
  for (int t = 0; t < ntiles; ++t) {
    const int buf = t & 1;
    if (t + 1 < ntiles) ATT_GLOAD(t + 1);
    const int k0 = t * 64;
    if (!CAUSAL || k0 <= qlo + 31) {
      const LAS unsigned char* kb = lds + buf * ATT_BUF;
      const bool first = (t == 0);
      const float nm = first ? 0.f : -mrow;
      f32x16 s0, s1;
#pragma unroll
      for (int i = 0; i < 16; ++i) { s0[i] = nm; s1[i] = nm; }
#pragma unroll
      for (int ks = 0; ks < NKS; ++ks) {
        const bf16x8 ka = *(const LAS bf16x8*)(kb + r32 * KROWB + ks * 32 + hi * 16);
        const bf16x8 kc = *(const LAS bf16x8*)(kb + (32 + r32) * KROWB + ks * 32 + hi * 16);
        s0 = __builtin_amdgcn_mfma_f32_32x32x16_bf16(ka, qf[ks], s0, 0, 0, 0);
        s1 = __builtin_amdgcn_mfma_f32_32x32x16_bf16(kc, qf[ks], s1, 0, 0, 0);
      }
      if (CAUSAL && k0 + 63 > qlo) {
#pragma unroll
        for (int i = 0; i < 16; ++i) { const int kv = k0 + (i & 3) + 8 * (i >> 2) + 4 * hi;
          if (kv > qabs) s0[i] = -INFINITY; if (kv + 32 > qabs) s1[i] = -INFINITY; }
      }
      float mx = s0[0];
#pragma unroll
      for (int i = 1; i < 16; ++i) mx = fmaxf(mx, s0[i]);
#pragma unroll
      for (int i = 0; i < 16; ++i) mx = fmaxf(mx, s1[i]);
      mx = fmaxf(mx, __shfl_xor(mx, 32));
      const bool need = first || (mx > 8.0f);
      if (__ballot(need) != 0ull) {
        const float d = need ? mx : 0.f;
        const float alpha = first ? 0.f : __builtin_amdgcn_exp2f(-d);
        mrow = first ? mx : mrow + d;
        lsum *= alpha;
#pragma unroll
        for (int dd = 0; dd < 4; ++dd)
#pragma unroll
          for (int i = 0; i < 16; ++i) o[dd][i] *= alpha;
#pragma unroll
        for (int i = 0; i < 16; ++i) { s0[i] -= d; s1[i] -= d; }
      }
      float ps = 0.f;
#pragma unroll
      for (int i = 0; i < 16; ++i) { s0[i] = __builtin_amdgcn_exp2f(s0[i]); s1[i] = __builtin_amdgcn_exp2f(s1[i]); ps += s0[i] + s1[i]; }
      lsum += ps;
      bf16x8 pa[4];
#pragma unroll
      for (int s = 0; s < 4; ++s) {
        u32x4 w;
        if (s < 2) { w.x = cvt_pk_bf16(s0[8 * s + 0], s0[8 * s + 1]); w.y = cvt_pk_bf16(s0[8 * s + 2], s0[8 * s + 3]); w.z = cvt_pk_bf16(s0[8 * s + 4], s0[8 * s + 5]); w.w = cvt_pk_bf16(s0[8 * s + 6], s0[8 * s + 7]); }
        else { const int b = 8 * (s - 2); w.x = cvt_pk_bf16(s1[b + 0], s1[b + 1]); w.y = cvt_pk_bf16(s1[b + 2], s1[b + 3]); w.z = cvt_pk_bf16(s1[b + 4], s1[b + 5]); w.w = cvt_pk_bf16(s1[b + 6], s1[b + 7]); }
        pa[s] = __builtin_bit_cast(bf16x8, w);
      }
      const LAS unsigned char* vb = kb + ATT_KBUF;
#pragma unroll
      for (int d = 0; d < 4; ++d)
#pragma unroll
        for (int s = 0; s < 4; ++s) {
          const LAS unsigned char* p = vb + (32 * d + r32) * ATT_VROWB + (16 * s + 4 * hi) * 2;
          const u32x2 lo = *(const LAS u32x2*)p, hh = *(const LAS u32x2*)(p + 16);
          const bf16x8 vf = __builtin_bit_cast(bf16x8, (u32x4){lo.x, lo.y, hh.x, hh.y});
          o[d] = __builtin_amdgcn_mfma_f32_32x32x16_bf16(vf, pa[s], o[d], 0, 0, 0);
        }
    }
    if (t + 1 < ntiles) ATT_LWRITE(buf ^ 1);
    __syncthreads();
  }
#undef ATT_GLOAD
#undef ATT_LWRITE
  const float inv = 1.0f / (lsum + __shfl_xor(lsum, 32));
  bf16_t* op = O + (size_t)(wid * 32 + r32) * ldo + 4 * hi;
#pragma unroll
  for (int d = 0; d < 4; ++d)
#pragma unroll
    for (int ig = 0; ig < 4; ++ig) {
      u32x2 w; w.x = cvt_pk_bf16(o[d][4 * ig] * inv, o[d][4 * ig + 1] * inv); w.y = cvt_pk_bf16(o[d][4 * ig + 2] * inv, o[d][4 * ig + 3] * inv);
      *(u32x2*)(op + 32 * d + 8 * ig) = w;
    }
}


#define XB_TMO      128
#define XB_XCNT(j)  (256  + 64 * (j))
#define XB_XSUB(j)  (1280 + 64 * (j))
#define XB_XGEN(j)  (2304 + 64 * (j))
#define XB_TOP      3328
#define XB_TOPGEN   3392
#define XCD_BAR_WORDS 3456
#define XB_SPIN_CAP (1u << 18)
__device__ __forceinline__ unsigned xb_ld(unsigned* p)              { return __hip_atomic_load(p, __ATOMIC_RELAXED, __HIP_MEMORY_SCOPE_AGENT); }
__device__ __forceinline__ unsigned xb_add(unsigned* p, unsigned v) { return __hip_atomic_fetch_add(p, v, __ATOMIC_RELAXED, __HIP_MEMORY_SCOPE_AGENT); }
__device__ __forceinline__ unsigned xb_xcc_id() { return (unsigned)__builtin_amdgcn_s_getreg((3 << 11) | 20) & 0xFu; }
#define XB_SPIN(cond, bar) do { unsigned _sp = 0; while (cond) { __builtin_amdgcn_s_sleep(1); \
    if ((++_sp & 255u) == 0u) { if (xb_ld(&(bar)[XB_TMO])) break; if (_sp > XB_SPIN_CAP) { atomicAdd(&(bar)[XB_TMO], 1u); break; } } } } while (0)
struct XcdBarrier { unsigned* bar; unsigned x; volatile LAS unsigned* st; };
__device__ __forceinline__ XcdBarrier xcd_barrier_post(unsigned* bar, volatile LAS unsigned* st) {
  XcdBarrier b; b.bar = bar; b.x = xb_xcc_id(); b.st = st;
  if (threadIdx.x == 0) (void)xb_add(&bar[XB_XCNT(b.x)], 1u);
  return b;
}
__device__ __forceinline__ void xcd_barrier_complete(unsigned* bar, unsigned x, unsigned& nloc, unsigned& nx) {
  const unsigned G = gridDim.x * gridDim.y * gridDim.z;
  unsigned sum, cnt, mine, sp = 0u;
  for (;;) {
    sum = 0u; cnt = 0u; mine = 0u;
#pragma unroll
    for (unsigned j = 0; j < 16; ++j) { const unsigned c = xb_ld(&bar[XB_XCNT(j)]); sum += c; cnt += (c > 0u) ? 1u : 0u; mine = (j == x) ? c : mine; }
    if (sum == G) break;
    __builtin_amdgcn_s_sleep(1);
    if ((++sp & 255u) == 0u) { if (xb_ld(&bar[XB_TMO])) break; if (sp > XB_SPIN_CAP) { atomicAdd(&bar[XB_TMO], 1u); break; } }
  }
  nloc = mine > 0u ? mine : 1u; nx = cnt > 0u ? cnt : 1u;
}
__device__ __forceinline__ void xcd_barrier(const XcdBarrier& b) {
  asm volatile("s_waitcnt vmcnt(0)" ::: "memory");
  __syncthreads();
  if (threadIdx.x == 0) {
    unsigned* bar = b.bar;
    __builtin_amdgcn_s_waitcnt(0);
    unsigned nloc = b.st[0], nx = b.st[1];
    if (nloc == 0u) { xcd_barrier_complete(bar, b.x, nloc, nx); b.st[0] = nloc; b.st[1] = nx; }
    const unsigned old = xb_add(&bar[XB_XSUB(b.x)], 1u);
    const unsigned gen = old / nloc;
    if (old + 1u == (gen + 1u) * nloc) {
      __builtin_amdgcn_fence(__ATOMIC_RELEASE, "agent");
      asm volatile("s_waitcnt vmcnt(0)" ::: "memory");
      const unsigned og = xb_add(&bar[XB_TOP], 1u);
      const unsigned tg = og / nx;
      if (og + 1u == (tg + 1u) * nx) xb_add(&bar[XB_TOPGEN], 1u);
      else XB_SPIN(xb_ld(&bar[XB_TOPGEN]) == tg, bar);
      __builtin_amdgcn_fence(__ATOMIC_ACQUIRE, "agent");
      xb_add(&bar[XB_XGEN(b.x)], 1u);
      asm volatile("s_waitcnt vmcnt(0)" ::: "memory");
    } else {
      XB_SPIN(xb_ld(&bar[XB_XGEN(b.x)]) == gen, bar);
      __builtin_amdgcn_fence(__ATOMIC_ACQUIRE, "agent");
      asm volatile("s_waitcnt vmcnt(0)" ::: "memory");
    }
  }
  __syncthreads();
}

constexpr int NWD = 27;
struct WDesc { const float* src; const float* scale; bf16_t* dst; int K, Ns, Nd, kind, item0, pad; };
struct Args { const float* in[25]; float* out; unsigned char* ws; WDesc wd[NWD]; int nitems; int pad; };

__device__ __forceinline__ int srccol(int kind, int n) {
  if (kind == 0) return n;
  if (kind == 1) { if (n < 512) return n; if (n < 576) { const int r = n - 512; return 512 + ((r & 1) ? 32 : 0) + (r >> 1); } return -1; }
  if (kind == 2) { const int h = n / 192, d = n - h * 192; if (d < 128) return n; const int r = d - 128; return h * 192 + 128 + ((r & 1) ? 32 : 0) + (r >> 1); }
  { const int t = n >> 8, w = n & 255; return (w >> 7) * DFF + 128 * t + (w & 127); }
}

constexpr int LDS_BYTES = 140 * 1024;
#ifndef ONLY
#define ONLY 0
#endif
#define EN(k) (ONLY == 0 || ONLY == (k))
typedef __attribute__((address_space(4))) const Args CArgs;
#define DERIVE_PTRS(ap) \
  unsigned char* ws = (ap)->ws; \
  float* rsA = (float*)(ws + WS_RS); float* rsB = rsA + MTOK; float* rsV = rsB + MTOK; float* rsQ = rsV + MTOK; float* rsKV = rsQ + MTOK; float* rsM = rsKV + MTOK; \
  f32x2* cs = (f32x2*)(ws + WS_CS); \
  bf16_t* memb = (bf16_t*)(ws + WS_MEMB); bf16_t* memk = (bf16_t*)(ws + WS_MEMK); bf16_t* memvt = (bf16_t*)(ws + WS_MEMVT); \
  bf16_t* xb = (bf16_t*)(ws + WS_XB); bf16_t* kvb = (bf16_t*)(ws + WS_KVB); bf16_t* kn = (bf16_t*)(ws + WS_KN); bf16_t* vT = (bf16_t*)(ws + WS_VT); \
  float* halo = (float*)(ws + WS_HALO); \
  bf16_t* gbuf = (bf16_t*)(ws + WS_R); bf16_t* zbuf = (bf16_t*)(ws + WS_R); bf16_t* cat = (bf16_t*)(ws + WS_CAT); bf16_t* qbuf = (bf16_t*)(ws + WS_Q); \
  const float* x_in = (ap)->in[0]; float* xo = (ap)->out; \
  (void)rsA; (void)rsB; (void)rsV; (void)rsQ; (void)rsKV; (void)rsM; (void)cs; (void)memb; (void)memk; (void)memvt; (void)xb; (void)kvb; (void)kn; (void)vT; (void)halo; (void)gbuf; (void)zbuf; (void)cat; (void)qbuf; (void)x_in; (void)xo;
__global__ void __launch_bounds__(512, 2) yoco_fwd(Args a) {
  extern __shared__ __attribute__((aligned(16))) unsigned char lds_raw[];
  LAS unsigned char* lds = (LAS unsigned char*)lds_raw;
  cg::grid_group grid = cg::this_grid();
  volatile LAS unsigned* xst = (volatile LAS unsigned*)(lds + 131072 + 64);
  if (threadIdx.x < 4) xst[threadIdx.x] = (threadIdx.x == 2) ? blockIdx.x : 0u;
  __syncthreads();
#define DERIVE_IDS \
  int tid_o = threadIdx.x; asm volatile("" : "+v"(tid_o)); \
  const int tid = tid_o, lane = tid & 63, wave = __builtin_amdgcn_readfirstlane(tid >> 6); \
  const int G = gridDim.x, bx = __builtin_amdgcn_readfirstlane((int)xst[2]); \
  const int vcu = (G % 8 == 0) ? (bx % 8) * (G / 8) + bx / 8 : bx; \
  const int gw = vcu * 8 + wave, NGW = G * 8; \
  const size_t gtid = (size_t)bx * 512 + tid, NGT = (size_t)G * 512; \
  (void)lane; (void)wave; (void)vcu; (void)gw; (void)NGW; (void)gtid; (void)NGT;
  {
    const Args* ap = &a; DERIVE_PTRS(ap)
    DERIVE_IDS
    LAS float* scr = (LAS float*)(lds + wave * 8448);
    for (int it = gw; it < a.nitems; it += NGW) {
      int di = 0;
#pragma unroll 1
      for (int j = 1; j < NWD; ++j) if (it >= a.wd[j].item0) di = j;
      const float* src = a.wd[di].src; const float* scale = a.wd[di].scale; bf16_t* dst = a.wd[di].dst;
      const int K = a.wd[di].K, Ns = a.wd[di].Ns, Nd = a.wd[di].Nd, kind = a.wd[di].kind, item = it - a.wd[di].item0;
      const int nblk = Nd / 32, kb = item / nblk, nb = item - kb * nblk, k0 = 64 * kb, n0 = 32 * nb;
      const int sc = srccol(kind, n0 + (lane & 31));
      float wv[32];
      { const float* sp = src + (size_t)(k0 + (lane >> 5)) * Ns + (sc >= 0 ? sc : 0);
#pragma unroll
        for (int i = 0; i < 32; ++i) wv[i] = sp[(size_t)(2 * i) * Ns]; }
      if (scale) {
#pragma unroll
        for (int i = 0; i < 32; ++i) wv[i] *= scale[k0 + 2 * i + (lane >> 5)];
      }
#pragma unroll
      for (int i = 0; i < 32; ++i) scr[(2 * i + (lane >> 5)) * 33 + (lane & 31)] = (sc >= 0) ? wv[i] : 0.f;
      asm volatile("s_waitcnt lgkmcnt(0)" ::: "memory");
      const int c = lane & 7;
#pragma unroll
      for (int j = 0; j < 4; ++j) { const int n = (lane >> 3) + 8 * j; const LAS float* s = scr + (8 * c) * 33 + n;
        u32x4 o; o.x = cvt_pk_bf16(s[0 * 33], s[1 * 33]); o.y = cvt_pk_bf16(s[2 * 33], s[3 * 33]); o.z = cvt_pk_bf16(s[4 * 33], s[5 * 33]); o.w = cvt_pk_bf16(s[6 * 33], s[7 * 33]);
        *(u32x4*)(dst + (size_t)(n0 + n) * K + k0 + 8 * c) = o; }
      asm volatile("s_waitcnt lgkmcnt(0)" ::: "memory");
    }
    for (int r = gw; r < MTOK + MMEM; r += NGW) {
      const bool ism = r >= MTOK; const int rr = ism ? r - MTOK : r;
      const f32x4* xr = (const f32x4*)((ism ? a.in[1] : x_in) + (size_t)rr * DM) + lane;
      u32x2* o8 = (u32x2*)((ism ? memb : xb) + (size_t)rr * DM) + lane;
      float s = 0.f;
#pragma unroll
      for (int j = 0; j < 8; ++j) { const f32x4 v = xr[64 * j]; s += (v[0] * v[0] + v[1] * v[1]) + (v[2] * v[2] + v[3] * v[3]); u32x2 w; w.x = cvt_pk_bf16(v[0], v[1]); w.y = cvt_pk_bf16(v[2], v[3]); o8[64 * j] = w; }
      s = wave_sum(s);
      if (lane == 0) (ism ? rsM : rsA)[rr] = s;
    }
    const int* pos = (const int*)a.in[2];
    for (size_t i = gtid; i < (size_t)MTOK * 32; i += NGT) {
      const int row = (int)(i >> 5), j = (int)(i & 31);
      const float inv = 1.0f / powf(10000.0f, (float)(2 * j) / 64.0f);
      const float ang = (float)pos[row] * inv;
      const double rev = (double)ang * 0.15915494309189535;
      const float fr = (float)(rev - floor(rev));
      cs[i] = (f32x2){__builtin_amdgcn_cosf(fr), __builtin_amdgcn_sinf(fr)};
    }
    for (size_t i = gtid; i < (size_t)MTOK * 4; i += NGT) rsB[i] = 0.f;
    if (bx == 0) for (int i = tid; i < XCD_BAR_WORDS; i += 512) ((unsigned*)ws)[i] = 0u;
  }
  grid.sync();
  XcdBarrier xbar; xbar.bar = (unsigned*)a.ws; xbar.x = xb_xcc_id(); xbar.st = xst;
  if (threadIdx.x == 0) xst[3] = xb_add(&xbar.bar[XB_XCNT(xbar.x)], 1u);
  xcd_barrier(xbar);
  if (threadIdx.x == 0) {
    const unsigned Gn = gridDim.x; bool ok = (Gn % 8u) == 0u;
    for (unsigned j = 0; j < 8; ++j) if (xb_ld(&xbar.bar[XB_XCNT(j)]) != Gn / 8u) ok = false;
    xst[2] = ok ? xst[3] * 8u + xbar.x : blockIdx.x;
  }
  __syncthreads();

  pg8::StaticOrder S;
#pragma unroll 1
  for (int l = -1; l < 4; ++l) {
    const bool isA = l < 2; const int j = l - 2;
#pragma unroll 1
    for (int s = 0; s < 10; ++s) {
      CArgs* ap = (CArgs*)__builtin_amdgcn_kernarg_segment_ptr(); asm volatile("" : "+s"(ap));
      DERIVE_PTRS(ap)
      DERIVE_IDS
      int type = 0; bool sync = false;
      pg8::Gemm g{nullptr, nullptr, 0, 0, 0, 0, 0}; int corder = bx;
      EpiG eg{nullptr, 0, nullptr, 0.f, nullptr, 0.f, 0, 0, 0, nullptr, 0, nullptr, 1 << 30, 1.f};
      EpiRes er{nullptr, nullptr, xb, nullptr};
      if (l < 0) {
        if (s < 8) {
          const int ml = s >> 1; const bf16_t* wt = ap->wd[9 + ml].dst;
          type = 1; corder = (bx + 16 * s) % G; sync = (s == 7);
          if (!(s & 1)) { g = pg8::Gemm{memb, wt, MMEM, 512, DM, DM, DM}; eg.O = memk + (size_t)ml * MMEM * 512; eg.ldc = 512; eg.rss = rsM; eg.rinvD = 1.0f / DM; }
          else { g = pg8::Gemm{wt + (size_t)512 * DM, memb, 512, MMEM, DM, DM, DM}; eg.O = memvt + (size_t)ml * 512 * MMEM; eg.ldc = MMEM; eg.css = rsM; eg.cinvD = 1.0f / DM; }
        }
      } else {
        switch (s) {
          case 0: if (l == 2) { type = 1; sync = true;
              g = pg8::Gemm{xb, ap->wd[4].dst, MTOK, KVW, DM, DM, DM};
              eg.O = kvb; eg.ldc = KVW; eg.rss = rsA; eg.rinvD = 1.0f / DM; eg.ss_lo = 0; eg.ss_hi = 512; eg.ssacc = rsKV; eg.rope_mode = 2; eg.cs = cs; } break;
          case 1: type = 1; eg.O = zbuf; eg.rss = rsA; eg.rinvD = 1.0f / DM; eg.sc_val = SC_MEM;
            if (isA) { sync = true; g = pg8::Gemm{xb, ap->wd[l].dst, MTOK, ZA_W, DM, DM, DM}; eg.ldc = ZA_W; eg.gelu_hi = 2 * GW; eg.ss_lo = GW; eg.ss_hi = 2 * GW; eg.ssacc = rsV; eg.sc_lo = 2 * GW; }
            else { g = pg8::Gemm{xb, ap->wd[2 + j].dst, MTOK, ZB_W, DM, DM, DM}; eg.ldc = ZB_W; eg.ss_lo = 0; eg.ss_hi = 512; eg.ssacc = rsQ; eg.sc_lo = 512; }
            break;
          case 2: if (!isA) { type = 1; g = pg8::Gemm{kvb, ap->wd[5 + j].dst, MTOK, GW, 512, KVW, 512}; eg.O = kn; eg.ldc = GW; eg.rss = rsKV; eg.rinvD = 1.0f / 512; } break;
          case 3: if (!isA) { type = 1; sync = true; g = pg8::Gemm{ap->wd[7 + j].dst, kvb, GW, MTOK, 512, 512, KVW}; eg.O = vT; eg.ldc = MTOK; eg.css = rsKV; eg.cinvD = 1.0f / 512; } break;
          case 4: if (!isA) { type = 1; sync = true; g = pg8::Gemm{zbuf, ap->wd[13 + j].dst, MTOK, QW, 512, ZB_W, 512};
              eg.O = qbuf; eg.ldc = QW; eg.rss = rsQ; eg.rinvD = 1.0f / 512; eg.rope_mode = 1; eg.cs = cs; eg.sc_lo = 0; eg.sc_val = SC_MLA; } break;
          case 5: type = 4; sync = true; break;
          case 6: type = 2; sync = true; g = pg8::Gemm{cat, ap->wd[15 + l].dst, MTOK, DM, DM, DM, DM}; er.xold = (l == 0) ? x_in : xo; er.xnew = xo; er.ssacc = rsB; break;
          case 7: type = 3; sync = true; g = pg8::Gemm{xb, ap->wd[19 + l].dst, MTOK, DFF2, DM, DM, DM}; break;
          case 8: type = 5; sync = true; break;
          case 9: type = 2; sync = true; g = pg8::Gemm{gbuf, ap->wd[23 + l].dst, MTOK, DM, DFF, DFF, DFF}; er.xold = xo; er.xnew = xo; er.ssacc = rsA; break;
        }
      }
      if (type == 1 && EN(1)) { S.init(g.M, g.N, G, corder); pg8::gemm_phase<EpiG>(lds, g, S, eg); }
      else if (type == 2 && EN(2)) {
        S.init(g.M, g.N, G, corder); pg8::gemm_phase<EpiRes>(lds, g, S, er);
        if (s == 6) for (size_t i = gtid; i < (size_t)MTOK; i += NGT) { rsA[i] = 0.f; rsV[i] = 0.f; rsQ[i] = 0.f; }
      }
      else if (type == 3 && EN(3)) {
        S.init(g.M, g.N, G, corder);
        EpiUp E{gbuf, halo, rsB, ap->in[22] + (size_t)l * 3 * DFF2, ap->in[23] + (size_t)l * DFF2, lds + 131072 + 1024};
        pg8::gemm_phase<EpiUp>(lds, g, S, E);
      }
      else if (type == 4 && (EN(4) || EN(6) || EN(7))) {
        if (isA && EN(4)) {
          const float* wsp = ap->in[8] + (size_t)l * 12 * 128 * 128; const float* bsp = ap->in[9] + (size_t)l * 12 * 128; const float* gv = ap->in[7] + (size_t)l * GW;
          LAS unsigned char* Wl = lds; LAS unsigned char* Vt = lds + 128 * 272;
          const int r32 = lane & 31, hi = lane >> 5, tb = wave & 3, chh = wave >> 2;
          f32x4 wreg[8], qreg = (f32x4){0.f, 0.f, 0.f, 0.f}; u32x4 vreg[4];
#pragma unroll
          for (int i = 0; i < 8; ++i) wreg[i] = (f32x4){0.f, 0.f, 0.f, 0.f};
#pragma unroll
          for (int i = 0; i < 4; ++i) vreg[i] = (u32x4){0u, 0u, 0u, 0u};
          if (vcu < NB * 32 * 12) { const int gi_ = (vcu) % 12, tok0_ = ((vcu) / 12) * 128;
#pragma unroll
              for (int i = 0; i < 8; ++i) { const int idx = tid + i * 512, t = idx >> 5, s4 = (idx & 31) * 4; wreg[i] = *(const f32x4*)(wsp + ((size_t)gi_ * 128 + t) * 128 + s4); }
              qreg = *(const f32x4*)(rsV + tok0_ + (tid & 31) * 4);
#pragma unroll
              for (int i = 0; i < 4; ++i) { const int idx = tid + i * 512, sr = (idx >> 8) * 16 + (idx & 15), c8 = ((idx >> 4) & 15) * 8;
                vreg[i] = *(const u32x4*)(zbuf + (size_t)(tok0_ + sr) * ZA_W + GW + gi_ * 128 + c8); } }
          for (int uidx = vcu; uidx < NB * 32 * 12; uidx += G) {
            const int gi = uidx % 12, bn = uidx / 12, tok0 = bn * 128;
            { f32x4 rq;
#pragma unroll
              for (int e = 0; e < 4; ++e) rq[e] = __builtin_amdgcn_rsqf(qreg[e] * (1.0f / GW) + EPS);
#pragma unroll
              for (int i = 0; i < 8; ++i) { const int idx = tid + i * 512, t = idx >> 5, s4 = (idx & 31) * 4;
                f32x4 w = wreg[i];
#pragma unroll
                for (int e = 0; e < 4; ++e) w[e] = (s4 + e <= t) ? w[e] * rq[e] : 0.f;
                *(LAS u32x2*)(Wl + t * 272 + s4 * 2) = (u32x2){cvt_pk_bf16(w[0], w[1]), cvt_pk_bf16(w[2], w[3])}; } }
#pragma unroll
            for (int i = 0; i < 4; ++i) { const int idx = tid + i * 512, sr = (idx >> 8) * 16 + (idx & 15), c8 = ((idx >> 4) & 15) * 8;
              const unsigned vv[4] = {vreg[i].x, vreg[i].y, vreg[i].z, vreg[i].w};
#pragma unroll
              for (int e = 0; e < 4; ++e) { *(LAS unsigned short*)(Vt + (c8 + 2 * e) * 272 + sr * 2) = (unsigned short)(vv[e] & 0xffffu); *(LAS unsigned short*)(Vt + (c8 + 2 * e + 1) * 272 + sr * 2) = (unsigned short)(vv[e] >> 16); } }
            __syncthreads();
            if (uidx + G < NB * 32 * 12) { const int gi_ = (uidx + G) % 12, tok0_ = ((uidx + G) / 12) * 128;
#pragma unroll
              for (int i = 0; i < 8; ++i) { const int idx = tid + i * 512, t = idx >> 5, s4 = (idx & 31) * 4; wreg[i] = *(const f32x4*)(wsp + ((size_t)gi_ * 128 + t) * 128 + s4); }
              qreg = *(const f32x4*)(rsV + tok0_ + (tid & 31) * 4);
#pragma unroll
              for (int i = 0; i < 4; ++i) { const int idx = tid + i * 512, sr = (idx >> 8) * 16 + (idx & 15), c8 = ((idx >> 4) & 15) * 8;
                vreg[i] = *(const u32x4*)(zbuf + (size_t)(tok0_ + sr) * ZA_W + GW + gi_ * 128 + c8); } }
            f32x16 acc2[2];
#pragma unroll
            for (int cb = 0; cb < 2; ++cb)
#pragma unroll
              for (int i = 0; i < 16; ++i) acc2[cb][i] = 0.f;
            const int nks = 2 * (tb + 1);
            for (int ks = 0; ks < nks; ++ks) {
              const bf16x8 wf = *(const LAS bf16x8*)(Wl + (32 * tb + r32) * 272 + ks * 32 + hi * 16);
#pragma unroll
              for (int cb = 0; cb < 2; ++cb) {
                const bf16x8 vf = *(const LAS bf16x8*)(Vt + (64 * chh + 32 * cb + r32) * 272 + ks * 32 + hi * 16);
                acc2[cb] = __builtin_amdgcn_mfma_f32_32x32x16_bf16(vf, wf, acc2[cb], 0, 0, 0);
              }
            }
            const int t = 32 * tb + r32; const float bt = bsp[gi * 128 + t];
            const size_t rowoff = (size_t)(tok0 + t);
#pragma unroll
            for (int cb = 0; cb < 2; ++cb)
#pragma unroll
              for (int ig = 0; ig < 4; ++ig) {
                const int c = gi * 128 + 64 * chh + 32 * cb + 8 * ig + 4 * hi;
                const f32x4 gg = *(const f32x4*)(gv + c);
                const u32x2 uu = *(const u32x2*)(zbuf + rowoff * ZA_W + c);
                const float u0 = __uint_as_float(uu.x << 16), u1 = __uint_as_float(uu.x & 0xffff0000u), u2 = __uint_as_float(uu.y << 16), u3 = __uint_as_float(uu.y & 0xffff0000u);
                const float o0 = u0 * (acc2[cb][4 * ig] * gg[0] + bt), o1 = u1 * (acc2[cb][4 * ig + 1] * gg[1] + bt), o2 = u2 * (acc2[cb][4 * ig + 2] * gg[2] + bt), o3 = u3 * (acc2[cb][4 * ig + 3] * gg[3] + bt);
                *(u32x2*)(cat + rowoff * DM + c) = (u32x2){cvt_pk_bf16(o0, o1), cvt_pk_bf16(o2, o3)};
              }
            __syncthreads();
          }
        } else if (!isA && EN(6)) {
          for (int p = 6 * vcu; p < 1536; p += 6 * G)
#pragma unroll 1
            for (int uu = p; uu < p + 6 && uu < 1536; ++uu) {
              const int pp = uu >> 1, half = uu & 1, bh = pp >> 3, i8 = pp & 7, b = bh / 12, h = bh - b * 12;
              const int qblk = half ? i8 : 15 - i8; const size_t row0 = (size_t)b * SEQ + qblk * 256;
              attn_unit<192, true>(lds, qbuf + row0 * QW + h * 192, QW, kn + (size_t)b * SEQ * GW + h * 128, GW, kvb + (size_t)b * SEQ * KVW + 512, KVW,
                                   vT + (size_t)(h * 128) * MTOK + (size_t)b * SEQ, MTOK, (qblk + 1) * 4, qblk * 256, cat + row0 * DM + h * 128, DM);
            }
        }
        if (EN(7)) {
          const bf16_t* qm = zbuf + (isA ? 2 * GW : 512); const int ldq = isA ? ZA_W : ZB_W;
#pragma unroll 1
          for (int uidx = vcu; uidx < NB * 4 * 16; uidx += G) {
            const int qblk = uidx & 15, bh = uidx >> 4, b = bh >> 2, h = bh & 3; const size_t row0 = (size_t)b * SEQ + qblk * 256;
            attn_unit<128, false>(lds, qm + row0 * ldq + h * 128, ldq, memk + (size_t)l * MMEM * 512 + (size_t)b * NMEM * 512 + h * 128, 512, nullptr, 0,
                                  memvt + (size_t)l * 512 * MMEM + (size_t)(h * 128) * MMEM + b * NMEM, MMEM, 4, 0, cat + row0 * DM + GW + h * 128, DM);
          }
        }
        for (size_t i = gtid; i < (size_t)MTOK; i += NGT) rsB[i] = 0.f;
      }
      else if (type == 5 && EN(5)) {
        const float* cw = ap->in[22] + (size_t)l * 3 * DFF2; const float* cb = ap->in[23] + (size_t)l * DFF2;
        for (size_t idx = gtid; idx < (size_t)1024 * (DFF / 4); idx += NGT) {
          const int rowi = (int)(idx / (DFF / 4)), c4 = (int)(idx % (DFF / 4)) * 4, blk = rowi >> 1, rr = rowi & 1;
          const bool hp = (blk & 63) != 0;
          const float* H0 = halo + (size_t)blk * 4 * DFF2; const float* Hp = H0 - (size_t)4 * DFF2;
          f32x4 cv[2];
#pragma unroll
          for (int part = 0; part < 2; ++part) {
            const int off = part * DFF + c4; const f32x4 z4 = (f32x4){0.f, 0.f, 0.f, 0.f};
            const f32x4 a0 = *(const f32x4*)(H0 + (size_t)rr * DFF2 + off);
            const f32x4 p3 = hp ? *(const f32x4*)(Hp + (size_t)3 * DFF2 + off) : z4;
            const f32x4 a1 = rr ? *(const f32x4*)(H0 + off) : p3;
            const f32x4 a2 = rr ? p3 : (hp ? *(const f32x4*)(Hp + (size_t)2 * DFF2 + off) : z4);
            cv[part] = *(const f32x4*)(cw + 2 * DFF2 + off) * a0 + *(const f32x4*)(cw + DFF2 + off) * a1 + *(const f32x4*)(cw + off) * a2 + *(const f32x4*)(cb + off);
          }
          u32x2 w; w.x = cvt_pk_bf16(silu1(cv[0][0]) * cv[1][0], silu1(cv[0][1]) * cv[1][1]); w.y = cvt_pk_bf16(silu1(cv[0][2]) * cv[1][2], silu1(cv[0][3]) * cv[1][3]);
          *(u32x2*)(gbuf + (size_t)(blk * 64 + rr) * DFF + c4) = w;
        }
      }
      if (sync) xcd_barrier(xbar);
    }
  }
  {
    const Args* ap = &a; DERIVE_PTRS(ap)
    DERIVE_IDS
    const float* gf = a.in[5];
    for (size_t i = gtid; i < (size_t)MTOK * (DM / 4); i += NGT) {
      const int row = (int)(i / (DM / 4)), c4 = (int)(i % (DM / 4)) * 4;
      const float r = __builtin_amdgcn_rsqf(rsA[row] * (1.0f / DM) + EPS);
      f32x4* p = (f32x4*)(xo + (size_t)row * DM + c4);
      *p = *p * r * *(const f32x4*)(gf + c4);
    }
  }
}

extern "C" void kernel_launch(void* const* d_in, const int* in_sizes, int n_in, void* d_out, int out_size, void* d_ws, size_t ws_size, hipStream_t stream) {
  static int grid_blocks = 0;
  if (!grid_blocks) {
    int dev = 0, cus = 0, per_cu = 0;
    (void)hipGetDevice(&dev);
    (void)hipDeviceGetAttribute(&cus, hipDeviceAttributeMultiprocessorCount, dev);
    (void)hipFuncSetAttribute((const void*)yoco_fwd, hipFuncAttributeMaxDynamicSharedMemorySize, LDS_BYTES);
    (void)hipOccupancyMaxActiveBlocksPerMultiprocessor(&per_cu, (const void*)yoco_fwd, 512, LDS_BYTES);
    if (per_cu < 1) per_cu = 1;
    grid_blocks = cus * per_cu;
    if (ws_size < WS_END) fprintf(stderr, "kernel_launch: workspace too small: %zu < %zu\n", ws_size, (size_t)WS_END);
  }
  Args a; memset(&a, 0, sizeof(a));
  for (int i = 0; i < 25; ++i) a.in[i] = (const float*)d_in[i];
  a.out = (float*)d_out; a.ws = (unsigned char*)d_ws;
  const float* const* in = a.in;
  bf16_t* wp = (bf16_t*)((unsigned char*)d_ws + WS_W);
  int nd = 0, items = 0;
  auto add = [&](const float* src, const float* scale, int K, int Ns, int Nd, int kind) {
    WDesc& d = a.wd[nd++]; d.src = src; d.scale = scale; d.dst = wp; d.K = K; d.Ns = Ns; d.Nd = Nd; d.kind = kind; d.item0 = items; d.pad = 0;
    items += (K / 64) * (Nd / 32); wp += (size_t)K * Nd;
  };
  for (int l = 0; l < 2; ++l) add(in[6] + (size_t)l * DM * ZA_W, in[3] + (size_t)l * DM, DM, ZA_W, ZA_W, 0);
  for (int j = 0; j < 2; ++j) add(in[13] + (size_t)j * DM * ZB_W, in[3] + (size_t)(2 + j) * DM, DM, ZB_W, ZB_W, 0);
  add(in[11], in[10], DM, 576, KVW, 1);
  for (int j = 0; j < 2; ++j) add(in[16] + (size_t)j * 512 * GW, in[12], 512, GW, GW, 0);
  for (int j = 0; j < 2; ++j) add(in[17] + (size_t)j * 512 * GW, in[12], 512, GW, GW, 0);
  for (int l = 0; l < 4; ++l) add(in[19] + (size_t)l * DM * 1024, in[18] + (size_t)l * DM, DM, 1024, 1024, 0);
  for (int j = 0; j < 2; ++j) add(in[15] + (size_t)j * 512 * QW, in[14] + (size_t)j * 512, 512, QW, QW, 2);
  for (int l = 0; l < 4; ++l) add(in[20] + (size_t)l * DM * DM, nullptr, DM, DM, DM, 0);
  for (int l = 0; l < 4; ++l) add(in[21] + (size_t)l * DM * DFF2, in[4] + (size_t)l * DM, DM, DFF2, DFF2, 3);
  for (int l = 0; l < 4; ++l) add(in[24] + (size_t)l * DFF * DM, nullptr, DFF, DM, DM, 0);
  a.nitems = items;
  void* args[] = {&a};
  hipError_t e = hipLaunchCooperativeKernel((const void*)yoco_fwd, dim3(grid_blocks), dim3(512), args, LDS_BYTES, stream);
  if (e != hipSuccess) fprintf(stderr, "cooperative launch failed: %s (grid %d)\n", hipGetErrorString(e), grid_blocks);
}
```

```cpp
#include <hip/hip_runtime.h>
#include <hip/hip_cooperative_groups.h>
#include <cstdio>
#include <cstring>
namespace cg = cooperative_groups;

#define LAS __attribute__((address_space(3)))
typedef unsigned short bf16_t;
typedef short bf16x8 __attribute__((ext_vector_type(8)));
typedef short s16x4 __attribute__((ext_vector_type(4)));
typedef float f32x4 __attribute__((ext_vector_type(4)));
typedef float f32x2 __attribute__((ext_vector_type(2)));
typedef float f32x16 __attribute__((ext_vector_type(16)));
typedef unsigned u32x4 __attribute__((ext_vector_type(4)));
typedef unsigned u32x2 __attribute__((ext_vector_type(2)));

constexpr int DM = 2048, NB = 8, SEQ = 4096, MTOK = NB * SEQ, NMEM = 256, MMEM = NB * NMEM;
constexpr int GW = 1536, ZA_W = 3584, ZB_W = 1024, QW = 2304, KVW = 768, DFF = 5632, DFF2 = 11264;
constexpr float EPS = 1e-6f;
constexpr float LOG2E = 1.4426950408889634f;
constexpr float SC_MEM = 0.08838834764831845f * LOG2E;
constexpr float SC_MLA = 0.07216878364870323f * LOG2E;

constexpr size_t MiB = 1u << 20;
constexpr size_t WS_RS = 1204 * MiB;
constexpr size_t WS_CS = 2 * MiB;
constexpr size_t WS_MEMB = 10 * MiB;
constexpr size_t WS_MEMK = 18 * MiB;
constexpr size_t WS_MEMVT = 26 * MiB;
constexpr size_t WS_W = 34 * MiB;
constexpr size_t WS_XB = 396 * MiB;
constexpr size_t WS_KVB = 524 * MiB;
constexpr size_t WS_KN = 572 * MiB;
constexpr size_t WS_VT = 668 * MiB;
constexpr size_t WS_HALO = 764 * MiB;
constexpr size_t WS_R = 852 * MiB;
constexpr size_t WS_CAT = WS_R + 224 * MiB;
constexpr size_t WS_Q = WS_R + 64 * MiB;
constexpr size_t WS_END = 1206 * MiB;

typedef __bf16 bf16x2_t __attribute__((ext_vector_type(2)));
__device__ __forceinline__ unsigned cvt_pk_bf16(float lo, float hi) { const f32x2 v = {lo, hi}; const bf16x2_t b = __builtin_convertvector(v, bf16x2_t); return __builtin_bit_cast(unsigned, b); }
typedef long long i64;
constexpr float FX_SCALE = 16777216.0f, FX_INV = 1.0f / 16777216.0f;
__device__ __forceinline__ i64 f2fx(float s) { return (i64)(s * FX_SCALE); }
__device__ __forceinline__ float fx2f(i64 v) { return (float)v * FX_INV; }
__device__ __forceinline__ void fx_add(i64* p, float s) { atomicAdd((unsigned long long*)p, (unsigned long long)f2fx(s)); }
__device__ __forceinline__ float wave_sum(float v) {
#pragma unroll
  for (int o = 1; o < 64; o <<= 1) v += __shfl_xor(v, o);
  return v;
}
__device__ __forceinline__ f32x2 gelu_pk(f32x2 v) {
  const f32x2 av = __builtin_elementwise_abs(v), d = av * 0.2316418882f + 1.0f;
  f32x2 t; t.x = __builtin_amdgcn_rcpf(d.x); t.y = __builtin_amdgcn_rcpf(d.y);
  f32x2 q = t * 0.5307027145f + (-0.7265760135f); q = q * t + 0.7107068705f; q = q * t + (-0.142248368f); q = q * t + 0.127414796f; q = q * t;
  const f32x2 s = (v * v) * (-0.72134752044f);
  f32x2 e; e.x = __builtin_amdgcn_exp2f(s.x); e.y = __builtin_amdgcn_exp2f(s.y);
  const f32x2 m = v * (q * e), r = v - m;
  f32x2 o; o.x = v.x < 0.f ? m.x : r.x; o.y = v.y < 0.f ? m.y : r.y; return o;
}
__device__ __forceinline__ f32x4 gelu4(f32x4 v) { f32x2 a = gelu_pk((f32x2){v[0], v[1]}), b = gelu_pk((f32x2){v[2], v[3]}); return (f32x4){a.x, a.y, b.x, b.y}; }
__device__ __forceinline__ float silu1(float x) { return x * __builtin_amdgcn_rcpf(1.0f + __builtin_amdgcn_exp2f(-x * LOG2E)); }
__device__ __forceinline__ float ror1(float v) { return __builtin_bit_cast(float, __builtin_amdgcn_update_dpp(0, __builtin_bit_cast(int, v), 0x121, 0xf, 0xf, true)); }
__device__ __forceinline__ float ror2(float v) { return __builtin_bit_cast(float, __builtin_amdgcn_update_dpp(0, __builtin_bit_cast(int, v), 0x122, 0xf, 0xf, true)); }
__device__ __forceinline__ float shr1o(float old, float v) { return __builtin_bit_cast(float, __builtin_amdgcn_update_dpp(__builtin_bit_cast(int, old), __builtin_bit_cast(int, v), 0x111, 0xf, 0xf, false)); }
__device__ __forceinline__ float shr2o(float old, float v) { return __builtin_bit_cast(float, __builtin_amdgcn_update_dpp(__builtin_bit_cast(int, old), __builtin_bit_cast(int, v), 0x112, 0xf, 0xf, false)); }
__device__ __forceinline__ f32x4 shr1ov(f32x4 o, f32x4 v) { return (f32x4){shr1o(o[0], v[0]), shr1o(o[1], v[1]), shr1o(o[2], v[2]), shr1o(o[3], v[3])}; }
__device__ __forceinline__ f32x4 shr2ov(f32x4 o, f32x4 v) { return (f32x4){shr2o(o[0], v[0]), shr2o(o[1], v[1]), shr2o(o[2], v[2]), shr2o(o[3], v[3])}; }
__device__ __forceinline__ f32x4 ror1v(f32x4 v) { return (f32x4){ror1(v[0]), ror1(v[1]), ror1(v[2]), ror1(v[3])}; }
__device__ __forceinline__ f32x4 ror2v(f32x4 v) { return (f32x4){ror2(v[0]), ror2(v[1]), ror2(v[2]), ror2(v[3])}; }

namespace pg8 {
constexpr int BM = 256, BK = 64, HALF = 128, HTB = HALF * BK * 2, STAGE_BYTES = 8 * HTB, NXCD = 8, WGM = 8;
__device__ __forceinline__ int lds_byte(int r, int c) { const int st = (r >> 4) * 2 + (c >> 5), rr = r & 15, cc = c & 31, ob = rr * 64 + cc * 2; return st * 1024 + (ob ^ (((ob >> 9) & 1) << 5)); }
__device__ __forceinline__ void stage_rc(int b, int& R, int& C) { const int st = b / 1024, sb = b % 1024, swz = sb ^ (((sb >> 9) & 1) << 5); R = (st >> 1) * 16 + swz / 64; C = (st & 1) * 32 + (swz % 64) / 2; }
__device__ __forceinline__ int perm32(int rho) { const int n = rho >> 4, i = rho & 15; return 8 * (i >> 2) + 4 * n + (i & 3); }
struct Unit { int pm, pn; };
struct Gemm { const bf16_t* A; const bf16_t* Bt; int M, N, K, lda, ldb; };
struct StaticOrder {
  int nM, nN, nwg, G, c;
  __device__ void init(int M, int N, int G_, int c_) { nM = M / BM; nN = N / BM; nwg = nM * nN; G = G_; c = c_; }
  __device__ bool next(int i, Unit& u) const {
    const long L = (long)i * G + c; if (L >= nwg) return false;
    int wgid = (int)L; { const int q = nwg / NXCD, r = nwg % NXCD, xcd = wgid % NXCD, off = wgid / NXCD; wgid = (xcd < r ? xcd * (q + 1) : r * (q + 1) + (xcd - r) * q) + off; }
    const int nig = WGM * nN, gid = wgid / nig, fm = gid * WGM, gsz = (nM - fm) < WGM ? (nM - fm) : WGM;
    u.pm = fm + ((wgid % nig) % gsz); u.pn = (wgid % nig) / gsz; return true;
  }
};

#ifndef PG8_SP2
#define PG8_SP2 true
#endif
#ifndef PG8_ALIGN
#define PG8_ALIGN true
#endif
template <class Epi, bool SP2 = PG8_SP2, bool ALIGN_EPI = PG8_ALIGN>
__device__ __forceinline__ void gemm_phase(LAS unsigned char* lds, const Gemm g, const StaticOrder& S, const Epi& E) {
  int tid_o = threadIdx.x; asm volatile("" : "+v"(tid_o));
  const int tid = tid_o, wid = __builtin_amdgcn_readfirstlane(tid >> 6), lane = tid & 63, wr = wid >> 2, wc = wid & 3, fr = lane & 15, fq = lane >> 4;
  const int K = g.K, nt = K / BK;
  unsigned voffA[2], voffB[2];
#pragma unroll
  for (int i = 0; i < 2; ++i) { int R, C; stage_rc(tid * 16 + i * 8192, R, C); const int Rb = Epi::PERM ? ((R & ~31) + perm32(R & 31)) : R;
    voffA[i] = (unsigned)(R * g.lda + C) * 2u; voffB[i] = (unsigned)(Rb * g.ldb + C) * 2u; }
  const size_t kstep = (size_t)(BK * 2);
  const size_t hstepA = (size_t)HALF * g.lda * 2, hstepB = (size_t)HALF * g.ldb * 2;
  const size_t tstepA = 2 * hstepA, tstepB = 2 * hstepB;
  const unsigned ldsw = (unsigned)wid * 1024u;
  const int aoff = lds_byte(wr * 64 + fr, fq * 8), boff = lds_byte(wc * 32 + fr, fq * 8);
#define PG8_SA(b, h) (((b) * 2 + (h)) * HTB)
#define PG8_SB(b, h) ((4 + (b) * 2 + (h)) * HTB)
#define PG8_STAGE(bufoff, gbase, voff) do { _Pragma("unroll") for (int _i = 0; _i < 2; ++_i) \
    __builtin_amdgcn_global_load_lds((const unsigned*)((const char*)(gbase) + (voff)[_i]), (LAS unsigned*)(lds + (bufoff) + ldsw + _i * 8192), 16, 0, 0); } while (0)
#define PG8_LDA(dst, b, h) do { _Pragma("unroll") for (int m = 0; m < 4; ++m) _Pragma("unroll") for (int k = 0; k < 2; ++k) dst[m][k] = *(const LAS bf16x8*)(lds + PG8_SA(b, h) + aoff + m * 2048 + k * 1024); } while (0)
#define PG8_LDB(dst, b, h) do { _Pragma("unroll") for (int n = 0; n < 2; ++n) _Pragma("unroll") for (int k = 0; k < 2; ++k) dst[n][k] = *(const LAS bf16x8*)(lds + PG8_SB(b, h) + boff + n * 2048 + k * 1024); } while (0)
#define PG8_MMA(ai, bj, At, Bt) do { __builtin_amdgcn_s_setprio(1); _Pragma("unroll") for (int m = 0; m < 4; ++m) _Pragma("unroll") for (int n = 0; n < 2; ++n) _Pragma("unroll") for (int k = 0; k < 2; ++k) \
    acc[ai][bj][m][n] = __builtin_amdgcn_mfma_f32_16x16x32_bf16(Bt[n][k], At[m][k], acc[ai][bj][m][n], 0, 0, 0); __builtin_amdgcn_s_setprio(0); } while (0)
#define PG8_WAIT_V(n) asm volatile("s_waitcnt vmcnt(" #n ")" ::: "memory")
#define PG8_WAIT_L(n) asm volatile("s_waitcnt lgkmcnt(" #n ")" ::: "memory")
#define PG8_BAR __builtin_amdgcn_s_barrier()
#define PG8_SCHED __builtin_amdgcn_sched_barrier(0)
  Unit cur, nxt; int ui = 0;
  if (!S.next(0, cur)) return;
  f32x4 acc[2][2][4][2];
  if constexpr (Epi::INIT) E.init(acc, cur, wr, wc, fr, fq);
  else {
#pragma unroll
  for (int a = 0; a < 2; ++a)
#pragma unroll
    for (int b = 0; b < 2; ++b)
#pragma unroll
      for (int m = 0; m < 4; ++m)
#pragma unroll
        for (int n = 0; n < 2; ++n) acc[a][b][m][n] = (f32x4){0.f, 0.f, 0.f, 0.f};
  }
  bf16x8 At[4][2], B0[2][2], B1[2][2];
  const char* cA = (const char*)g.A + (size_t)cur.pm * tstepA; const char* cB = (const char*)g.Bt + (size_t)cur.pn * tstepB;
  if constexpr (SP2) {
    PG8_STAGE(PG8_SB(0, 0), cB, voffB); PG8_STAGE(PG8_SB(0, 1), cB + hstepB, voffB); PG8_STAGE(PG8_SA(0, 0), cA, voffA); PG8_STAGE(PG8_SA(0, 1), cA + hstepA, voffA);
    if (wr == 1) PG8_BAR;
    PG8_WAIT_V(2); PG8_BAR;
    PG8_STAGE(PG8_SB(1, 0), cB + kstep, voffB); PG8_STAGE(PG8_SA(1, 0), cA + kstep, voffA); PG8_STAGE(PG8_SB(1, 1), cB + hstepB + kstep, voffB);
    PG8_WAIT_V(6); PG8_BAR;
  } else {
  PG8_STAGE(PG8_SB(0, 0), cB, voffB); PG8_STAGE(PG8_SA(0, 0), cA, voffA); PG8_STAGE(PG8_SB(0, 1), cB + hstepB, voffB); PG8_STAGE(PG8_SA(0, 1), cA + hstepA, voffA);
  if (wr == 1) PG8_BAR;
  PG8_WAIT_V(4); PG8_BAR;
  PG8_STAGE(PG8_SB(1, 0), cB + kstep, voffB); PG8_STAGE(PG8_SA(1, 0), cA + kstep, voffA); PG8_STAGE(PG8_SB(1, 1), cB + hstepB + kstep, voffB);
  PG8_WAIT_V(6); PG8_BAR;
  }
  for (;;) {
    const bool has_next = S.next(ui + 1, nxt);
    const char* nA = has_next ? (const char*)g.A + (size_t)nxt.pm * tstepA : cA; const char* nB = has_next ? (const char*)g.Bt + (size_t)nxt.pn * tstepB : cB;
    for (int t = 0; t < nt; t += 2) {
      const bool last = (t == nt - 2);
      const char* a1 = cA + (size_t)(t + 1) * kstep;
      const char* a2 = last ? nA : cA + (size_t)(t + 2) * kstep; const char* b2 = last ? nB : cB + (size_t)(t + 2) * kstep;
      const char* a3 = a2 + kstep; const char* b3 = b2 + kstep;
      if constexpr (SP2) {
      PG8_LDB(B0, 0, 0); PG8_LDB(B1, 0, 1); PG8_SCHED; PG8_LDA(At, 0, 0); PG8_STAGE(PG8_SA(1, 1), a1 + hstepA, voffA);
      PG8_WAIT_V(8); PG8_WAIT_L(0); PG8_BAR; PG8_MMA(0, 0, At, B0); PG8_MMA(0, 1, At, B1); PG8_BAR; PG8_SCHED;
      PG8_LDA(At, 0, 1); PG8_STAGE(PG8_SB(0, 0), b2, voffB); PG8_STAGE(PG8_SB(0, 1), b2 + hstepB, voffB); PG8_STAGE(PG8_SA(0, 0), a2, voffA);
      PG8_WAIT_V(8); PG8_WAIT_L(0); PG8_BAR; PG8_MMA(1, 0, At, B0); PG8_MMA(1, 1, At, B1); PG8_BAR; PG8_SCHED;
      PG8_LDB(B0, 1, 0); PG8_LDB(B1, 1, 1); PG8_SCHED; PG8_LDA(At, 1, 0); PG8_STAGE(PG8_SA(0, 1), a2 + hstepA, voffA);
      PG8_WAIT_V(8); PG8_WAIT_L(0); PG8_BAR; PG8_MMA(0, 0, At, B0); PG8_MMA(0, 1, At, B1); PG8_BAR; PG8_SCHED;
      PG8_LDA(At, 1, 1); PG8_STAGE(PG8_SB(1, 0), b3, voffB); PG8_STAGE(PG8_SB(1, 1), b3 + hstepB, voffB); PG8_STAGE(PG8_SA(1, 0), a3, voffA);
      PG8_WAIT_V(8); PG8_WAIT_L(0); PG8_BAR; PG8_MMA(1, 0, At, B0); PG8_MMA(1, 1, At, B1); PG8_BAR; PG8_SCHED;
      } else {
      PG8_LDB(B0, 0, 0); PG8_SCHED; PG8_LDA(At, 0, 0); PG8_STAGE(PG8_SA(1, 1), a1 + hstepA, voffA);
      PG8_WAIT_L(8); PG8_BAR; PG8_WAIT_L(0); PG8_MMA(0, 0, At, B0); PG8_BAR; PG8_SCHED;
      PG8_LDB(B1, 0, 1); PG8_STAGE(PG8_SB(0, 0), b2, voffB);
      PG8_BAR; PG8_WAIT_L(0); PG8_MMA(0, 1, At, B1); PG8_BAR;
      PG8_LDA(At, 0, 1); PG8_STAGE(PG8_SA(0, 0), a2, voffA);
      PG8_BAR; PG8_WAIT_L(0); PG8_MMA(1, 0, At, B0); PG8_BAR; PG8_SCHED;
      PG8_STAGE(PG8_SB(0, 1), b2 + hstepB, voffB);
      PG8_WAIT_V(6); PG8_BAR; PG8_MMA(1, 1, At, B1); PG8_BAR;
      PG8_LDB(B0, 1, 0); PG8_SCHED; PG8_LDA(At, 1, 0); PG8_STAGE(PG8_SA(0, 1), a2 + hstepA, voffA);
      PG8_WAIT_L(8); PG8_BAR; PG8_WAIT_L(0); PG8_MMA(0, 0, At, B0); PG8_BAR; PG8_SCHED;
      PG8_LDB(B1, 1, 1); PG8_STAGE(PG8_SB(1, 0), b3, voffB);
      PG8_BAR; PG8_WAIT_L(0); PG8_MMA(0, 1, At, B1); PG8_BAR;
      PG8_LDA(At, 1, 1); PG8_STAGE(PG8_SA(1, 0), a3, voffA);
      PG8_BAR; PG8_WAIT_L(0); PG8_MMA(1, 0, At, B0); PG8_BAR; PG8_SCHED;
      PG8_STAGE(PG8_SB(1, 1), b3 + hstepB, voffB);
      PG8_WAIT_V(6); PG8_BAR; PG8_MMA(1, 1, At, B1); PG8_BAR;
      }
    }
    if constexpr (ALIGN_EPI) { if (wr == 0) PG8_BAR; }
    E(acc, cur, wr, wc, fr, fq);
    if (!has_next) break;
    if constexpr (Epi::INIT) E.init(acc, nxt, wr, wc, fr, fq);
    else {
#pragma unroll
    for (int a = 0; a < 2; ++a)
#pragma unroll
      for (int b = 0; b < 2; ++b)
#pragma unroll
        for (int m = 0; m < 4; ++m)
#pragma unroll
          for (int n = 0; n < 2; ++n) acc[a][b][m][n] = (f32x4){0.f, 0.f, 0.f, 0.f};
    }
    cur = nxt; cA = nA; cB = nB; ++ui;
    if constexpr (ALIGN_EPI) { if (wr == 1) PG8_BAR; }
  }
  PG8_WAIT_V(0);
  if constexpr (!ALIGN_EPI) { if (wr == 0) PG8_BAR; }
  PG8_BAR;
#undef PG8_SA
#undef PG8_SB
#undef PG8_STAGE
#undef PG8_LDA
#undef PG8_LDB
#undef PG8_MMA
#undef PG8_WAIT_V
#undef PG8_WAIT_L
#undef PG8_BAR
#undef PG8_SCHED
}
}
using pg8::Unit; using pg8::HALF;
typedef f32x4 Acc[2][2][4][2];

struct EpiG {
  static constexpr bool PERM = true, INIT = false;
  bf16_t* O; int ldc;
  const i64* rss; float rinvD;
  const i64* css; float cinvD;
  int gelu_hi;
  int ss_lo, ss_hi; i64* ssacc;
  int rope_mode;
  const f32x2* cs;
  int sc_lo; float sc_val;
  __device__ __forceinline__ void operator()(Acc& acc, const Unit& u, int wr, int wc, int fr, int fq) const {
    const int ct = u.pn * 256;
    const bool do_gelu = ct < gelu_hi, do_ss = (ct >= ss_lo && ct < ss_hi), do_sc = ct >= sc_lo;
    float rsv[2][4];
#pragma unroll
    for (int ai = 0; ai < 2; ++ai)
#pragma unroll
      for (int m = 0; m < 4; ++m) rsv[ai][m] = rss ? fx2f(rss[u.pm * 256 + ai * HALF + wr * 64 + m * 16 + fr]) : 1.0f;
    f32x4 cq[2][2];
#pragma unroll
    for (int bj = 0; bj < 2; ++bj) { const int c0 = ct + bj * HALF + wc * 32 + 8 * fq;
      cq[bj][0] = (f32x4){1.f, 1.f, 1.f, 1.f}; cq[bj][1] = cq[bj][0];
      if (css) {
#pragma unroll
        for (int j = 0; j < 4; ++j) { cq[bj][0][j] = fx2f(css[c0 + j]); cq[bj][1][j] = fx2f(css[c0 + 4 + j]); } } }
    if (rss) {
#pragma unroll
      for (int ai = 0; ai < 2; ++ai)
#pragma unroll
        for (int m = 0; m < 4; ++m) rsv[ai][m] = __builtin_amdgcn_rsqf(rsv[ai][m] * rinvD + EPS);
    }
    if (css) {
#pragma unroll
      for (int bj = 0; bj < 2; ++bj)
#pragma unroll
        for (int h = 0; h < 2; ++h)
#pragma unroll
          for (int j = 0; j < 4; ++j) cq[bj][h][j] = __builtin_amdgcn_rsqf(cq[bj][h][j] * cinvD + EPS);
    }
#pragma unroll
    for (int ai = 0; ai < 2; ++ai)
#pragma unroll
      for (int m = 0; m < 4; ++m) {
        const int row = u.pm * 256 + ai * HALF + wr * 64 + m * 16 + fr;
        const float rs = rsv[ai][m];
        float ss = 0.f;
#pragma unroll
        for (int bj = 0; bj < 2; ++bj) {
          const int c0 = ct + bj * HALF + wc * 32 + 8 * fq;
          f32x4 v0 = acc[ai][bj][m][0] * rs, v1 = acc[ai][bj][m][1] * rs;
          if (css) { v0 = v0 * cq[bj][0]; v1 = v1 * cq[bj][1]; }
          if (do_gelu) { v0 = gelu4(v0); v1 = gelu4(v1); }
          if (do_ss) ss += (v0[0] * v0[0] + v0[1] * v0[1]) + (v0[2] * v0[2] + v0[3] * v0[3]) + (v1[0] * v1[0] + v1[1] * v1[1]) + (v1[2] * v1[2] + v1[3] * v1[3]);
          int roff = -1;
          if (rope_mode == 1) { const int d = c0 % 192; if (d >= 128) roff = d - 128; }
          else if (rope_mode == 2) { if (c0 >= 512 && c0 < 576) roff = c0 - 512; }
          if (roff >= 0) {
            const f32x2* t = cs + (size_t)row * 32 + (roff >> 1);
            const f32x2 t0 = t[0], t1 = t[1], t2 = t[2], t3 = t[3];
            f32x4 w0, w1;
            w0[0] = v0[0] * t0.x - v0[1] * t0.y; w0[1] = v0[1] * t0.x + v0[0] * t0.y;
            w0[2] = v0[2] * t1.x - v0[3] * t1.y; w0[3] = v0[3] * t1.x + v0[2] * t1.y;
            w1[0] = v1[0] * t2.x - v1[1] * t2.y; w1[1] = v1[1] * t2.x + v1[0] * t2.y;
            w1[2] = v1[2] * t3.x - v1[3] * t3.y; w1[3] = v1[3] * t3.x + v1[2] * t3.y;
            v0 = w0; v1 = w1;
          }
          if (do_sc) { v0 = v0 * sc_val; v1 = v1 * sc_val; }
          u32x4 w; w.x = cvt_pk_bf16(v0[0], v0[1]); w.y = cvt_pk_bf16(v0[2], v0[3]); w.z = cvt_pk_bf16(v1[0], v1[1]); w.w = cvt_pk_bf16(v1[2], v1[3]);
          *(u32x4*)(O + (size_t)row * ldc + c0) = w;
        }
        if (do_ss) { ss += __shfl_xor(ss, 16); ss += __shfl_xor(ss, 32); if (fq == 0) fx_add(ssacc + row, ss); }
      }
  }
};

struct EpiRes {
  static constexpr bool PERM = true, INIT = true;
  bf16_t* xb; i64* ssacc;
  __device__ __forceinline__ void init(Acc& acc, const Unit& u, int wr, int wc, int fr, int fq) const {
#pragma unroll
    for (int ai = 0; ai < 2; ++ai)
#pragma unroll
      for (int bj = 0; bj < 2; ++bj)
#pragma unroll
        for (int m = 0; m < 4; ++m) {
          const int row = u.pm * 256 + ai * HALF + wr * 64 + m * 16 + fr, c0 = u.pn * 256 + bj * HALF + wc * 32 + 8 * fq;
          const u32x4 w = *(const u32x4*)(xb + (size_t)row * DM + c0);
          acc[ai][bj][m][0] = (f32x4){__uint_as_float(w.x << 16), __uint_as_float(w.x & 0xffff0000u), __uint_as_float(w.y << 16), __uint_as_float(w.y & 0xffff0000u)};
          acc[ai][bj][m][1] = (f32x4){__uint_as_float(w.z << 16), __uint_as_float(w.z & 0xffff0000u), __uint_as_float(w.w << 16), __uint_as_float(w.w & 0xffff0000u)};
        }
  }
  __device__ __forceinline__ void operator()(Acc& acc, const Unit& u, int wr, int wc, int fr, int fq) const {
#pragma unroll
    for (int ai = 0; ai < 2; ++ai)
#pragma unroll
      for (int m = 0; m < 4; ++m) {
        const int row = u.pm * 256 + ai * HALF + wr * 64 + m * 16 + fr;
        float ss = 0.f;
#pragma unroll
        for (int bj = 0; bj < 2; ++bj) {
          const int c0 = u.pn * 256 + bj * HALF + wc * 32 + 8 * fq;
          const f32x4 v0 = acc[ai][bj][m][0], v1 = acc[ai][bj][m][1];
          u32x4 w; w.x = cvt_pk_bf16(v0[0], v0[1]); w.y = cvt_pk_bf16(v0[2], v0[3]); w.z = cvt_pk_bf16(v1[0], v1[1]); w.w = cvt_pk_bf16(v1[2], v1[3]);
          *(u32x4*)(xb + (size_t)row * DM + c0) = w;
          ss += (v0[0] * v0[0] + v0[1] * v0[1]) + (v0[2] * v0[2] + v0[3] * v0[3]) + (v1[0] * v1[0] + v1[1] * v1[1]) + (v1[2] * v1[2] + v1[3] * v1[3]);
        }
        ss += __shfl_xor(ss, 16); ss += __shfl_xor(ss, 32);
        if (fq == 0) fx_add(ssacc + row, ss);
      }
  }
};

struct EpiUp {
  static constexpr bool PERM = true, INIT = false;
  bf16_t* g; float* halo; const i64* rss; const float* cw; const float* cb; LAS unsigned char* epl;
  __device__ __forceinline__ void operator()(Acc& acc, const Unit& u, int wr, int wc, int fr, int fq) const {
    const int rowb = u.pm * 256 + wr * 64;
    const int c0 = u.pn * 128 + wc * 32 + 8 * fq;
    float rr[2][4];
#pragma unroll
    for (int ai = 0; ai < 2; ++ai)
#pragma unroll
      for (int m = 0; m < 4; ++m) rr[ai][m] = fx2f(rss[rowb + ai * HALF + m * 16 + fr]);
    LAS unsigned char* wl = epl + (wr * 4 + wc) * 1024;
    { const int lane = fq * 16 + fr, arr = lane >> 3, part = lane & 7, col = u.pn * 128 + wc * 32 + 4 * part;
      const float* sp = ((arr & 3) == 3 ? cb : cw + (size_t)(arr & 3) * DFF2) + (arr >> 2) * DFF + col;
      const f32x4 wv = *(const f32x4*)sp;
      *(LAS f32x4*)(wl + lane * 16) = wv; }
#pragma unroll
    for (int ai = 0; ai < 2; ++ai)
#pragma unroll
      for (int m = 0; m < 4; ++m) {
        const float r = __builtin_amdgcn_rsqf(rr[ai][m] * (1.0f / DM) + EPS);
#pragma unroll
        for (int bj = 0; bj < 2; ++bj)
#pragma unroll
          for (int n = 0; n < 2; ++n) acc[ai][bj][m][n] = acc[ai][bj][m][n] * r;
      }
    asm volatile("s_waitcnt lgkmcnt(0)" ::: "memory");
#pragma unroll
    for (int n = 0; n < 2; ++n) {
      const int cc = c0 + 4 * n;
      const LAS unsigned char* wp = wl + (8 * fq + 4 * n) * 4;
      const f32x4 wg0 = *(const LAS f32x4*)(wp), wg1 = *(const LAS f32x4*)(wp + 128), wg2 = *(const LAS f32x4*)(wp + 256), bg = *(const LAS f32x4*)(wp + 384);
      const f32x4 wv0 = *(const LAS f32x4*)(wp + 512), wv1 = *(const LAS f32x4*)(wp + 640), wv2 = *(const LAS f32x4*)(wp + 768), bv = *(const LAS f32x4*)(wp + 896);
#pragma unroll
      for (int ai = 0; ai < 2; ++ai) {
        f32x4 g1p = (f32x4){0.f, 0.f, 0.f, 0.f}, g2p = g1p, v1p = g1p, v2p = g1p;
#pragma unroll
        for (int m = 0; m < 4; ++m) {
          const f32x4 G = acc[ai][0][m][n], V = acc[ai][1][m][n];
          const f32x4 pg1 = shr1ov(g1p, G), pg2 = shr2ov(g2p, G), pv1 = shr1ov(v1p, V), pv2 = shr2ov(v2p, V);
          const f32x4 cgt = wg2 * G + wg1 * pg1 + wg0 * pg2 + bg;
          const f32x4 cvl = wv2 * V + wv1 * pv1 + wv0 * pv2 + bv;
          if (m < 3) { g1p = ror1v(G); g2p = ror2v(G); v1p = ror1v(V); v2p = ror2v(V); }
          const int row = rowb + ai * HALF + m * 16 + fr;
          if (m > 0 || fr >= 2) {
            u32x2 w; w.x = cvt_pk_bf16(silu1(cgt[0]) * cvl[0], silu1(cgt[1]) * cvl[1]); w.y = cvt_pk_bf16(silu1(cgt[2]) * cvl[2], silu1(cgt[3]) * cvl[3]);
            *(u32x2*)(g + (size_t)row * DFF + cc) = w;
          }
          int slot = -1;
          if (m == 0 && fr < 2) slot = fr;
          if (m == 3 && fr >= 14) slot = fr - 12;
          if (slot >= 0) {
            float* hp = halo + ((size_t)(row >> 6) * 4 + slot) * DFF2 + cc;
            *(f32x4*)hp = G; *(f32x4*)(hp + DFF) = V;
          }
        }
      }
    }
  }
};

constexpr int ATT_KBUF = 64 * 400, ATT_VROWB = 136, ATT_VBUF = 128 * ATT_VROWB, ATT_BUF = ATT_KBUF + ATT_VBUF;
template <int DQK, bool CAUSAL>
__device__ __forceinline__ void attn_unit(LAS unsigned char* lds, const bf16_t* Q, int ldq, const bf16_t* K1, int ldk1, const bf16_t* K2, int ldk2,
                                          const bf16_t* VT, int ldv, int ntiles, int q0, bf16_t* O, int ldo) {
  constexpr int KROWB = (DQK + 8) * 2, NKS = DQK / 16, CPR = DQK / 8, NKCH = 64 * CPR / 512;
  int tid_o = threadIdx.x; asm volatile("" : "+v"(tid_o));
  const int tid = tid_o, wid = __builtin_amdgcn_readfirstlane(tid >> 6), lane = tid & 63, r32 = lane & 31, hi = lane >> 5;
  bf16x8 qf[NKS];
  { const bf16_t* qp = Q + (size_t)(wid * 32 + r32) * ldq + hi * 8;
#pragma unroll
    for (int ks = 0; ks < NKS; ++ks) qf[ks] = *(const bf16x8*)(qp + ks * 16); }
  u32x4 kreg[NKCH], vreg[2];
#define ATT_GLOAD(t_) do { const int k0_ = (t_) * 64; \
    _Pragma("unroll") for (int i = 0; i < NKCH; ++i) { const int ch = tid + i * 512, kr = ch / CPR, kc = ch - kr * CPR; \
      const bf16_t* src = (DQK == 128 || kc < 16) ? K1 + (size_t)(k0_ + kr) * ldk1 + kc * 8 : K2 + (size_t)(k0_ + kr) * ldk2 + (kc - 16) * 8; \
      kreg[i] = *(const u32x4*)src; } \
    _Pragma("unroll") for (int i = 0; i < 2; ++i) { const int ch = tid + i * 512, d = ch >> 3, cc = ch & 7; vreg[i] = *(const u32x4*)(VT + (size_t)d * ldv + k0_ + cc * 8); } } while (0)
#define ATT_LWRITE(buf_) do { LAS unsigned char* kb_ = lds + (buf_) * ATT_BUF; \
    _Pragma("unroll") for (int i = 0; i < NKCH; ++i) { const int ch = tid + i * 512, kr = ch / CPR, kc = ch - kr * CPR; *(LAS u32x4*)(kb_ + kr * KROWB + kc * 16) = kreg[i]; } \
    _Pragma("unroll") for (int i = 0; i < 2; ++i) { const int ch = tid + i * 512, d = ch >> 3, cc = ch & 7; LAS unsigned char* p = kb_ + ATT_KBUF + d * ATT_VROWB + cc * 16; \
      *(LAS u32x2*)p = (u32x2){vreg[i].x, vreg[i].y}; *(LAS u32x2*)(p + 8) = (u32x2){vreg[i].z, vreg[i].w}; } } while (0)
  f32x16 o[4];
#pragma unroll
  for (int d = 0; d < 4; ++d)
#pragma unroll
    for (int i = 0; i < 16; ++i) o[d][i] = 0.f;
  float mrow = 0.f, lsum = 0.f;
  const int qabs = q0 + wid * 32 + r32, qlo = q0 + wid * 32;
  ATT_GLOAD(0); ATT_LWRITE(0); __syncthreads();
  for (int t = 0; t < ntiles; ++t) {
    const int buf = t & 1;
    if (t + 1 < ntiles) ATT_GLOAD(t + 1);
    const int k0 = t * 64;
    if (!CAUSAL || k0 <= qlo + 31) {
      const LAS unsigned char* kb = lds + buf * ATT_BUF;
      const bool first = (t == 0);
      const float nm = first ? 0.f : -mrow;
      f32x16 s0, s1;
#pragma unroll
      for (int i = 0; i < 16; ++i) { s0[i] = nm; s1[i] = nm; }
#pragma unroll
      for (int ks = 0; ks < NKS; ++ks) {
        const bf16x8 ka = *(const LAS bf16x8*)(kb + r32 * KROWB + ks * 32 + hi * 16);
        const bf16x8 kc = *(const LAS bf16x8*)(kb + (32 + r32) * KROWB + ks * 32 + hi * 16);
        s0 = __builtin_amdgcn_mfma_f32_32x32x16_bf16(ka, qf[ks], s0, 0, 0, 0);
        s1 = __builtin_amdgcn_mfma_f32_32x32x16_bf16(kc, qf[ks], s1, 0, 0, 0);
      }
      if (CAUSAL && k0 + 63 > qlo) {
#pragma unroll
        for (int i = 0; i < 16; ++i) { const int kv = k0 + (i & 3) + 8 * (i >> 2) + 4 * hi;
          if (kv > qabs) s0[i] = -INFINITY; if (kv + 32 > qabs) s1[i] = -INFINITY; }
      }
      float mx = s0[0];
#pragma unroll
      for (int i = 1; i < 16; ++i) mx = fmaxf(mx, s0[i]);
#pragma unroll
      for (int i = 0; i < 16; ++i) mx = fmaxf(mx, s1[i]);
      mx = fmaxf(mx, __shfl_xor(mx, 32));
      const bool need = first || (mx > 8.0f);
      if (__ballot(need) != 0ull) {
        const float d = need ? mx : 0.f;
        const float alpha = first ? 0.f : __builtin_amdgcn_exp2f(-d);
        mrow = first ? mx : mrow + d;
        lsum *= alpha;
#pragma unroll
        for (int dd = 0; dd < 4; ++dd)
#pragma unroll
          for (int i = 0; i < 16; ++i) o[dd][i] *= alpha;
#pragma unroll
        for (int i = 0; i < 16; ++i) { s0[i] -= d; s1[i] -= d; }
      }
      float ps = 0.f;
#pragma unroll
      for (int i = 0; i < 16; ++i) { s0[i] = __builtin_amdgcn_exp2f(s0[i]); s1[i] = __builtin_amdgcn_exp2f(s1[i]); ps += s0[i] + s1[i]; }
      lsum += ps;
      bf16x8 pa[4];
#pragma unroll
      for (int s = 0; s < 4; ++s) {
        u32x4 w;
        if (s < 2) { w.x = cvt_pk_bf16(s0[8 * s + 0], s0[8 * s + 1]); w.y = cvt_pk_bf16(s0[8 * s + 2], s0[8 * s + 3]); w.z = cvt_pk_bf16(s0[8 * s + 4], s0[8 * s + 5]); w.w = cvt_pk_bf16(s0[8 * s + 6], s0[8 * s + 7]); }
        else { const int b = 8 * (s - 2); w.x = cvt_pk_bf16(s1[b + 0], s1[b + 1]); w.y = cvt_pk_bf16(s1[b + 2], s1[b + 3]); w.z = cvt_pk_bf16(s1[b + 4], s1[b + 5]); w.w = cvt_pk_bf16(s1[b + 6], s1[b + 7]); }
        pa[s] = __builtin_bit_cast(bf16x8, w);
      }
      const LAS unsigned char* vb = kb + ATT_KBUF;
#pragma unroll
      for (int d = 0; d < 4; ++d)
#pragma unroll
        for (int s = 0; s < 4; ++s) {
          const LAS unsigned char* p = vb + (32 * d + r32) * ATT_VROWB + (16 * s + 4 * hi) * 2;
          const u32x2 lo = *(const LAS u32x2*)p, hh = *(const LAS u32x2*)(p + 16);
          const bf16x8 vf = __builtin_bit_cast(bf16x8, (u32x4){lo.x, lo.y, hh.x, hh.y});
          o[d] = __builtin_amdgcn_mfma_f32_32x32x16_bf16(vf, pa[s], o[d], 0, 0, 0);
        }
    }
    if (t + 1 < ntiles) ATT_LWRITE(buf ^ 1);
    __syncthreads();
  }
#undef ATT_GLOAD
#undef ATT_LWRITE
  const float inv = 1.0f / (lsum + __shfl_xor(lsum, 32));
  bf16_t* op = O + (size_t)(wid * 32 + r32) * ldo + 4 * hi;
#pragma unroll
  for (int d = 0; d < 4; ++d)
#pragma unroll
    for (int ig = 0; ig < 4; ++ig) {
      u32x2 w; w.x = cvt_pk_bf16(o[d][4 * ig] * inv, o[d][4 * ig + 1] * inv); w.y = cvt_pk_bf16(o[d][4 * ig + 2] * inv, o[d][4 * ig + 3] * inv);
      *(u32x2*)(op + 32 * d + 8 * ig) = w;
    }
}


#define XB_TMO      128
#define XB_XCNT(j)  (256  + 64 * (j))
#define XB_XSUB(j)  (1280 + 64 * (j))
#define XB_XGEN(j)  (2304 + 64 * (j))
#define XB_TOP      3328
#define XB_TOPGEN   3392
#define XCD_BAR_WORDS 3456
#define XB_SPIN_CAP (1u << 18)
__device__ __forceinline__ unsigned xb_ld(unsigned* p)              { return __hip_atomic_load(p, __ATOMIC_RELAXED, __HIP_MEMORY_SCOPE_AGENT); }
__device__ __forceinline__ unsigned xb_add(unsigned* p, unsigned v) { return __hip_atomic_fetch_add(p, v, __ATOMIC_RELAXED, __HIP_MEMORY_SCOPE_AGENT); }
__device__ __forceinline__ unsigned xb_xcc_id() { return (unsigned)__builtin_amdgcn_s_getreg((3 << 11) | 20) & 0xFu; }
#define XB_SPIN(cond, bar) do { unsigned _sp = 0; while (cond) { __builtin_amdgcn_s_sleep(1); \
    if ((++_sp & 255u) == 0u) { if (xb_ld(&(bar)[XB_TMO])) break; if (_sp > XB_SPIN_CAP) { atomicAdd(&(bar)[XB_TMO], 1u); break; } } } } while (0)
struct XcdBarrier { unsigned* bar; unsigned x; volatile LAS unsigned* st; };
__device__ __forceinline__ XcdBarrier xcd_barrier_post(unsigned* bar, volatile LAS unsigned* st) {
  XcdBarrier b; b.bar = bar; b.x = xb_xcc_id(); b.st = st;
  if (threadIdx.x == 0) (void)xb_add(&bar[XB_XCNT(b.x)], 1u);
  return b;
}
__device__ __forceinline__ void xcd_barrier_complete(unsigned* bar, unsigned x, unsigned& nloc, unsigned& nx) {
  const unsigned G = gridDim.x * gridDim.y * gridDim.z;
  unsigned sum, cnt, mine, sp = 0u;
  for (;;) {
    sum = 0u; cnt = 0u; mine = 0u;
#pragma unroll
    for (unsigned j = 0; j < 16; ++j) { const unsigned c = xb_ld(&bar[XB_XCNT(j)]); sum += c; cnt += (c > 0u) ? 1u : 0u; mine = (j == x) ? c : mine; }
    if (sum == G) break;
    __builtin_amdgcn_s_sleep(1);
    if ((++sp & 255u) == 0u) { if (xb_ld(&bar[XB_TMO])) break; if (sp > XB_SPIN_CAP) { atomicAdd(&bar[XB_TMO], 1u); break; } }
  }
  nloc = mine > 0u ? mine : 1u; nx = cnt > 0u ? cnt : 1u;
}
__device__ __forceinline__ void xcd_barrier(const XcdBarrier& b) {
  asm volatile("s_waitcnt vmcnt(0)" ::: "memory");
  __syncthreads();
  if (threadIdx.x == 0) {
    unsigned* bar = b.bar;
    __builtin_amdgcn_s_waitcnt(0);
    unsigned nloc = b.st[0], nx = b.st[1];
    if (nloc == 0u) { xcd_barrier_complete(bar, b.x, nloc, nx); b.st[0] = nloc; b.st[1] = nx; }
    const unsigned old = xb_add(&bar[XB_XSUB(b.x)], 1u);
    const unsigned gen = old / nloc;
    if (old + 1u == (gen + 1u) * nloc) {
      __builtin_amdgcn_fence(__ATOMIC_RELEASE, "agent");
      asm volatile("s_waitcnt vmcnt(0)" ::: "memory");
      const unsigned og = xb_add(&bar[XB_TOP], 1u);
      const unsigned tg = og / nx;
      if (og + 1u == (tg + 1u) * nx) xb_add(&bar[XB_TOPGEN], 1u);
      else XB_SPIN(xb_ld(&bar[XB_TOPGEN]) == tg, bar);
      __builtin_amdgcn_fence(__ATOMIC_ACQUIRE, "agent");
      xb_add(&bar[XB_XGEN(b.x)], 1u);
      asm volatile("s_waitcnt vmcnt(0)" ::: "memory");
    } else {
      XB_SPIN(xb_ld(&bar[XB_XGEN(b.x)]) == gen, bar);
      __builtin_amdgcn_fence(__ATOMIC_ACQUIRE, "agent");
      asm volatile("s_waitcnt vmcnt(0)" ::: "memory");
    }
  }
  __syncthreads();
}

constexpr int NWD = 27;
struct WDesc { const float* src; const float* scale; bf16_t* dst; int K, Ns, Nd, kind, item0, pad; };
struct Args { const float* in[25]; float* out; unsigned char* ws; WDesc wd[NWD]; int nitems; int pad; };

__device__ __forceinline__ int srccol(int kind, int n) {
  if (kind == 0) return n;
  if (kind == 1) { if (n < 512) return n; if (n < 576) { const int r = n - 512; return 512 + ((r & 1) ? 32 : 0) + (r >> 1); } return -1; }
  if (kind == 2) { const int h = n / 192, d = n - h * 192; if (d < 128) return n; const int r = d - 128; return h * 192 + 128 + ((r & 1) ? 32 : 0) + (r >> 1); }
  { const int t = n >> 8, w = n & 255; return (w >> 7) * DFF + 128 * t + (w & 127); }
}

constexpr int LDS_BYTES = 140 * 1024;
#ifndef ONLY
#define ONLY 0
#endif
#define EN(k) (ONLY == 0 || ONLY == (k))
typedef __attribute__((address_space(4))) const Args CArgs;
#define DERIVE_PTRS(ap) \
  unsigned char* ws = (ap)->ws; \
  i64* rsA = (i64*)(ws + WS_RS); i64* rsB = rsA + MTOK; i64* rsV = rsB + MTOK; i64* rsQ = rsV + MTOK; i64* rsKV = rsQ + MTOK; i64* rsM = rsKV + MTOK; \
  f32x2* cs = (f32x2*)(ws + WS_CS); \
  bf16_t* memb = (bf16_t*)(ws + WS_MEMB); bf16_t* memk = (bf16_t*)(ws + WS_MEMK); bf16_t* memvt = (bf16_t*)(ws + WS_MEMVT); \
  bf16_t* xb = (bf16_t*)(ws + WS_XB); bf16_t* kvb = (bf16_t*)(ws + WS_KVB); bf16_t* kn = (bf16_t*)(ws + WS_KN); bf16_t* vT = (bf16_t*)(ws + WS_VT); \
  float* halo = (float*)(ws + WS_HALO); \
  bf16_t* gbuf = (bf16_t*)(ws + WS_R); bf16_t* zbuf = (bf16_t*)(ws + WS_R); bf16_t* cat = (bf16_t*)(ws + WS_CAT); bf16_t* qbuf = (bf16_t*)(ws + WS_Q); \
  const float* x_in = (ap)->in[0]; float* xo = (ap)->out; \
  (void)rsA; (void)rsB; (void)rsV; (void)rsQ; (void)rsKV; (void)rsM; (void)cs; (void)memb; (void)memk; (void)memvt; (void)xb; (void)kvb; (void)kn; (void)vT; (void)halo; (void)gbuf; (void)zbuf; (void)cat; (void)qbuf; (void)x_in; (void)xo;
__global__ void __launch_bounds__(512, 2) yoco_fwd(Args a) {
  extern __shared__ __attribute__((aligned(16))) unsigned char lds_raw[];
  LAS unsigned char* lds = (LAS unsigned char*)lds_raw;
  cg::grid_group grid = cg::this_grid();
  volatile LAS unsigned* xst = (volatile LAS unsigned*)(lds + 131072 + 64);
  if (threadIdx.x < 4) xst[threadIdx.x] = 0u;
  __syncthreads();
#define DERIVE_IDS \
  int tid_o = threadIdx.x; asm volatile("" : "+v"(tid_o)); \
  const int tid = tid_o, lane = tid & 63, wave = __builtin_amdgcn_readfirstlane(tid >> 6); \
  const int G = gridDim.x, bx = blockIdx.x; \
  const int vcu = (G % 8 == 0) ? (bx % 8) * (G / 8) + bx / 8 : bx; \
  const int gw = vcu * 8 + wave, NGW = G * 8; \
  const size_t gtid = (size_t)bx * 512 + tid, NGT = (size_t)G * 512; \
  (void)lane; (void)wave; (void)vcu; (void)gw; (void)NGW; (void)gtid; (void)NGT;
  {
    const Args* ap = &a; DERIVE_PTRS(ap)
    DERIVE_IDS
    LAS float* scr = (LAS float*)(lds + wave * 8448);
    for (int it = gw; it < a.nitems; it += NGW) {
      int di = 0;
#pragma unroll 1
      for (int j = 1; j < NWD; ++j) if (it >= a.wd[j].item0) di = j;
      const float* src = a.wd[di].src; const float* scale = a.wd[di].scale; bf16_t* dst = a.wd[di].dst;
      const int K = a.wd[di].K, Ns = a.wd[di].Ns, Nd = a.wd[di].Nd, kind = a.wd[di].kind, item = it - a.wd[di].item0;
      const int nblk = Nd / 32, kb = item / nblk, nb = item - kb * nblk, k0 = 64 * kb, n0 = 32 * nb;
      const int sc = srccol(kind, n0 + (lane & 31));
      float wv[32];
      { const float* sp = src + (size_t)(k0 + (lane >> 5)) * Ns + (sc >= 0 ? sc : 0);
#pragma unroll
        for (int i = 0; i < 32; ++i) wv[i] = sp[(size_t)(2 * i) * Ns]; }
      if (scale) {
#pragma unroll
        for (int i = 0; i < 32; ++i) wv[i] *= scale[k0 + 2 * i + (lane >> 5)];
      }
#pragma unroll
      for (int i = 0; i < 32; ++i) scr[(2 * i + (lane >> 5)) * 33 + (lane & 31)] = (sc >= 0) ? wv[i] : 0.f;
      asm volatile("s_waitcnt lgkmcnt(0)" ::: "memory");
      const int c = lane & 7;
#pragma unroll
      for (int j = 0; j < 4; ++j) { const int n = (lane >> 3) + 8 * j; const LAS float* s = scr + (8 * c) * 33 + n;
        u32x4 o; o.x = cvt_pk_bf16(s[0 * 33], s[1 * 33]); o.y = cvt_pk_bf16(s[2 * 33], s[3 * 33]); o.z = cvt_pk_bf16(s[4 * 33], s[5 * 33]); o.w = cvt_pk_bf16(s[6 * 33], s[7 * 33]);
        *(u32x4*)(dst + (size_t)(n0 + n) * K + k0 + 8 * c) = o; }
      asm volatile("s_waitcnt lgkmcnt(0)" ::: "memory");
    }
    for (int r = gw; r < MTOK + MMEM; r += NGW) {
      const bool ism = r >= MTOK; const int rr = ism ? r - MTOK : r;
      const f32x4* xr = (const f32x4*)((ism ? a.in[1] : x_in) + (size_t)rr * DM) + lane;
      u32x2* o8 = (u32x2*)((ism ? memb : xb) + (size_t)rr * DM) + lane;
      float s = 0.f;
#pragma unroll
      for (int j = 0; j < 8; ++j) { const f32x4 v = xr[64 * j]; s += (v[0] * v[0] + v[1] * v[1]) + (v[2] * v[2] + v[3] * v[3]); u32x2 w; w.x = cvt_pk_bf16(v[0], v[1]); w.y = cvt_pk_bf16(v[2], v[3]); o8[64 * j] = w; }
      s = wave_sum(s);
      if (lane == 0) (ism ? rsM : rsA)[rr] = f2fx(s);
    }
    const int* pos = (const int*)a.in[2];
    for (size_t i = gtid; i < (size_t)MTOK * 32; i += NGT) {
      const int row = (int)(i >> 5), j = (int)(i & 31);
      const float inv = 1.0f / powf(10000.0f, (float)(2 * j) / 64.0f);
      const float ang = (float)pos[row] * inv;
      const double rev = (double)ang * 0.15915494309189535;
      const float fr = (float)(rev - floor(rev));
      cs[i] = (f32x2){__builtin_amdgcn_cosf(fr), __builtin_amdgcn_sinf(fr)};
    }
    for (size_t i = gtid; i < (size_t)MTOK * 4; i += NGT) rsB[i] = 0;
    if (bx == 0) for (int i = tid; i < XCD_BAR_WORDS; i += 512) ((unsigned*)ws)[i] = 0u;
  }
  grid.sync();
  const XcdBarrier xbar = xcd_barrier_post((unsigned*)a.ws, xst);

  pg8::StaticOrder S;
#pragma unroll 1
  for (int l = -1; l < 4; ++l) {
    const bool isA = l < 2; const int j = l - 2;
#pragma unroll 1
    for (int s = 0; s < 10; ++s) {
      CArgs* ap = (CArgs*)__builtin_amdgcn_kernarg_segment_ptr(); asm volatile("" : "+s"(ap));
      DERIVE_PTRS(ap)
      DERIVE_IDS
      int type = 0; bool sync = false;
      pg8::Gemm g{nullptr, nullptr, 0, 0, 0, 0, 0}; int corder = bx;
      EpiG eg{nullptr, 0, nullptr, 0.f, nullptr, 0.f, 0, 0, 0, nullptr, 0, nullptr, 1 << 30, 1.f};
      EpiRes er{xb, nullptr};
      if (l < 0) {
        if (s < 8) {
          const int ml = s >> 1; const bf16_t* wt = ap->wd[9 + ml].dst;
          type = 1; corder = (bx + 16 * s) % G; sync = (s == 7);
          if (!(s & 1)) { g = pg8::Gemm{memb, wt, MMEM, 512, DM, DM, DM}; eg.O = memk + (size_t)ml * MMEM * 512; eg.ldc = 512; eg.rss = rsM; eg.rinvD = 1.0f / DM; }
          else { g = pg8::Gemm{wt + (size_t)512 * DM, memb, 512, MMEM, DM, DM, DM}; eg.O = memvt + (size_t)ml * 512 * MMEM; eg.ldc = MMEM; eg.css = rsM; eg.cinvD = 1.0f / DM; }
        }
      } else {
        switch (s) {
          case 0: if (l == 2) { type = 1; sync = true;
              g = pg8::Gemm{xb, ap->wd[4].dst, MTOK, KVW, DM, DM, DM};
              eg.O = kvb; eg.ldc = KVW; eg.rss = rsA; eg.rinvD = 1.0f / DM; eg.ss_lo = 0; eg.ss_hi = 512; eg.ssacc = rsKV; eg.rope_mode = 2; eg.cs = cs; } break;
          case 1: type = 1; eg.O = zbuf; eg.rss = rsA; eg.rinvD = 1.0f / DM; eg.sc_val = SC_MEM;
            if (isA) { sync = true; g = pg8::Gemm{xb, ap->wd[l].dst, MTOK, ZA_W, DM, DM, DM}; eg.ldc = ZA_W; eg.gelu_hi = 2 * GW; eg.ss_lo = GW; eg.ss_hi = 2 * GW; eg.ssacc = rsV; eg.sc_lo = 2 * GW; }
            else { g = pg8::Gemm{xb, ap->wd[2 + j].dst, MTOK, ZB_W, DM, DM, DM}; eg.ldc = ZB_W; eg.ss_lo = 0; eg.ss_hi = 512; eg.ssacc = rsQ; eg.sc_lo = 512; }
            break;
          case 2: if (!isA) { type = 1; g = pg8::Gemm{kvb, ap->wd[5 + j].dst, MTOK, GW, 512, KVW, 512}; eg.O = kn; eg.ldc = GW; eg.rss = rsKV; eg.rinvD = 1.0f / 512; } break;
          case 3: if (!isA) { type = 1; sync = true; g = pg8::Gemm{ap->wd[7 + j].dst, kvb, GW, MTOK, 512, 512, KVW}; eg.O = vT; eg.ldc = MTOK; eg.css = rsKV; eg.cinvD = 1.0f / 512; } break;
          case 4: if (!isA) { type = 1; sync = true; g = pg8::Gemm{zbuf, ap->wd[13 + j].dst, MTOK, QW, 512, ZB_W, 512};
              eg.O = qbuf; eg.ldc = QW; eg.rss = rsQ; eg.rinvD = 1.0f / 512; eg.rope_mode = 1; eg.cs = cs; eg.sc_lo = 0; eg.sc_val = SC_MLA; } break;
          case 5: type = 4; sync = true; break;
          case 6: type = 2; sync = true; g = pg8::Gemm{cat, ap->wd[15 + l].dst, MTOK, DM, DM, DM, DM}; er.ssacc = rsB; break;
          case 7: type = 3; sync = true; g = pg8::Gemm{xb, ap->wd[19 + l].dst, MTOK, DFF2, DM, DM, DM}; break;
          case 8: type = 5; sync = true; break;
          case 9: type = 2; sync = true; g = pg8::Gemm{gbuf, ap->wd[23 + l].dst, MTOK, DM, DFF, DFF, DFF}; er.ssacc = rsA; break;
        }
      }
      if (type == 1 && EN(1)) { S.init(g.M, g.N, G, corder); pg8::gemm_phase<EpiG>(lds, g, S, eg); }
      else if (type == 2 && EN(2)) {
        S.init(g.M, g.N, G, corder); pg8::gemm_phase<EpiRes>(lds, g, S, er);
        if (s == 6) for (size_t i = gtid; i < (size_t)MTOK; i += NGT) { rsA[i] = 0; rsV[i] = 0; rsQ[i] = 0; }
      }
      else if (type == 3 && EN(3)) {
        S.init(g.M, g.N, G, corder);
        EpiUp E{gbuf, halo, rsB, ap->in[22] + (size_t)l * 3 * DFF2, ap->in[23] + (size_t)l * DFF2, lds + 131072 + 1024};
        pg8::gemm_phase<EpiUp>(lds, g, S, E);
      }
      else if (type == 4 && (EN(4) || EN(6) || EN(7))) {
        if (isA && EN(4)) {
          const float* wsp = ap->in[8] + (size_t)l * 12 * 128 * 128; const float* bsp = ap->in[9] + (size_t)l * 12 * 128; const float* gv = ap->in[7] + (size_t)l * GW;
          LAS unsigned char* Wl = lds; LAS unsigned char* Vt = lds + 128 * 272;
          const int r32 = lane & 31, hi = lane >> 5, tb = wave & 3, chh = wave >> 2;
          f32x4 wreg[8], qreg = (f32x4){0.f, 0.f, 0.f, 0.f}; u32x4 vreg[4];
#pragma unroll
          for (int i = 0; i < 8; ++i) wreg[i] = (f32x4){0.f, 0.f, 0.f, 0.f};
#pragma unroll
          for (int i = 0; i < 4; ++i) vreg[i] = (u32x4){0u, 0u, 0u, 0u};
          if (vcu < NB * 32 * 12) { const int gi_ = (vcu) % 12, tok0_ = ((vcu) / 12) * 128;
#pragma unroll
              for (int i = 0; i < 8; ++i) { const int idx = tid + i * 512, t = idx >> 5, s4 = (idx & 31) * 4; wreg[i] = *(const f32x4*)(wsp + ((size_t)gi_ * 128 + t) * 128 + s4); }
              { const i64* qp = rsV + tok0_ + (tid & 31) * 4; qreg = (f32x4){fx2f(qp[0]), fx2f(qp[1]), fx2f(qp[2]), fx2f(qp[3])}; }
#pragma unroll
              for (int i = 0; i < 4; ++i) { const int idx = tid + i * 512, sr = (idx >> 8) * 16 + (idx & 15), c8 = ((idx >> 4) & 15) * 8;
                vreg[i] = *(const u32x4*)(zbuf + (size_t)(tok0_ + sr) * ZA_W + GW + gi_ * 128 + c8); } }
          for (int uidx = vcu; uidx < NB * 32 * 12; uidx += G) {
            const int gi = uidx % 12, bn = uidx / 12, tok0 = bn * 128;
            { f32x4 rq;
#pragma unroll
              for (int e = 0; e < 4; ++e) rq[e] = __builtin_amdgcn_rsqf(qreg[e] * (1.0f / GW) + EPS);
#pragma unroll
              for (int i = 0; i < 8; ++i) { const int idx = tid + i * 512, t = idx >> 5, s4 = (idx & 31) * 4;
                f32x4 w = wreg[i];
#pragma unroll
                for (int e = 0; e < 4; ++e) w[e] = (s4 + e <= t) ? w[e] * rq[e] : 0.f;
                *(LAS u32x2*)(Wl + t * 272 + s4 * 2) = (u32x2){cvt_pk_bf16(w[0], w[1]), cvt_pk_bf16(w[2], w[3])}; } }
#pragma unroll
            for (int i = 0; i < 4; ++i) { const int idx = tid + i * 512, sr = (idx >> 8) * 16 + (idx & 15), c8 = ((idx >> 4) & 15) * 8;
              const unsigned vv[4] = {vreg[i].x, vreg[i].y, vreg[i].z, vreg[i].w};
#pragma unroll
              for (int e = 0; e < 4; ++e) { *(LAS unsigned short*)(Vt + (c8 + 2 * e) * 272 + sr * 2) = (unsigned short)(vv[e] & 0xffffu); *(LAS unsigned short*)(Vt + (c8 + 2 * e + 1) * 272 + sr * 2) = (unsigned short)(vv[e] >> 16); } }
            __syncthreads();
            if (uidx + G < NB * 32 * 12) { const int gi_ = (uidx + G) % 12, tok0_ = ((uidx + G) / 12) * 128;
#pragma unroll
              for (int i = 0; i < 8; ++i) { const int idx = tid + i * 512, t = idx >> 5, s4 = (idx & 31) * 4; wreg[i] = *(const f32x4*)(wsp + ((size_t)gi_ * 128 + t) * 128 + s4); }
              { const i64* qp = rsV + tok0_ + (tid & 31) * 4; qreg = (f32x4){fx2f(qp[0]), fx2f(qp[1]), fx2f(qp[2]), fx2f(qp[3])}; }
#pragma unroll
              for (int i = 0; i < 4; ++i) { const int idx = tid + i * 512, sr = (idx >> 8) * 16 + (idx & 15), c8 = ((idx >> 4) & 15) * 8;
                vreg[i] = *(const u32x4*)(zbuf + (size_t)(tok0_ + sr) * ZA_W + GW + gi_ * 128 + c8); } }
            f32x16 acc2[2];
#pragma unroll
            for (int cb = 0; cb < 2; ++cb)
#pragma unroll
              for (int i = 0; i < 16; ++i) acc2[cb][i] = 0.f;
            const int nks = 2 * (tb + 1);
            for (int ks = 0; ks < nks; ++ks) {
              const bf16x8 wf = *(const LAS bf16x8*)(Wl + (32 * tb + r32) * 272 + ks * 32 + hi * 16);
#pragma unroll
              for (int cb = 0; cb < 2; ++cb) {
                const bf16x8 vf = *(const LAS bf16x8*)(Vt + (64 * chh + 32 * cb + r32) * 272 + ks * 32 + hi * 16);
                acc2[cb] = __builtin_amdgcn_mfma_f32_32x32x16_bf16(vf, wf, acc2[cb], 0, 0, 0);
              }
            }
            const int t = 32 * tb + r32; const float bt = bsp[gi * 128 + t];
            const size_t rowoff = (size_t)(tok0 + t);
#pragma unroll
            for (int cb = 0; cb < 2; ++cb)
#pragma unroll
              for (int ig = 0; ig < 4; ++ig) {
                const int c = gi * 128 + 64 * chh + 32 * cb + 8 * ig + 4 * hi;
                const f32x4 gg = *(const f32x4*)(gv + c);
                const u32x2 uu = *(const u32x2*)(zbuf + rowoff * ZA_W + c);
                const float u0 = __uint_as_float(uu.x << 16), u1 = __uint_as_float(uu.x & 0xffff0000u), u2 = __uint_as_float(uu.y << 16), u3 = __uint_as_float(uu.y & 0xffff0000u);
                const float o0 = u0 * (acc2[cb][4 * ig] * gg[0] + bt), o1 = u1 * (acc2[cb][4 * ig + 1] * gg[1] + bt), o2 = u2 * (acc2[cb][4 * ig + 2] * gg[2] + bt), o3 = u3 * (acc2[cb][4 * ig + 3] * gg[3] + bt);
                *(u32x2*)(cat + rowoff * DM + c) = (u32x2){cvt_pk_bf16(o0, o1), cvt_pk_bf16(o2, o3)};
              }
            __syncthreads();
          }
        } else if (!isA && EN(6)) {
          for (int p = 6 * vcu; p < 1536; p += 6 * G)
#pragma unroll 1
            for (int uu = p; uu < p + 6 && uu < 1536; ++uu) {
              const int pp = uu >> 1, half = uu & 1, bh = pp >> 3, i8 = pp & 7, b = bh / 12, h = bh - b * 12;
              const int qblk = half ? i8 : 15 - i8; const size_t row0 = (size_t)b * SEQ + qblk * 256;
              attn_unit<192, true>(lds, qbuf + row0 * QW + h * 192, QW, kn + (size_t)b * SEQ * GW + h * 128, GW, kvb + (size_t)b * SEQ * KVW + 512, KVW,
                                   vT + (size_t)(h * 128) * MTOK + (size_t)b * SEQ, MTOK, (qblk + 1) * 4, qblk * 256, cat + row0 * DM + h * 128, DM);
            }
        }
        if (EN(7)) {
          const bf16_t* qm = zbuf + (isA ? 2 * GW : 512); const int ldq = isA ? ZA_W : ZB_W;
#pragma unroll 1
          for (int uidx = vcu; uidx < NB * 4 * 16; uidx += G) {
            const int qblk = uidx & 15, bh = uidx >> 4, b = bh >> 2, h = bh & 3; const size_t row0 = (size_t)b * SEQ + qblk * 256;
            attn_unit<128, false>(lds, qm + row0 * ldq + h * 128, ldq, memk + (size_t)l * MMEM * 512 + (size_t)b * NMEM * 512 + h * 128, 512, nullptr, 0,
                                  memvt + (size_t)l * 512 * MMEM + (size_t)(h * 128) * MMEM + b * NMEM, MMEM, 4, 0, cat + row0 * DM + GW + h * 128, DM);
          }
        }
        for (size_t i = gtid; i < (size_t)MTOK; i += NGT) rsB[i] = 0;
      }
      else if (type == 5 && EN(5)) {
        const float* cw = ap->in[22] + (size_t)l * 3 * DFF2; const float* cb = ap->in[23] + (size_t)l * DFF2;
        for (size_t idx = gtid; idx < (size_t)1024 * (DFF / 4); idx += NGT) {
          const int rowi = (int)(idx / (DFF / 4)), c4 = (int)(idx % (DFF / 4)) * 4, blk = rowi >> 1, rr = rowi & 1;
          const bool hp = (blk & 63) != 0;
          const float* H0 = halo + (size_t)blk * 4 * DFF2; const float* Hp = H0 - (size_t)4 * DFF2;
          f32x4 cv[2];
#pragma unroll
          for (int part = 0; part < 2; ++part) {
            const int off = part * DFF + c4; const f32x4 z4 = (f32x4){0.f, 0.f, 0.f, 0.f};
            const f32x4 a0 = *(const f32x4*)(H0 + (size_t)rr * DFF2 + off);
            const f32x4 p3 = hp ? *(const f32x4*)(Hp + (size_t)3 * DFF2 + off) : z4;
            const f32x4 a1 = rr ? *(const f32x4*)(H0 + off) : p3;
            const f32x4 a2 = rr ? p3 : (hp ? *(const f32x4*)(Hp + (size_t)2 * DFF2 + off) : z4);
            cv[part] = *(const f32x4*)(cw + 2 * DFF2 + off) * a0 + *(const f32x4*)(cw + DFF2 + off) * a1 + *(const f32x4*)(cw + off) * a2 + *(const f32x4*)(cb + off);
          }
          u32x2 w; w.x = cvt_pk_bf16(silu1(cv[0][0]) * cv[1][0], silu1(cv[0][1]) * cv[1][1]); w.y = cvt_pk_bf16(silu1(cv[0][2]) * cv[1][2], silu1(cv[0][3]) * cv[1][3]);
          *(u32x2*)(gbuf + (size_t)(blk * 64 + rr) * DFF + c4) = w;
        }
      }
      if (sync) xcd_barrier(xbar);
    }
  }
  {
    const Args* ap = &a; DERIVE_PTRS(ap)
    DERIVE_IDS
    const float* gf = a.in[5];
    for (size_t i = gtid; i < (size_t)MTOK * (DM / 8); i += NGT) {
      const int row = (int)(i / (DM / 8)), c8 = (int)(i % (DM / 8)) * 8;
      const float r = __builtin_amdgcn_rsqf(fx2f(rsA[row]) * (1.0f / DM) + EPS);
      const u32x4 w = *(const u32x4*)(xb + (size_t)row * DM + c8);
      const f32x4 g0 = *(const f32x4*)(gf + c8), g1 = *(const f32x4*)(gf + c8 + 4);
      f32x4 o0 = (f32x4){__uint_as_float(w.x << 16), __uint_as_float(w.x & 0xffff0000u), __uint_as_float(w.y << 16), __uint_as_float(w.y & 0xffff0000u)};
      f32x4 o1 = (f32x4){__uint_as_float(w.z << 16), __uint_as_float(w.z & 0xffff0000u), __uint_as_float(w.w << 16), __uint_as_float(w.w & 0xffff0000u)};
      *(f32x4*)(xo + (size_t)row * DM + c8) = o0 * r * g0;
      *(f32x4*)(xo + (size_t)row * DM + c8 + 4) = o1 * r * g1;
    }
  }
}

extern "C" void kernel_launch(void* const* d_in, const int* in_sizes, int n_in, void* d_out, int out_size, void* d_ws, size_t ws_size, hipStream_t stream) {
  static int grid_blocks = 0;
  if (!grid_blocks) {
    int dev = 0, cus = 0, per_cu = 0;
    (void)hipGetDevice(&dev);
    (void)hipDeviceGetAttribute(&cus, hipDeviceAttributeMultiprocessorCount, dev);
    (void)hipFuncSetAttribute((const void*)yoco_fwd, hipFuncAttributeMaxDynamicSharedMemorySize, LDS_BYTES);
    (void)hipOccupancyMaxActiveBlocksPerMultiprocessor(&per_cu, (const void*)yoco_fwd, 512, LDS_BYTES);
    if (per_cu < 1) per_cu = 1;
    grid_blocks = cus * per_cu;
    if (ws_size < WS_END) fprintf(stderr, "kernel_launch: workspace too small: %zu < %zu\n", ws_size, (size_t)WS_END);
  }
  Args a; memset(&a, 0, sizeof(a));
  for (int i = 0; i < 25; ++i) a.in[i] = (const float*)d_in[i];
  a.out = (float*)d_out; a.ws = (unsigned char*)d_ws;
  const float* const* in = a.in;
  bf16_t* wp = (bf16_t*)((unsigned char*)d_ws + WS_W);
  int nd = 0, items = 0;
  auto add = [&](const float* src, const float* scale, int K, int Ns, int Nd, int kind) {
    WDesc& d = a.wd[nd++]; d.src = src; d.scale = scale; d.dst = wp; d.K = K; d.Ns = Ns; d.Nd = Nd; d.kind = kind; d.item0 = items; d.pad = 0;
    items += (K / 64) * (Nd / 32); wp += (size_t)K * Nd;
  };
  for (int l = 0; l < 2; ++l) add(in[6] + (size_t)l * DM * ZA_W, in[3] + (size_t)l * DM, DM, ZA_W, ZA_W, 0);
  for (int j = 0; j < 2; ++j) add(in[13] + (size_t)j * DM * ZB_W, in[3] + (size_t)(2 + j) * DM, DM, ZB_W, ZB_W, 0);
  add(in[11], in[10], DM, 576, KVW, 1);
  for (int j = 0; j < 2; ++j) add(in[16] + (size_t)j * 512 * GW, in[12], 512, GW, GW, 0);
  for (int j = 0; j < 2; ++j) add(in[17] + (size_t)j * 512 * GW, in[12], 512, GW, GW, 0);
  for (int l = 0; l < 4; ++l) add(in[19] + (size_t)l * DM * 1024, in[18] + (size_t)l * DM, DM, 1024, 1024, 0);
  for (int j = 0; j < 2; ++j) add(in[15] + (size_t)j * 512 * QW, in[14] + (size_t)j * 512, 512, QW, QW, 2);
  for (int l = 0; l < 4; ++l) add(in[20] + (size_t)l * DM * DM, nullptr, DM, DM, DM, 0);
  for (int l = 0; l < 4; ++l) add(in[21] + (size_t)l * DM * DFF2, in[4] + (size_t)l * DM, DM, DFF2, DFF2, 3);
  for (int l = 0; l < 4; ++l) add(in[24] + (size_t)l * DFF * DM, nullptr, DFF, DM, DM, 0);
  a.nitems = items;
  void* args[] = {&a};
  hipError_t e = hipLaunchCooperativeKernel((const void*)yoco_fwd, dim3(grid_blocks), dim3(512), args, LDS_BYTES, stream);
  if (e != hipSuccess) fprintf(stderr, "cooperative launch failed: %s (grid %d)\n", hipGetErrorString(e), grid_blocks);
}
```
